# Optimizing an MI355X kernel written in HIP

```python
import jax, jax.numpy as jnp
from jax import lax
import numpy as np

D_MODEL = 2048
BATCH = 1
SEQ = 16384
DEPTH = 2

CTX_LEN = 256
GRID_W = 64
HEAD_DIM = 128
NA_HEADS = 6
NA_KH = 8
NA_KW = 16
GA_HEADS = 6
GA_KV_HEADS = 2
WA_HEADS = 4
WA_KV_HEADS = 2
WINDOW = 128
Q_BLOCK = 128
ROPE_THETA = 10000.0
NORM_EPS = 1e-6
NEG_INF = -1e30
PEER_HEADS = 8
PEER_NKEYS = 128
PEER_DKEY = 256
PEER_TOPK = 16
PEER_EXPERTS = PEER_NKEYS * PEER_NKEYS
PEER_BLOCK = 128

A_W = NA_HEADS * HEAD_DIM
B_QW = GA_HEADS * HEAD_DIM
B_KW = GA_KV_HEADS * HEAD_DIM
C_QW = WA_HEADS * HEAD_DIM
C_KW = WA_KV_HEADS * HEAD_DIM
N_BRANCH = 3
N_MOD = 6
IN_SPLITS = (A_W, A_W, A_W, B_QW, B_KW, B_KW, C_QW, C_KW, C_KW, N_BRANCH * D_MODEL)
IN_COLS = 3 * A_W + B_QW + 2 * B_KW + C_QW + 2 * C_KW + N_BRANCH * D_MODEL

kernel_name = "hybrid_natten_gqa_swa_peer_dit"


def rmsnorm(x, g):
    xf = x.astype(jnp.float32)
    y = xf * lax.rsqrt(jnp.mean(xf * xf, axis=-1, keepdims=True) + NORM_EPS)
    return (y * g.astype(jnp.float32)).astype(x.dtype)


def modulate(x, shift, scale):
    return x * (1 + scale) + shift


def softmax_f32(logits):
    return jax.nn.softmax(logits.astype(jnp.float32), axis=-1)


def rope_2d(x, pos_row, pos_col):
    quarter = HEAD_DIM // 4
    half = HEAD_DIM // 2
    inv_freq = ROPE_THETA ** (-jnp.arange(quarter, dtype=jnp.float32) / quarter)

    def rot(xh, pos):
        ang = pos[:, None] * inv_freq[None, :]
        cos = jnp.cos(ang)[None, :, None, :].astype(x.dtype)
        sin = jnp.sin(ang)[None, :, None, :].astype(x.dtype)
        x1, x2 = jnp.split(xh, 2, axis=-1)
        return jnp.concatenate([x1 * cos - x2 * sin, x2 * cos + x1 * sin], axis=-1)

    return jnp.concatenate([rot(x[..., :half], pos_row), rot(x[..., half:], pos_col)], axis=-1)


def ctx_attention(q, k, v, sink=None):
    B, C, Hq, dh = q.shape
    Hkv = k.shape[2]
    G = Hq // Hkv
    qg = q.reshape(B, C, Hkv, G, dh) * (dh ** -0.5)
    s = jnp.einsum('bqkgd,bskd->bkgqs', qg, k).astype(jnp.float32)
    if sink is not None:
        sk = jnp.broadcast_to(sink.reshape(Hkv, G)[None, :, :, None, None].astype(jnp.float32), s.shape[:-1] + (1,))
        p = softmax_f32(jnp.concatenate([s, sk], axis=-1))[..., :-1]
    else:
        p = softmax_f32(s)
    o = jnp.einsum('bkgqs,bskd->bqkgd', p.astype(v.dtype), v)
    return o.reshape(B, C, Hq * dh)


def neighbourhood_attention(q, k, v, kc, vc, rpb):
    B, S, H, dh = q.shape
    rows = S // GRID_W
    kh = min(NA_KH, rows)
    qg = (q * (dh ** -0.5)).reshape(B, rows, GRID_W, H, dh)
    kg = k.reshape(B, rows, GRID_W, H, dh)
    vg = v.reshape(B, rows, GRID_W, H, dh)
    row_start = jnp.clip(jnp.arange(rows) - kh // 2, 0, rows - kh)
    col_start = jnp.clip(jnp.arange(GRID_W) - NA_KW // 2, 0, GRID_W - NA_KW)
    col_idx = col_start[:, None] + jnp.arange(NA_KW)[None, :]
    col_off = col_idx - jnp.arange(GRID_W)[:, None] + (NA_KW - 1)
    n_nb = kh * NA_KW

    def one_row(args):
        q_r, r, rs = args
        k_rows = lax.dynamic_slice_in_dim(kg, rs, kh, axis=1)
        v_rows = lax.dynamic_slice_in_dim(vg, rs, kh, axis=1)
        k_nb = k_rows[:, :, col_idx]
        v_nb = v_rows[:, :, col_idx]
        row_off = rs + jnp.arange(kh) - r + (NA_KH - 1)
        bias = rpb[:, row_off[None, :, None], col_off[:, None, :]]
        s_nb = jnp.einsum('bqhd,baqkhd->bhqak', q_r, k_nb).astype(jnp.float32) + bias[None].astype(jnp.float32)
        s_nb = s_nb.reshape(B, H, GRID_W, n_nb)
        s_ctx = jnp.einsum('bqhd,bchd->bhqc', q_r, kc).astype(jnp.float32)
        p = softmax_f32(jnp.concatenate([s_nb, s_ctx], axis=-1))
        p_nb = p[..., :n_nb].reshape(B, H, GRID_W, kh, NA_KW).astype(v.dtype)
        p_ctx = p[..., n_nb:].astype(v.dtype)
        return (jnp.einsum('bhqak,baqkhd->bqhd', p_nb, v_nb)
                + jnp.einsum('bhqc,bchd->bqhd', p_ctx, vc))

    out = lax.map(one_row, (jnp.moveaxis(qg, 1, 0), jnp.arange(rows), row_start))
    return jnp.moveaxis(out, 0, 1).reshape(B, S, H * dh)


def global_attention(q, k, v, kc, vc):
    B, S, Hq, dh = q.shape
    Hkv = k.shape[2]
    G = Hq // Hkv
    keys = jnp.concatenate([k, kc], axis=1)
    vals = jnp.concatenate([v, vc], axis=1)
    qb = (q * (dh ** -0.5)).reshape(B, S // Q_BLOCK, Q_BLOCK, Hkv, G, dh)

    def one_block(q_blk):
        s = jnp.einsum('bqkgd,bskd->bkgqs', q_blk, keys).astype(jnp.float32)
        p = softmax_f32(s).astype(vals.dtype)
        return jnp.einsum('bkgqs,bskd->bqkgd', p, vals)

    out = lax.map(one_block, jnp.moveaxis(qb, 1, 0))
    return jnp.moveaxis(out, 0, 1).reshape(B, S, Hq * dh)


def window_attention(q, k, v, kc, vc, sink):
    B, S, Hq, dh = q.shape
    Hkv = k.shape[2]
    G = Hq // Hkv
    C = kc.shape[1]
    nb = S // Q_BLOCK
    span = Q_BLOCK + 2 * WINDOW
    pad = ((0, 0), (WINDOW, WINDOW), (0, 0), (0, 0))
    kp = jnp.pad(k, pad)
    vp = jnp.pad(v, pad)
    qb = (q * (dh ** -0.5)).reshape(B, nb, Q_BLOCK, Hkv, G, dh)
    rel = jnp.arange(span)[None, :] - WINDOW - jnp.arange(Q_BLOCK)[:, None]
    in_band = jnp.abs(rel) <= WINDOW
    sink_l = sink.reshape(Hkv, G).astype(jnp.float32)

    def one_block(args):
        q_blk, i = args
        start = i * Q_BLOCK
        k_blk = lax.dynamic_slice_in_dim(kp, start, span, axis=1)
        v_blk = lax.dynamic_slice_in_dim(vp, start, span, axis=1)
        key_pos = start - WINDOW + jnp.arange(span)
        valid = in_band & ((key_pos >= 0) & (key_pos < S))[None, :]
        s_win = jnp.einsum('bqkgd,bskd->bkgqs', q_blk, k_blk).astype(jnp.float32)
        s_win = jnp.where(valid, s_win, NEG_INF)
        s_ctx = jnp.einsum('bqkgd,bskd->bkgqs', q_blk, kc).astype(jnp.float32)
        s_sink = jnp.broadcast_to(sink_l[None, :, :, None, None], s_win.shape[:-1] + (1,))
        p = softmax_f32(jnp.concatenate([s_win, s_ctx, s_sink], axis=-1))
        p_win = p[..., :span].astype(v.dtype)
        p_ctx = p[..., span:span + C].astype(v.dtype)
        return (jnp.einsum('bkgqs,bskd->bqkgd', p_win, v_blk)
                + jnp.einsum('bkgqs,bskd->bqkgd', p_ctx, vc))

    out = lax.map(one_block, (jnp.moveaxis(qb, 1, 0), jnp.arange(nb)))
    return jnp.moveaxis(out, 0, 1).reshape(B, S, Hq * dh)


def split_cols(p):
    offs = [int(o) for o in np.cumsum(IN_SPLITS)[:-1]]
    return jnp.split(p, offs, axis=-1)


def project(h, w_in, qnorm_b, knorm_b):
    B, T, _ = h.shape
    qa, ka, va, qb, kb, vb, qc, kc, vc, gates = split_cols(h @ w_in)

    def heads(t, n):
        return t.reshape(B, T, n, HEAD_DIM)

    return (heads(qa, NA_HEADS), heads(ka, NA_HEADS), heads(va, NA_HEADS),
            rmsnorm(heads(qb, GA_HEADS), qnorm_b), rmsnorm(heads(kb, GA_KV_HEADS), knorm_b), heads(vb, GA_KV_HEADS),
            heads(qc, WA_HEADS), heads(kc, WA_KV_HEADS), heads(vc, WA_KV_HEADS), gates)


def merge_branches(o_a, o_b, o_c, gates, w_br_a, w_br_b, w_br_c, w_out):
    B, T, _ = o_a.shape
    g = jax.nn.sigmoid(gates.astype(jnp.float32)).astype(o_a.dtype).reshape(B, T, N_BRANCH, D_MODEL)
    m = g[:, :, 0] * (o_a @ w_br_a) + g[:, :, 1] * (o_b @ w_br_b) + g[:, :, 2] * (o_c @ w_br_c)
    return m @ w_out


def token_mixers(h, hc, w_in, rpb_a, qnorm_b, knorm_b, sink_c, w_br_a, w_br_b, w_br_c, w_out,
                 pos_row, pos_col, ctx_out):
    qa, ka, va, qb, kb, vb, qc, kc, vc, g = project(h, w_in, qnorm_b, knorm_b)
    qa_c, ka_c, va_c, qb_c, kb_c, vb_c, qc_c, kc_c, vc_c, g_c = project(hc, w_in, qnorm_b, knorm_b)
    o_a = neighbourhood_attention(qa, ka, va, ka_c, va_c, rpb_a)
    o_b = global_attention(rope_2d(qb, pos_row, pos_col), rope_2d(kb, pos_row, pos_col), vb, kb_c, vb_c)
    o_c = window_attention(rope_2d(qc, pos_row, pos_col), rope_2d(kc, pos_row, pos_col), vc, kc_c, vc_c, sink_c)
    y = merge_branches(o_a, o_b, o_c, g, w_br_a, w_br_b, w_br_c, w_out)
    if not ctx_out:
        return y, None
    oc_a = ctx_attention(qa_c, ka_c, va_c)
    oc_b = ctx_attention(qb_c, kb_c, vb_c)
    oc_c = ctx_attention(qc_c, kc_c, vc_c, sink_c)
    yc = merge_branches(oc_a, oc_b, oc_c, g_c, w_br_a, w_br_b, w_br_c, w_out)
    return y, yc


def peer_ffn(h, wq, keys, u, v):
    B, T, D = h.shape
    nb = T // PEER_BLOCK
    half = PEER_DKEY // 2
    hb = jnp.moveaxis(h.reshape(B, nb, PEER_BLOCK, D), 1, 0)

    def one_block(h_blk):
        q = (h_blk @ wq).reshape(B, PEER_BLOCK, PEER_HEADS, 2, half)
        s = jnp.einsum('bthpd,hpnd->bthpn', q, keys).astype(jnp.float32)
        s1, i1 = lax.top_k(s[..., 0, :], PEER_TOPK)
        s2, i2 = lax.top_k(s[..., 1, :], PEER_TOPK)
        cand_s = (s1[..., :, None] + s2[..., None, :]).reshape(B, PEER_BLOCK, PEER_HEADS, PEER_TOPK * PEER_TOPK)
        cand_i = (i1[..., :, None] * PEER_NKEYS + i2[..., None, :]).reshape(B, PEER_BLOCK, PEER_HEADS, PEER_TOPK * PEER_TOPK)
        top_s, pos = lax.top_k(cand_s, PEER_TOPK)
        idx = jnp.take_along_axis(cand_i, pos, axis=-1)
        gw = softmax_f32(top_s).astype(h.dtype)
        ue = u[idx]
        act = jax.nn.gelu(jnp.einsum('btd,bthkd->bthk', h_blk, ue))
        ve = v[idx]
        return jnp.einsum('bthk,bthkd->btd', gw * act, ve)

    out = lax.map(one_block, hb)
    return jnp.moveaxis(out, 0, 1).reshape(B, T, D)


def setup_inputs(seed: int = 0) -> dict:
    key = jax.random.key(seed)
    ks = jax.random.split(key, 22)
    L, D = DEPTH, D_MODEL

    def nrm(k, shape, scale):
        return jax.random.normal(k, shape, jnp.float32) * scale

    return {
        "x": nrm(ks[0], (BATCH, SEQ, D), 1.0),
        "c": nrm(ks[1], (BATCH, D), 1.0),
        "ctx": nrm(ks[2], (BATCH, CTX_LEN, D), 1.0),
        "c_ctx": nrm(ks[3], (D,), 1.0),
        "w_mod": nrm(ks[4], (L, D, N_MOD * D), 0.5 * D ** -0.5),
        "b_mod": nrm(ks[5], (L, N_MOD * D), 0.02),
        "norm1_g": 1.0 + nrm(ks[6], (L, D), 0.02),
        "norm2_g": 1.0 + nrm(ks[7], (L, D), 0.02),
        "w_in": nrm(ks[8], (L, D, IN_COLS), D ** -0.5),
        "rpb_a": nrm(ks[9], (L, NA_HEADS, 2 * NA_KH - 1, 2 * NA_KW - 1), 0.1),
        "qnorm_b": 1.0 + nrm(ks[10], (L, HEAD_DIM), 0.02),
        "knorm_b": 1.0 + nrm(ks[11], (L, HEAD_DIM), 0.02),
        "sink_c": nrm(ks[12], (L, WA_HEADS), 0.5),
        "w_br_a": nrm(ks[13], (L, A_W, D), A_W ** -0.5),
        "w_br_b": nrm(ks[14], (L, B_QW, D), B_QW ** -0.5),
        "w_br_c": nrm(ks[15], (L, C_QW, D), C_QW ** -0.5),
        "w_out": nrm(ks[16], (L, D, D), D ** -0.5),
        "peer_wq": nrm(ks[17], (L, D, PEER_HEADS * PEER_DKEY), D ** -0.5),
        "peer_keys": nrm(ks[18], (L, PEER_HEADS, 2, PEER_NKEYS, PEER_DKEY // 2), (PEER_DKEY // 2) ** -0.5),
        "peer_u": nrm(ks[19], (L, PEER_EXPERTS, D), D ** -0.5),
        "peer_v": nrm(ks[20], (L, PEER_EXPERTS, D), 0.5),
        "final_g": 1.0 + nrm(ks[21], (D,), 0.02),
    }


def reference(x, c, ctx, c_ctx, w_mod, b_mod, norm1_g, norm2_g, w_in, rpb_a, qnorm_b, knorm_b, sink_c,
              w_br_a, w_br_b, w_br_c, w_out, peer_wq, peer_keys, peer_u, peer_v, final_g):
    B, S, D = x.shape
    C = ctx.shape[1]
    t = jnp.arange(S)
    pos_row = (t // GRID_W).astype(jnp.float32)
    pos_col = (t % GRID_W).astype(jnp.float32)
    for l in range(DEPTH):
        ctx_out = l < DEPTH - 1
        mod = jax.nn.silu(c) @ w_mod[l] + b_mod[l]
        mod_c = jax.nn.silu(c_ctx) @ w_mod[l] + b_mod[l]
        sh1, sc1, g1, sh2, sc2, g2 = [m[:, None, :] for m in jnp.split(mod, N_MOD, axis=-1)]
        sh1c, sc1c, g1c, sh2c, sc2c, g2c = jnp.split(mod_c, N_MOD, axis=-1)
        h = modulate(rmsnorm(x, norm1_g[l]), sh1, sc1)
        hc = modulate(rmsnorm(ctx, norm1_g[l]), sh1c, sc1c)
        y, yc = token_mixers(h, hc, w_in[l], rpb_a[l], qnorm_b[l], knorm_b[l], sink_c[l],
                             w_br_a[l], w_br_b[l], w_br_c[l], w_out[l], pos_row, pos_col, ctx_out)
        x = x + g1 * y
        h2 = modulate(rmsnorm(x, norm2_g[l]), sh2, sc2)
        if ctx_out:
            ctx = ctx + g1c * yc
            h2c = modulate(rmsnorm(ctx, norm2_g[l]), sh2c, sc2c)
            f = peer_ffn(jnp.concatenate([h2c, h2], axis=1), peer_wq[l], peer_keys[l], peer_u[l], peer_v[l])
            ctx = ctx + g2c * f[:, :C]
            x = x + g2 * f[:, C:]
        else:
            x = x + g2 * peer_ffn(h2, peer_wq[l], peer_keys[l], peer_u[l], peer_v[l])
    return rmsnorm(x, final_g)
```

```cpp
#include <hip/hip_runtime.h>
#include <stdint.h>
#include <stdio.h>

constexpr int D = 2048, S = 16384, CT = 256, MT = S + CT, NL = 2;
constexpr int NCOL = 10752, NQKV = 4608, NGATE = 6144, NMOD = 12288;
constexpr int QA = 0, KA = 768, VA = 1536, QB = 2304, KB = 3072, VB = 3328, QC = 3584, KC = 4096, VC = 4352;
constexpr float EPS = 1e-6f;
constexpr float QSCALE = 0.08838834764831845f;

typedef unsigned short bf16_t;
typedef short bf16x8 __attribute__((ext_vector_type(8)));
typedef float f32x4 __attribute__((ext_vector_type(4)));

__device__ __forceinline__ float bf2f(unsigned b) { return __uint_as_float((b & 0xffffu) << 16); }
__device__ __forceinline__ bf16_t f2bf(float f) { unsigned u = __float_as_uint(f); u += 0x7fffu + ((u >> 16) & 1u); return (bf16_t)(u >> 16); }
__device__ __forceinline__ unsigned pk2(float lo, float hi) { return (unsigned)f2bf(lo) | ((unsigned)f2bf(hi) << 16); }
__device__ __forceinline__ float wsum(float v) { for (int o = 32; o >= 1; o >>= 1) v += __shfl_xor(v, o); return v; }
__device__ __forceinline__ float wmax(float v) { for (int o = 32; o >= 1; o >>= 1) v = fmaxf(v, __shfl_xor(v, o)); return v; }
__device__ __forceinline__ float silu_f(float x) { return x / (1.f + __expf(-x)); }
__device__ __forceinline__ float sigmoid_f(float x) { return 1.f / (1.f + __expf(-x)); }
__device__ __forceinline__ float gelu_tanh(float x) { const float u = 0.7978845608028654f * (x + 0.044715f * x * x * x); return 0.5f * x * (1.f + tanhf(u)); }

constexpr size_t MiB = 1u << 20;
constexpr size_t WS_CTL = 0;
constexpr size_t WS_MOD = 1 * MiB;
constexpr size_t WS_WIN = 2 * MiB;
constexpr size_t WS_WBR = 44 * MiB;
constexpr size_t WS_WOUT = 52 * MiB;
constexpr size_t WS_WQ = 60 * MiB;
constexpr size_t WS_X = 68 * MiB;
constexpr size_t WS_H = 198 * MiB;
constexpr size_t WS_QKV = 263 * MiB;
constexpr size_t WS_G = 410 * MiB;
constexpr size_t WS_O = 605 * MiB;
constexpr size_t WS_MF = 670 * MiB;
constexpr size_t WS_MB = 800 * MiB;
constexpr size_t WS_IDX = 865 * MiB;
constexpr size_t WS_GWT = 874 * MiB;
constexpr size_t WS_END = 883 * MiB;

__global__ __launch_bounds__(256) void k_modvec(const float* __restrict__ c, const float* __restrict__ c_ctx, const float* __restrict__ w_mod,
                                                const float* __restrict__ b_mod, float* __restrict__ MOD) {
    __shared__ float s0[2048], s1[2048];
    for (int i = threadIdx.x; i < 2048; i += 256) { s0[i] = silu_f(c[i]); s1[i] = silu_f(c_ctx[i]); }
    __syncthreads();
    const int gid = blockIdx.x * 256 + threadIdx.x, l = gid / NMOD, n = gid % NMOD;
    const float* w = w_mod + (size_t)l * 2048 * NMOD + n;
    float a0 = 0.f, a1 = 0.f;
#pragma unroll 8
    for (int k = 0; k < 2048; ++k) { const float wv = w[(size_t)k * NMOD]; a0 += s0[k] * wv; a1 += s1[k] * wv; }
    const float b = b_mod[l * NMOD + n];
    MOD[(l * 2 + 0) * NMOD + n] = a0 + b; MOD[(l * 2 + 1) * NMOD + n] = a1 + b;
}

__global__ __launch_bounds__(256) void k_cvt_T(const float* __restrict__ W, int K, int N, bf16_t* __restrict__ WT, int ldt, int koff) {
    __shared__ float t[32][33];
    const int tx = threadIdx.x & 31, ty = threadIdx.x >> 5, n0 = blockIdx.x * 32, k0 = blockIdx.y * 32;
    for (int i = ty; i < 32; i += 8) t[i][tx] = W[(size_t)(k0 + i) * N + n0 + tx];
    __syncthreads();
    for (int i = ty; i < 32; i += 8) WT[(size_t)(n0 + i) * ldt + koff + k0 + tx] = f2bf(t[tx][i]);
}

template <int MODE>
__global__ __launch_bounds__(256) void k_norm_mod(const float* __restrict__ xlat, const float* __restrict__ xctx, const float* __restrict__ gnorm,
                                                  const float* __restrict__ MODl, int sh_off, int sc_off, bf16_t* __restrict__ Hb, float* __restrict__ Hf) {
    const int wave = threadIdx.x >> 6, lane = threadIdx.x & 63, row = blockIdx.x * 4 + wave;
    const float* xr = row < S ? xlat + (size_t)row * D : xctx + (size_t)(row - S) * D;
    const float* md = MODl + (row < S ? 0 : NMOD);
    float4 v[8]; float ss = 0.f;
#pragma unroll
    for (int i = 0; i < 8; ++i) { v[i] = *(const float4*)(xr + 4 * lane + 256 * i); ss += v[i].x * v[i].x + v[i].y * v[i].y + v[i].z * v[i].z + v[i].w * v[i].w; }
    ss = wsum(ss);
    const float rs = rsqrtf(ss * (1.f / D) + EPS);
#pragma unroll
    for (int i = 0; i < 8; ++i) {
        const int col = 4 * lane + 256 * i;
        const float4 g = *(const float4*)(gnorm + col), sh = *(const float4*)(md + sh_off + col), sc = *(const float4*)(md + sc_off + col);
        float4 o;
        o.x = v[i].x * rs * g.x * (1.f + sc.x) + sh.x; o.y = v[i].y * rs * g.y * (1.f + sc.y) + sh.y;
        o.z = v[i].z * rs * g.z * (1.f + sc.z) + sh.z; o.w = v[i].w * rs * g.w * (1.f + sc.w) + sh.w;
        if (MODE == 0) { uint2 p; p.x = pk2(o.x, o.y); p.y = pk2(o.z, o.w); *(uint2*)(Hb + (size_t)row * D + col) = p; }
        else *(float4*)(Hf + (size_t)row * D + col) = o;
    }
}

template <class Epi>
__global__ __launch_bounds__(256) void k_gemm_bf16(const bf16_t* __restrict__ A, int lda, const bf16_t* __restrict__ Bt, int ldb, int K, Epi epi) {
    __shared__ __attribute__((aligned(16))) bf16_t sA[128][40];
    __shared__ __attribute__((aligned(16))) bf16_t sB[128][40];
    const int tid = threadIdx.x, wave = tid >> 6, lane = tid & 63, wr = wave >> 1, wc = wave & 1, fr = lane & 15, fq = lane >> 4;
    const int m0 = blockIdx.y * 128, n0 = blockIdx.x * 128;
    f32x4 acc[4][4];
#pragma unroll
    for (int m = 0; m < 4; ++m)
#pragma unroll
        for (int n = 0; n < 4; ++n) acc[m][n] = (f32x4){0.f, 0.f, 0.f, 0.f};
    const int lr = tid >> 2, lc = (tid & 3) * 8;
    for (int k0 = 0; k0 < K; k0 += 32) {
        const uint4 a0 = *(const uint4*)(A + (size_t)(m0 + lr) * lda + k0 + lc), a1 = *(const uint4*)(A + (size_t)(m0 + 64 + lr) * lda + k0 + lc);
        const uint4 b0 = *(const uint4*)(Bt + (size_t)(n0 + lr) * ldb + k0 + lc), b1 = *(const uint4*)(Bt + (size_t)(n0 + 64 + lr) * ldb + k0 + lc);
        __syncthreads();
        *(uint4*)&sA[lr][lc] = a0; *(uint4*)&sA[64 + lr][lc] = a1; *(uint4*)&sB[lr][lc] = b0; *(uint4*)&sB[64 + lr][lc] = b1;
        __syncthreads();
        bf16x8 af[4], bfr[4];
#pragma unroll
        for (int m = 0; m < 4; ++m) af[m] = *(const bf16x8*)&sA[wr * 64 + m * 16 + fr][fq * 8];
#pragma unroll
        for (int n = 0; n < 4; ++n) bfr[n] = *(const bf16x8*)&sB[wc * 64 + n * 16 + fr][fq * 8];
#pragma unroll
        for (int m = 0; m < 4; ++m)
#pragma unroll
            for (int n = 0; n < 4; ++n) acc[m][n] = __builtin_amdgcn_mfma_f32_16x16x32_bf16(bfr[n], af[m], acc[m][n], 0, 0, 0);
    }
#pragma unroll
    for (int m = 0; m < 4; ++m)
#pragma unroll
        for (int n = 0; n < 4; ++n) epi(m0 + wr * 64 + m * 16 + fr, n0 + wc * 64 + n * 16 + fq * 4, acc[m][n]);
}

template <class Epi>
__global__ __launch_bounds__(256) void k_gemm_f32(const float* __restrict__ A, int lda, const float* __restrict__ B, int ldb, int K, Epi epi) {
    __shared__ __attribute__((aligned(16))) float sA[128][20];
    __shared__ __attribute__((aligned(16))) float sB[16][132];
    const int tid = threadIdx.x, wave = tid >> 6, lane = tid & 63, wr = wave >> 1, wc = wave & 1, fr = lane & 15, fq = lane >> 4;
    const int m0 = blockIdx.y * 128, n0 = blockIdx.x * 128;
    f32x4 acc[4][4];
#pragma unroll
    for (int m = 0; m < 4; ++m)
#pragma unroll
        for (int n = 0; n < 4; ++n) acc[m][n] = (f32x4){0.f, 0.f, 0.f, 0.f};
    const int ar = tid >> 2, ac = (tid & 3) * 4, bk = tid >> 5, bn = (tid & 31) * 4;
    for (int k0 = 0; k0 < K; k0 += 16) {
        const float4 a0 = *(const float4*)(A + (size_t)(m0 + ar) * lda + k0 + ac), a1 = *(const float4*)(A + (size_t)(m0 + 64 + ar) * lda + k0 + ac);
        const float4 b0 = *(const float4*)(B + (size_t)(k0 + bk) * ldb + n0 + bn), b1 = *(const float4*)(B + (size_t)(k0 + 8 + bk) * ldb + n0 + bn);
        __syncthreads();
        *(float4*)&sA[ar][ac] = a0; *(float4*)&sA[64 + ar][ac] = a1; *(float4*)&sB[bk][bn] = b0; *(float4*)&sB[8 + bk][bn] = b1;
        __syncthreads();
#pragma unroll
        for (int kk = 0; kk < 4; ++kk) {
            float af[4], bfr[4];
#pragma unroll
            for (int m = 0; m < 4; ++m) af[m] = sA[wr * 64 + m * 16 + fr][kk * 4 + fq];
#pragma unroll
            for (int n = 0; n < 4; ++n) bfr[n] = sB[kk * 4 + fq][wc * 64 + n * 16 + fr];
#pragma unroll
            for (int m = 0; m < 4; ++m)
#pragma unroll
                for (int n = 0; n < 4; ++n) acc[m][n] = __builtin_amdgcn_mfma_f32_16x16x4f32(bfr[n], af[m], acc[m][n], 0, 0, 0);
        }
    }
#pragma unroll
    for (int m = 0; m < 4; ++m)
#pragma unroll
        for (int n = 0; n < 4; ++n) epi(m0 + wr * 64 + m * 16 + fr, n0 + wc * 64 + n * 16 + fq * 4, acc[m][n]);
}

struct EpiInproj {
    bf16_t* QKV; bf16_t* G;
    __device__ __forceinline__ void operator()(int row, int col, f32x4 v) const {
        if (col < NQKV) { uint2 p; p.x = pk2(v[0], v[1]); p.y = pk2(v[2], v[3]); *(uint2*)(QKV + (size_t)row * NQKV + col) = p; }
        else { uint2 p; p.x = pk2(sigmoid_f(v[0]), sigmoid_f(v[1])); p.y = pk2(sigmoid_f(v[2]), sigmoid_f(v[3])); *(uint2*)(G + (size_t)row * NGATE + (col - NQKV)) = p; }
    }
};
struct EpiBranch {
    const bf16_t* G; float* MF; bf16_t* MB; int gi; int mode;
    __device__ __forceinline__ void operator()(int row, int col, f32x4 v) const {
        const uint2 gp = *(const uint2*)(G + (size_t)row * NGATE + gi * D + col);
        f32x4 g = {bf2f(gp.x), bf2f(gp.x >> 16), bf2f(gp.y), bf2f(gp.y >> 16)};
        f32x4 r = g * v;
        float* mp = MF + (size_t)row * D + col;
        if (mode >= 1) r += *(const f32x4*)mp;
        if (mode <= 1) *(f32x4*)mp = r;
        else { uint2 p; p.x = pk2(r[0], r[1]); p.y = pk2(r[2], r[3]); *(uint2*)(MB + (size_t)row * D + col) = p; }
    }
};
struct EpiOut {
    const float* blat; const float* bctx; const float* MODl; float* X;
    __device__ __forceinline__ void operator()(int row, int col, f32x4 v) const {
        const float* b = row < S ? blat + (size_t)row * D : bctx + (size_t)(row - S) * D;
        const f32x4 g1 = *(const f32x4*)(MODl + (row < S ? 0 : NMOD) + 2 * D + col);
        *(f32x4*)(X + (size_t)row * D + col) = *(const f32x4*)(b + col) + g1 * v;
    }
};
struct EpiStoreF32 {
    float* C; int ldc; int pad;
    __device__ __forceinline__ void operator()(int row, int col, f32x4 v) const { *(f32x4*)(C + (size_t)row * ldc + col) = v; }
};

__global__ __launch_bounds__(256) void k_qk_post(bf16_t* __restrict__ QKV, const float* __restrict__ qnorm, const float* __restrict__ knorm) {
    const int wave = threadIdx.x >> 6, lane = threadIdx.x & 63, gw = blockIdx.x * 4 + wave;
    const int row = gw / 14, slot = gw % 14;
    int col0; const float* g = nullptr;
    if (slot < 6) { col0 = QB + 128 * slot; g = qnorm; } else if (slot < 8) { col0 = KB + 128 * (slot - 6); g = knorm; }
    else if (slot < 12) col0 = QC + 128 * (slot - 8); else col0 = KC + 128 * (slot - 12);
    const int i = lane & 31, half = lane >> 5;
    bf16_t* p = QKV + (size_t)row * NQKV + col0 + half * 64;
    float x1 = bf2f(p[i]), x2 = bf2f(p[32 + i]);
    if (g) { const float ss = wsum(x1 * x1 + x2 * x2); const float rs = rsqrtf(ss * (1.f / 128.f) + EPS); x1 = x1 * rs * g[half * 64 + i]; x2 = x2 * rs * g[half * 64 + 32 + i]; }
    if (row < S) {
        const float pos = (float)(half == 0 ? (row >> 6) : (row & 63));
        const float inv = powf(10000.f, -(float)i / 32.f);
        float sn, cs; sincosf(pos * inv, &sn, &cs);
        const float y1 = x1 * cs - x2 * sn, y2 = x2 * cs + x1 * sn; x1 = y1; x2 = y2;
    }
    p[i] = f2bf(x1); p[32 + i] = f2bf(x2);
}

template <int KIND> struct AK {
    static constexpr int BR = KIND % 3;
    static constexpr int NH = BR == 2 ? 4 : 6, GQ = BR == 0 ? 1 : (BR == 1 ? 3 : 2);
    static constexpr int QCOL = BR == 0 ? QA : (BR == 1 ? QB : QC), KCOL = BR == 0 ? KA : (BR == 1 ? KB : KC), VCOL = BR == 0 ? VA : (BR == 1 ? VB : VC);
    static constexpr int OCOL = BR == 0 ? 0 : (BR == 1 ? 768 : 1536);
    static constexpr int NT = KIND == 0 ? 6 : (KIND == 1 ? 260 : (KIND == 2 ? 9 : 4));
};
template <int KIND>
__device__ __forceinline__ int attn_tok(int s, int t, int h, int r, int c, int rs, int cs, const float* rpb, bool& valid, float& bias) {
    valid = true; bias = 0.f;
    if (KIND == 0) {
        if (s < 128) { const int a = s >> 4, kk = s & 15, kr = rs + a, kc = cs + kk; bias = rpb[(h * 15 + (kr - r + 7)) * 31 + (kc - c + 15)]; return kr * 64 + kc; }
        return S + (s - 128);
    } else if (KIND == 1) { return s; }
    else if (KIND == 2) {
        if (s < 320) { const int pos = t - 128 + s; valid = (pos >= 0) && (pos < S) && (s <= 256); return valid ? pos : 0; }
        return S + (s - 320);
    } else return S + s;
}
template <int KIND>
__global__ __launch_bounds__(256) void k_attn_naive(const bf16_t* __restrict__ QKV, const float* __restrict__ rpb, const float* __restrict__ sink, bf16_t* __restrict__ O) {
    typedef AK<KIND> P;
    __shared__ __attribute__((aligned(16))) float sq[4][128];
    __shared__ float sp[4][64];
    const int wave = threadIdx.x >> 6, lane = threadIdx.x & 63, gw = blockIdx.x * 4 + wave;
    const int qi = gw / P::NH, h = gw % P::NH, t = (KIND >= 3) ? S + qi : qi, kvh = h / P::GQ;
    const bf16_t* qp = QKV + (size_t)t * NQKV + P::QCOL + h * 128;
    sq[wave][lane] = bf2f(qp[lane]) * QSCALE; sq[wave][lane + 64] = bf2f(qp[lane + 64]) * QSCALE;
    __syncthreads();
    const int r = t >> 6, c = t & 63, rs = min(max(r - 4, 0), 248), cs = min(max(c - 8, 0), 48);
    float m = -1e30f, lsum = 0.f, o0 = 0.f, o1 = 0.f;
    for (int tile = 0; tile < P::NT; ++tile) {
        bool valid; float bias; const int tok = attn_tok<KIND>(tile * 64 + lane, t, h, r, c, rs, cs, rpb, valid, bias);
        float sc = -1e30f;
        if (valid) {
            const uint4* kp = (const uint4*)(QKV + (size_t)tok * NQKV + P::KCOL + kvh * 128);
            float acc = 0.f;
#pragma unroll 4
            for (int d8 = 0; d8 < 16; ++d8) { const uint4 kv = kp[d8]; const float4 q0 = *(const float4*)&sq[wave][d8 * 8], q1 = *(const float4*)&sq[wave][d8 * 8 + 4];
                acc += q0.x * bf2f(kv.x) + q0.y * bf2f(kv.x >> 16) + q0.z * bf2f(kv.y) + q0.w * bf2f(kv.y >> 16) + q1.x * bf2f(kv.z) + q1.y * bf2f(kv.z >> 16) + q1.z * bf2f(kv.w) + q1.w * bf2f(kv.w >> 16); }
            sc = acc + bias;
        }
        const float mn = fmaxf(m, wmax(sc)), alpha = __expf(m - mn), p = valid ? __expf(sc - mn) : 0.f;
        lsum = lsum * alpha + wsum(p); o0 *= alpha; o1 *= alpha; m = mn;
        __syncthreads();
        sp[wave][lane] = p;
        __syncthreads();
        for (int k = 0; k < 64; ++k) {
            const float pk = sp[wave][k];
            if (pk != 0.f) { bool v2; float b2; const int tk = attn_tok<KIND>(tile * 64 + k, t, h, r, c, rs, cs, rpb, v2, b2);
                const unsigned w = *(const unsigned*)(QKV + (size_t)tk * NQKV + P::VCOL + kvh * 128 + 2 * lane); o0 += pk * bf2f(w); o1 += pk * bf2f(w >> 16); }
        }
    }
    if (P::BR == 2) { const float sk = sink[h], mn = fmaxf(m, sk), alpha = __expf(m - mn); lsum = lsum * alpha + __expf(sk - mn); o0 *= alpha; o1 *= alpha; }
    const float inv = 1.f / lsum;
    *(unsigned*)(O + (size_t)t * D + P::OCOL + h * 128 + 2 * lane) = pk2(o0 * inv, o1 * inv);
}

__device__ __forceinline__ void wave_argmax(float& v, int& i) {
    for (int o = 32; o >= 1; o >>= 1) { const float ov = __shfl_xor(v, o); const int oi = __shfl_xor(i, o); if (ov > v || (ov == v && oi < i)) { v = ov; i = oi; } }
}
__global__ __launch_bounds__(256) void k_peer_select(const float* __restrict__ QPF, const float* __restrict__ keys, int* __restrict__ IDX, float* __restrict__ GWT) {
    __shared__ __attribute__((aligned(16))) float sq[4][256];
    __shared__ float ss[4][32]; __shared__ int si[4][32];
    const int wave = threadIdx.x >> 6, lane = threadIdx.x & 63, gw = blockIdx.x * 4 + wave, token = gw >> 3, h = gw & 7;
#pragma unroll
    for (int j = 0; j < 4; ++j) sq[wave][lane + 64 * j] = QPF[(size_t)token * D + h * 256 + lane + 64 * j];
    __syncthreads();
    float sc[2][2];
#pragma unroll
    for (int p = 0; p < 2; ++p)
#pragma unroll
        for (int r = 0; r < 2; ++r) {
            const float4* kp = (const float4*)(keys + ((size_t)((h * 2 + p) * 128 + lane + 64 * r)) * 128);
            float acc = 0.f;
#pragma unroll 8
            for (int d4 = 0; d4 < 32; ++d4) { const float4 kv = kp[d4]; const float4 q = *(const float4*)&sq[wave][p * 128 + d4 * 4]; acc += q.x * kv.x + q.y * kv.y + q.z * kv.z + q.w * kv.w; }
            sc[p][r] = acc;
        }
#pragma unroll
    for (int p = 0; p < 2; ++p) {
        float v0 = sc[p][0], v1 = sc[p][1];
        for (int k = 0; k < 16; ++k) {
            float bv; int bi; if (v0 >= v1) { bv = v0; bi = lane; } else { bv = v1; bi = lane + 64; }
            wave_argmax(bv, bi);
            if (lane == 0) { ss[wave][p * 16 + k] = bv; si[wave][p * 16 + k] = bi; }
            if (bi == lane) v0 = -INFINITY; else if (bi == lane + 64) v1 = -INFINITY;
        }
    }
    __syncthreads();
    float cv[4];
#pragma unroll
    for (int r = 0; r < 4; ++r) { const int ci = lane + 64 * r; cv[r] = ss[wave][ci >> 4] + ss[wave][16 + (ci & 15)]; }
    float my_s = 0.f; int my_i = 0;
    for (int k = 0; k < 16; ++k) {
        float bv = cv[0]; int bi = lane;
#pragma unroll
        for (int r = 1; r < 4; ++r) if (cv[r] > bv) { bv = cv[r]; bi = lane + 64 * r; }
        wave_argmax(bv, bi);
        if (lane == k) { my_s = bv; my_i = bi; }
#pragma unroll
        for (int r = 0; r < 4; ++r) if (bi == lane + 64 * r) cv[r] = -INFINITY;
    }
    const float mx = __shfl(my_s, 0);
    const float e = lane < 16 ? __expf(my_s - mx) : 0.f;
    const float sum = wsum(e);
    if (lane < 16) { IDX[(size_t)token * 128 + h * 16 + lane] = si[wave][my_i >> 4] * 128 + si[wave][16 + (my_i & 15)]; GWT[(size_t)token * 128 + h * 16 + lane] = e / sum; }
}
__global__ __launch_bounds__(256) void k_peer_expert(const float* __restrict__ H2F, const int* __restrict__ IDX, const float* __restrict__ GWT, const float* __restrict__ U,
                                                     const float* __restrict__ V, const float* __restrict__ MODl, float* __restrict__ X) {
    const int wave = threadIdx.x >> 6, lane = threadIdx.x & 63, row = blockIdx.x * 4 + wave;
    float4 hv[8], acc[8];
#pragma unroll
    for (int i = 0; i < 8; ++i) { hv[i] = *(const float4*)(H2F + (size_t)row * D + 4 * lane + 256 * i); acc[i] = make_float4(0.f, 0.f, 0.f, 0.f); }
    for (int j = 0; j < 128; ++j) {
        const int e = IDX[(size_t)row * 128 + j]; const float w = GWT[(size_t)row * 128 + j];
        const float4* up = (const float4*)(U + (size_t)e * D) + lane; const float4* vp = (const float4*)(V + (size_t)e * D) + lane;
        float d = 0.f; float4 vv[8];
#pragma unroll
        for (int i = 0; i < 8; ++i) { const float4 u = up[64 * i]; d += hv[i].x * u.x + hv[i].y * u.y + hv[i].z * u.z + hv[i].w * u.w; }
#pragma unroll
        for (int i = 0; i < 8; ++i) vv[i] = vp[64 * i];
        d = wsum(d);
        const float a = gelu_tanh(d) * w;
#pragma unroll
        for (int i = 0; i < 8; ++i) { acc[i].x += a * vv[i].x; acc[i].y += a * vv[i].y; acc[i].z += a * vv[i].z; acc[i].w += a * vv[i].w; }
    }
    const float* md = MODl + (row < S ? 0 : NMOD) + 5 * D;
#pragma unroll
    for (int i = 0; i < 8; ++i) {
        const int col = 4 * lane + 256 * i; const float4 g = *(const float4*)(md + col); float4* xp = (float4*)(X + (size_t)row * D + col); float4 x = *xp;
        x.x += g.x * acc[i].x; x.y += g.y * acc[i].y; x.z += g.z * acc[i].z; x.w += g.w * acc[i].w; *xp = x;
    }
}
__global__ __launch_bounds__(256) void k_final(const float* __restrict__ X, const float* __restrict__ g, float* __restrict__ out) {
    const int wave = threadIdx.x >> 6, lane = threadIdx.x & 63, row = blockIdx.x * 4 + wave;
    float4 v[8]; float ss = 0.f;
#pragma unroll
    for (int i = 0; i < 8; ++i) { v[i] = *(const float4*)(X + (size_t)row * D + 4 * lane + 256 * i); ss += v[i].x * v[i].x + v[i].y * v[i].y + v[i].z * v[i].z + v[i].w * v[i].w; }
    ss = wsum(ss);
    const float rs = rsqrtf(ss * (1.f / D) + EPS);
#pragma unroll
    for (int i = 0; i < 8; ++i) { const int col = 4 * lane + 256 * i; const float4 gg = *(const float4*)(g + col);
        *(float4*)(out + (size_t)row * D + col) = make_float4(v[i].x * rs * gg.x, v[i].y * rs * gg.y, v[i].z * rs * gg.z, v[i].w * rs * gg.w); }
}

extern "C" void kernel_launch(void* const* d_in, const int* in_sizes, int n_in, void* d_out, int out_size, void* d_ws, size_t ws_size, hipStream_t stream) {
    if (n_in != 22 || ws_size < WS_END) { fprintf(stderr, "kernel_launch: bad args n_in %d ws %zu\n", n_in, ws_size); return; }
    const float* x = (const float*)d_in[0]; const float* c = (const float*)d_in[1]; const float* ctx = (const float*)d_in[2]; const float* c_ctx = (const float*)d_in[3];
    const float* w_mod = (const float*)d_in[4]; const float* b_mod = (const float*)d_in[5]; const float* norm1_g = (const float*)d_in[6]; const float* norm2_g = (const float*)d_in[7];
    const float* w_in = (const float*)d_in[8]; const float* rpb_a = (const float*)d_in[9]; const float* qnorm_b = (const float*)d_in[10]; const float* knorm_b = (const float*)d_in[11];
    const float* sink_c = (const float*)d_in[12]; const float* w_br_a = (const float*)d_in[13]; const float* w_br_b = (const float*)d_in[14]; const float* w_br_c = (const float*)d_in[15];
    const float* w_out = (const float*)d_in[16]; const float* peer_wq = (const float*)d_in[17]; const float* peer_keys = (const float*)d_in[18]; const float* peer_u = (const float*)d_in[19];
    const float* peer_v = (const float*)d_in[20]; const float* final_g = (const float*)d_in[21];
    char* ws = (char*)d_ws;
    float* MOD = (float*)(ws + WS_MOD); bf16_t* WIN = (bf16_t*)(ws + WS_WIN); bf16_t* WBR = (bf16_t*)(ws + WS_WBR); bf16_t* WOUT = (bf16_t*)(ws + WS_WOUT);
    float* X = (float*)(ws + WS_X); bf16_t* H = (bf16_t*)(ws + WS_H); bf16_t* QKV = (bf16_t*)(ws + WS_QKV); float* QPF = (float*)(ws + WS_QKV);
    bf16_t* G = (bf16_t*)(ws + WS_G); bf16_t* O = (bf16_t*)(ws + WS_O); float* MF = (float*)(ws + WS_MF); float* H2F = (float*)(ws + WS_MF); bf16_t* MB = (bf16_t*)(ws + WS_MB);
    int* IDX = (int*)(ws + WS_IDX); float* GWT = (float*)(ws + WS_GWT);

    k_modvec<<<NL * NMOD / 256, 256, 0, stream>>>(c, c_ctx, w_mod, b_mod, MOD);
    for (int l = 0; l < NL; ++l) {
        const float* MODl = MOD + (size_t)l * 2 * NMOD;
        const float* xl = l == 0 ? x : X; const float* xc = l == 0 ? ctx : X + (size_t)S * D;
        k_cvt_T<<<dim3(NCOL / 32, D / 32), 256, 0, stream>>>(w_in + (size_t)l * D * NCOL, D, NCOL, WIN, D, 0);
        k_cvt_T<<<dim3(D / 32, 768 / 32), 256, 0, stream>>>(w_br_a + (size_t)l * 768 * D, 768, D, WBR, D, 0);
        k_cvt_T<<<dim3(D / 32, 768 / 32), 256, 0, stream>>>(w_br_b + (size_t)l * 768 * D, 768, D, WBR, D, 768);
        k_cvt_T<<<dim3(D / 32, 512 / 32), 256, 0, stream>>>(w_br_c + (size_t)l * 512 * D, 512, D, WBR, D, 1536);
        k_cvt_T<<<dim3(D / 32, D / 32), 256, 0, stream>>>(w_out + (size_t)l * D * D, D, D, WOUT, D, 0);
        k_norm_mod<0><<<MT / 4, 256, 0, stream>>>(xl, xc, norm1_g + l * D, MODl, 0, D, H, nullptr);
        k_gemm_bf16<EpiInproj><<<dim3(NCOL / 128, MT / 128), 256, 0, stream>>>(H, D, WIN, D, D, EpiInproj{QKV, G});
        k_qk_post<<<MT * 14 / 4, 256, 0, stream>>>(QKV, qnorm_b + l * 128, knorm_b + l * 128);
        k_attn_naive<0><<<S * 6 / 4, 256, 0, stream>>>(QKV, rpb_a + (size_t)l * 6 * 15 * 31, sink_c + l * 4, O);
        k_attn_naive<1><<<S * 6 / 4, 256, 0, stream>>>(QKV, rpb_a, sink_c + l * 4, O);
        k_attn_naive<2><<<S * 4 / 4, 256, 0, stream>>>(QKV, rpb_a, sink_c + l * 4, O);
        int rows = S;
        if (l < NL - 1) {
            rows = MT;
            k_attn_naive<3><<<CT * 6 / 4, 256, 0, stream>>>(QKV, rpb_a, sink_c + l * 4, O);
            k_attn_naive<4><<<CT * 6 / 4, 256, 0, stream>>>(QKV, rpb_a, sink_c + l * 4, O);
            k_attn_naive<5><<<CT * 4 / 4, 256, 0, stream>>>(QKV, rpb_a, sink_c + l * 4, O);
        }
        k_gemm_bf16<EpiBranch><<<dim3(D / 128, rows / 128), 256, 0, stream>>>(O, D, WBR, D, 768, EpiBranch{G, MF, MB, 0, 0});
        k_gemm_bf16<EpiBranch><<<dim3(D / 128, rows / 128), 256, 0, stream>>>(O + 768, D, WBR + 768, D, 768, EpiBranch{G, MF, MB, 1, 1});
        k_gemm_bf16<EpiBranch><<<dim3(D / 128, rows / 128), 256, 0, stream>>>(O + 1536, D, WBR + 1536, D, 512, EpiBranch{G, MF, MB, 2, 2});
        k_gemm_bf16<EpiOut><<<dim3(D / 128, rows / 128), 256, 0, stream>>>(MB, D, WOUT, D, D, EpiOut{xl, xc, MODl, X});
        k_norm_mod<1><<<rows / 4, 256, 0, stream>>>(X, X + (size_t)S * D, norm2_g + l * D, MODl, 3 * D, 4 * D, nullptr, H2F);
        k_gemm_f32<EpiStoreF32><<<dim3(D / 128, rows / 128), 256, 0, stream>>>(H2F, D, peer_wq + (size_t)l * D * D, D, D, EpiStoreF32{QPF, D, 0});
        k_peer_select<<<rows * 8 / 4, 256, 0, stream>>>(QPF, peer_keys + (size_t)l * 8 * 2 * 128 * 128, IDX, GWT);
        k_peer_expert<<<rows / 4, 256, 0, stream>>>(H2F, IDX, GWT, peer_u + (size_t)l * 16384 * D, peer_v + (size_t)l * 16384 * D, MODl, X);
    }
    k_final<<<S / 4, 256, 0, stream>>>(X, final_g, (float*)d_out);
}
```

```cpp
#include <hip/hip_runtime.h>
#include <stdint.h>
#include <stdio.h>
#ifndef MK_PARTSPLIT
#define MK_PARTSPLIT 0
#endif

constexpr int D = 2048, S = 16384, CT = 256, MT = S + CT, NL = 2;
constexpr int NCOL = 10752, NQKV = 4608, NGATE = 6144, NMOD = 12288;
constexpr int QA = 0, KA = 768, VA = 1536, QB = 2304, KB = 3072, VB = 3328, QC = 3584, KC = 4096, VC = 4352;
constexpr float EPS = 1e-6f;
constexpr float QSCALE = 0.08838834764831845f;

typedef unsigned short bf16_t;
typedef short bf16x8 __attribute__((ext_vector_type(8)));
typedef float f32x4 __attribute__((ext_vector_type(4)));

__device__ __forceinline__ float bf2f(unsigned b) { return __uint_as_float((b & 0xffffu) << 16); }
__device__ __forceinline__ bf16_t f2bf(float f) { unsigned u = __float_as_uint(f); u += 0x7fffu + ((u >> 16) & 1u); return (bf16_t)(u >> 16); }
__device__ __forceinline__ unsigned pk2(float lo, float hi) { return (unsigned)f2bf(lo) | ((unsigned)f2bf(hi) << 16); }
template <int CTRL> __device__ __forceinline__ float dpp_mov_f(float v) { return __builtin_bit_cast(float, __builtin_amdgcn_update_dpp(0, __builtin_bit_cast(int, v), CTRL, 0xF, 0xF, true)); }
__device__ __forceinline__ float swz16_f(float v) { return __builtin_bit_cast(float, __builtin_amdgcn_ds_swizzle(__builtin_bit_cast(int, v), 0x401F)); }
__device__ __forceinline__ float wsum(float v) {
    v += dpp_mov_f<0xB1>(v); v += dpp_mov_f<0x4E>(v); v += dpp_mov_f<0x141>(v); v += dpp_mov_f<0x140>(v); v += swz16_f(v);
    return __builtin_bit_cast(float, __builtin_amdgcn_readlane(__builtin_bit_cast(int, v), 0)) + __builtin_bit_cast(float, __builtin_amdgcn_readlane(__builtin_bit_cast(int, v), 32)); }
__device__ __forceinline__ float wmax(float v) {
    v = fmaxf(v, dpp_mov_f<0xB1>(v)); v = fmaxf(v, dpp_mov_f<0x4E>(v)); v = fmaxf(v, dpp_mov_f<0x141>(v)); v = fmaxf(v, dpp_mov_f<0x140>(v)); v = fmaxf(v, swz16_f(v));
    return fmaxf(__builtin_bit_cast(float, __builtin_amdgcn_readlane(__builtin_bit_cast(int, v), 0)), __builtin_bit_cast(float, __builtin_amdgcn_readlane(__builtin_bit_cast(int, v), 32))); }
__device__ __forceinline__ int shxl_i(int v, int M, int lane) { return __builtin_amdgcn_ds_bpermute((lane ^ M) << 2, v); }
__device__ __forceinline__ float shxl_f(float v, int M, int lane) { return __builtin_bit_cast(float, shxl_i(__builtin_bit_cast(int, v), M, lane)); }
__device__ __forceinline__ float silu_f(float x) { return x / (1.f + __expf(-x)); }
__device__ __forceinline__ float sigmoid_f(float x) { return 1.f / (1.f + __expf(-x)); }
__device__ __forceinline__ float gelu_tanh(float x) { const float u = 0.7978845608028654f * (x + 0.044715f * x * x * x); return 0.5f * x * (1.f + tanhf(u)); }

constexpr size_t MiB = 1u << 20;
__device__ __forceinline__ void wave_argmax(float& v, int& i) {
    for (int o = 32; o >= 1; o >>= 1) { const float ov = __shfl_xor(v, o); const int oi = __shfl_xor(i, o); if (ov > v || (ov == v && oi < i)) { v = ov; i = oi; } }
}
constexpr int ARG_OFF = 156672;
__device__ __forceinline__ int grid_x() { unsigned base = ARG_OFF; asm volatile("" : "+v"(base)); const __attribute__((address_space(3))) unsigned* p = (const __attribute__((address_space(3))) unsigned*)(size_t)base; unsigned v = p[48]; asm volatile("" : "+v"(v)); return (int)__builtin_amdgcn_readfirstlane(v); }

namespace pg8 {
#define PG8_LAS __attribute__((address_space(3)))
typedef unsigned u32x4 __attribute__((ext_vector_type(4)));
constexpr int BM = 256, BK = 64, HALF = 128, HTB = HALF * BK * 2, STAGE_BYTES = 8 * HTB, NXCD = 8, WGM = 8;
__host__ __device__ __forceinline__ int lds_byte(int r, int c) { const int st = (r >> 4) * 2 + (c >> 5), rr = r & 15, cc = c & 31, ob = rr * 64 + cc * 2; return st * 1024 + (ob ^ (((ob >> 9) & 1) << 5)); }
__host__ __device__ __forceinline__ void stage_rc(int b, int& R, int& C) { const int st = b / 1024, sb = b % 1024, swz = sb ^ (((sb >> 9) & 1) << 5); R = (st >> 1) * 16 + swz / 64; C = (st & 1) * 32 + (swz % 64) / 2; }
__host__ __device__ __forceinline__ int perm32(int rho) { const int n = rho >> 4, i = rho & 15; return 8 * (i >> 2) + 4 * n + (i & 3); }
struct Unit { int pm, pn; };
struct Gemm { const bf16_t* A; const bf16_t* Bt; };
struct StaticOrder {
    int nM, nN, nwg, G, c;
    __device__ void init(int M, int N, int G_, int c_) { nM = M / BM; nN = N / BM; nwg = nM * nN; G = G_; c = c_; }
    __device__ bool next(int i, Unit& u) const {
        const long L = (long)i * G + c; if (L >= nwg) return false;
        int wgid = (int)L; { const int q = nwg / NXCD, r = nwg % NXCD, xcd = wgid % NXCD, off = wgid / NXCD; wgid = (xcd < r ? xcd * (q + 1) : r * (q + 1) + (xcd - r) * q) + off; }
        const int nig = WGM * nN, gid = wgid / nig, fm = gid * WGM, gsz = (nM - fm) < WGM ? (nM - fm) : WGM;
        u.pm = fm + ((wgid % nig) % gsz); u.pn = (wgid % nig) / gsz; return true;
    }
};
__device__ __forceinline__ unsigned cvt_pk_bf16(float lo, float hi) { unsigned r; asm volatile("v_cvt_pk_bf16_f32 %0, %1, %2" : "=v"(r) : "v"(lo), "v"(hi)); return r; }
typedef _Float16 f16x8 __attribute__((ext_vector_type(8)));
template <bool F16> __device__ __forceinline__ f32x4 mma16(bf16x8 a, bf16x8 b, f32x4 c) {
    if constexpr (F16) return __builtin_amdgcn_mfma_f32_16x16x32_f16(__builtin_bit_cast(f16x8, a), __builtin_bit_cast(f16x8, b), c, 0, 0, 0);
    else return __builtin_amdgcn_mfma_f32_16x16x32_bf16(a, b, c, 0, 0, 0); }
template <int KMAP> __device__ __forceinline__ size_t koffA(int t) { return KMAP == 0 ? (size_t)t * 128 : (size_t)(t & 31) * 128 + (((t >> 5) == 1) ? 4096 : 0); }
template <int KMAP> __device__ __forceinline__ size_t koffB(int t) { return KMAP == 0 ? (size_t)t * 128 : (size_t)(t & 31) * 128 + (((t >> 5) == 2) ? 4096 : 0); }

template <class Epi, class Sched, int KMAP, int LDA, int LDB, int NT, bool F16 = false>
__device__ __forceinline__ void gemm_phase(PG8_LAS unsigned char* lds, const Gemm g, const Sched& S, const Epi& E, int tid) {
    const int wid = __builtin_amdgcn_readfirstlane(tid >> 6), lane = tid & 63, wr = wid >> 2, wc = wid & 3, fr = lane & 15, fq = lane >> 4;
    constexpr int nt = NT;
    unsigned voffA[2], voffB[2];
#pragma unroll
    for (int i = 0; i < 2; ++i) { int R, C; stage_rc(tid * 16 + i * 8192, R, C); const int Rb = Epi::PERM ? ((R & ~31) + perm32(R & 31)) : R;
        voffA[i] = (unsigned)(R * LDA + C) * 2u; voffB[i] = (unsigned)(Rb * LDB + C) * 2u; }
    constexpr size_t kstep = (size_t)(BK * 2);
    constexpr size_t hstepA = (size_t)HALF * LDA * 2, hstepB = (size_t)HALF * LDB * 2, tstepA = 2 * hstepA, tstepB = 2 * hstepB;
    const unsigned ldsw = (unsigned)wid * 1024u;
    const int aoff = lds_byte(wr * 64 + fr, fq * 8), boff = lds_byte(wc * 32 + fr, fq * 8);
#define PG8_SA(b, h) (((b) * 2 + (h)) * HTB)
#define PG8_SB(b, h) ((4 + (b) * 2 + (h)) * HTB)
#define PG8_STAGE(bufoff, gbase, voff) do { _Pragma("unroll") for (int _i = 0; _i < 2; ++_i) \
        __builtin_amdgcn_global_load_lds((const unsigned*)((const char*)(gbase) + (voff)[_i]), (PG8_LAS unsigned*)(lds + (bufoff) + ldsw + _i * 8192), 16, 0, 0); } while (0)
#define PG8_LDA(dst, b, h) do { _Pragma("unroll") for (int m = 0; m < 4; ++m) _Pragma("unroll") for (int k = 0; k < 2; ++k) dst[m][k] = *(const PG8_LAS bf16x8*)(lds + PG8_SA(b, h) + aoff + m * 2048 + k * 1024); } while (0)
#define PG8_LDB(dst, b, h) do { _Pragma("unroll") for (int n = 0; n < 2; ++n) _Pragma("unroll") for (int k = 0; k < 2; ++k) dst[n][k] = *(const PG8_LAS bf16x8*)(lds + PG8_SB(b, h) + boff + n * 2048 + k * 1024); } while (0)
#define PG8_MMA(ai, bj, At, Bt) do { __builtin_amdgcn_s_setprio(1); _Pragma("unroll") for (int m = 0; m < 4; ++m) _Pragma("unroll") for (int n = 0; n < 2; ++n) _Pragma("unroll") for (int k = 0; k < 2; ++k) \
        acc[ai][bj][m][n] = mma16<F16>(Bt[n][k], At[m][k], acc[ai][bj][m][n]); __builtin_amdgcn_s_setprio(0); } while (0)
#define PG8_WAIT_V(n) asm volatile("s_waitcnt vmcnt(" #n ")" ::: "memory")
#define PG8_WAIT_L(n) asm volatile("s_waitcnt lgkmcnt(" #n ")" ::: "memory")
#define PG8_BAR __builtin_amdgcn_s_barrier()
#define PG8_SCHED __builtin_amdgcn_sched_barrier(0)
    Unit cur, nxt; int ui = 0;
    if (!S.next(0, cur)) return;
    f32x4 acc[2][2][4][2];
#pragma unroll
    for (int a = 0; a < 2; ++a)
#pragma unroll
        for (int b = 0; b < 2; ++b)
#pragma unroll
            for (int m = 0; m < 4; ++m)
#pragma unroll
                for (int n = 0; n < 2; ++n) acc[a][b][m][n] = (f32x4){0.f, 0.f, 0.f, 0.f};
    bf16x8 At[4][2], B0[2][2], B1[2][2];
    const char* cA = (const char*)g.A + (size_t)cur.pm * tstepA; const char* cB = (const char*)g.Bt + (size_t)cur.pn * tstepB;
    PG8_STAGE(PG8_SB(0, 0), cB, voffB); PG8_STAGE(PG8_SB(0, 1), cB + hstepB, voffB); PG8_STAGE(PG8_SA(0, 0), cA, voffA); PG8_STAGE(PG8_SA(0, 1), cA + hstepA, voffA);
    if (wr == 1) PG8_BAR;
    PG8_WAIT_V(2); PG8_BAR;
    PG8_STAGE(PG8_SB(1, 0), cB + kstep, voffB); PG8_STAGE(PG8_SA(1, 0), cA + kstep, voffA); PG8_STAGE(PG8_SB(1, 1), cB + hstepB + kstep, voffB);
    PG8_WAIT_V(6); PG8_BAR;
    for (;;) {
        const bool has_next = S.next(ui + 1, nxt);
        const char* nA = has_next ? (const char*)g.A + (size_t)nxt.pm * tstepA : cA; const char* nB = has_next ? (const char*)g.Bt + (size_t)nxt.pn * tstepB : cB;
        for (int t = 0; t < nt; t += 2) {
            const bool last = (t == nt - 2);
            const char* a1 = cA + koffA<KMAP>(t) + kstep;
            const char* a2 = last ? nA : cA + koffA<KMAP>(t + 2); const char* b2 = last ? nB : cB + koffB<KMAP>(t + 2);
            const char* a3 = a2 + kstep; const char* b3 = b2 + kstep;
            if constexpr (Epi::HAS_MID) { if (t == Epi::MID1 || t == Epi::MID2) E.mid(acc, cur, t, tid); }
            PG8_LDB(B0, 0, 0); PG8_LDB(B1, 0, 1); PG8_SCHED; PG8_LDA(At, 0, 0); PG8_STAGE(PG8_SA(1, 1), a1 + hstepA, voffA);
            PG8_WAIT_V(8); PG8_WAIT_L(0); PG8_BAR; PG8_MMA(0, 0, At, B0); PG8_MMA(0, 1, At, B1); PG8_BAR; PG8_SCHED;
            PG8_LDA(At, 0, 1); PG8_STAGE(PG8_SB(0, 0), b2, voffB); PG8_STAGE(PG8_SB(0, 1), b2 + hstepB, voffB); PG8_STAGE(PG8_SA(0, 0), a2, voffA);
            PG8_WAIT_V(8); PG8_WAIT_L(0); PG8_BAR; PG8_MMA(1, 0, At, B0); PG8_MMA(1, 1, At, B1); PG8_BAR; PG8_SCHED;
            PG8_LDB(B0, 1, 0); PG8_LDB(B1, 1, 1); PG8_SCHED; PG8_LDA(At, 1, 0); PG8_STAGE(PG8_SA(0, 1), a2 + hstepA, voffA);
            PG8_WAIT_V(8); PG8_WAIT_L(0); PG8_BAR; PG8_MMA(0, 0, At, B0); PG8_MMA(0, 1, At, B1); PG8_BAR; PG8_SCHED;
            PG8_LDA(At, 1, 1); PG8_STAGE(PG8_SB(1, 0), b3, voffB); PG8_STAGE(PG8_SB(1, 1), b3 + hstepB, voffB); PG8_STAGE(PG8_SA(1, 0), a3, voffA);
            PG8_WAIT_V(8); PG8_WAIT_L(0); PG8_BAR; PG8_MMA(1, 0, At, B0); PG8_MMA(1, 1, At, B1); PG8_BAR; PG8_SCHED;
        }
        if (wr == 0) PG8_BAR;
        E(acc, cur, tid);
        if (!has_next) break;
#pragma unroll
        for (int a = 0; a < 2; ++a)
#pragma unroll
            for (int b = 0; b < 2; ++b)
#pragma unroll
                for (int m = 0; m < 4; ++m)
#pragma unroll
                    for (int n = 0; n < 2; ++n) acc[a][b][m][n] = (f32x4){0.f, 0.f, 0.f, 0.f};
        cur = nxt; cA = nA; cB = nB; ++ui;
        if (wr == 1) PG8_BAR;
    }
    PG8_WAIT_V(0);
    PG8_BAR;
#undef PG8_SA
#undef PG8_SB
#undef PG8_STAGE
#undef PG8_LDA
#undef PG8_LDB
#undef PG8_MMA
#undef PG8_WAIT_V
#undef PG8_WAIT_L
#undef PG8_BAR
#undef PG8_SCHED
}

typedef const f32x4 (&AccC)[2][2][4][2];
typedef f32x4 (&AccM)[2][2][4][2];
__device__ __forceinline__ u32x4 pack8(f32x4 v0, f32x4 v1) { u32x4 w; w.x = cvt_pk_bf16(v0[0], v0[1]); w.y = cvt_pk_bf16(v0[2], v0[3]); w.z = cvt_pk_bf16(v1[0], v1[1]); w.w = cvt_pk_bf16(v1[2], v1[3]); return w; }
__device__ __forceinline__ f32x4 sig4(f32x4 v) { f32x4 r;
#pragma unroll
    for (int j = 0; j < 4; ++j) r[j] = __builtin_amdgcn_rcpf(1.f + __builtin_amdgcn_exp2f(-1.4426950408889634f * v[j])); return r; }
__device__ __forceinline__ f32x4 unpack_lo4(unsigned a, unsigned b) { return (f32x4){__uint_as_float(a << 16), __uint_as_float(a & 0xffff0000u), __uint_as_float(b << 16), __uint_as_float(b & 0xffff0000u)}; }

struct EpiInprojF {
    static constexpr bool PERM = true, HAS_MID = false;
    bf16_t* QKV; bf16_t* G; const float* qn; const float* kn; const float* rope; PG8_LAS float* xch;
    __device__ __forceinline__ void operator()(AccC acc, const Unit& u, int tid) const {
        const int wid_ = __builtin_amdgcn_readfirstlane(tid >> 6), wr = wid_ >> 2, wc = wid_ & 3, fr = tid & 15, fq = (tid >> 4) & 3;
        const int pn = u.pn, rowb = u.pm * BM + wr * 64 + fr;
        if (pn >= 18) {
#pragma unroll
            for (int ai = 0; ai < 2; ++ai)
#pragma unroll
                for (int m = 0; m < 4; ++m) { bf16_t* rowp = G + (size_t)(rowb + ai * HALF + m * 16) * NGATE + (pn - 18) * BM + wc * 32 + 8 * fq;
#pragma unroll
                    for (int bj = 0; bj < 2; ++bj) *(u32x4*)(rowp + bj * HALF) = pack8(acc[ai][bj][m][0], acc[ai][bj][m][1]); }
            return;
        }
        const bool ropet = (pn >= 9 && pn <= 12) || (pn >= 14 && pn <= 16);
        if (!ropet) {
#pragma unroll
            for (int ai = 0; ai < 2; ++ai)
#pragma unroll
                for (int m = 0; m < 4; ++m) { bf16_t* rowp = QKV + (size_t)(rowb + ai * HALF + m * 16) * NQKV + pn * BM + wc * 32 + 8 * fq;
#pragma unroll
                    for (int bj = 0; bj < 2; ++bj) *(u32x4*)(rowp + bj * HALF) = pack8(acc[ai][bj][m][0], acc[ai][bj][m][1]); }
            return;
        }
        const bool nrm = pn <= 12; const int half = wc & 1;
        float rs[2][4];
        f32x4 gg[2][2];
#pragma unroll
        for (int bj = 0; bj < 2; ++bj)
#pragma unroll
            for (int n = 0; n < 2; ++n) gg[bj][n] = (f32x4){1.f, 1.f, 1.f, 1.f};
#pragma unroll
        for (int ai = 0; ai < 2; ++ai)
#pragma unroll
            for (int m = 0; m < 4; ++m) rs[ai][m] = 1.f;
        if (nrm) {
            const float qsc = (pn <= 11 && u.pm < (S / BM)) ? 0.088388347648318440f * 1.4426950408889634f : 1.f;
            const float* gv = (pn <= 11 ? qn : kn) + 64 * half + 8 * fq;
#pragma unroll
            for (int bj = 0; bj < 2; ++bj)
#pragma unroll
                for (int n = 0; n < 2; ++n) gg[bj][n] = *(const f32x4*)(gv + 32 * bj + 4 * n);
#pragma unroll
            for (int ai = 0; ai < 2; ++ai)
#pragma unroll
                for (int m = 0; m < 4; ++m) { float s = 0.f;
#pragma unroll
                    for (int bj = 0; bj < 2; ++bj)
#pragma unroll
                        for (int n = 0; n < 2; ++n) { const f32x4 x = acc[ai][bj][m][n]; s += (x[0] * x[0] + x[1] * x[1]) + (x[2] * x[2] + x[3] * x[3]); }
                    s += shxl_f(s, 16, tid & 63); s += shxl_f(s, 32, tid & 63);
                    if (fq == 0) xch[(ai * HALF + wr * 64 + m * 16 + fr) * 4 + wc] = s; }
            asm volatile("s_waitcnt lgkmcnt(0)" ::: "memory"); __builtin_amdgcn_s_barrier(); asm volatile("" ::: "memory");
#pragma unroll
            for (int ai = 0; ai < 2; ++ai)
#pragma unroll
                for (int m = 0; m < 4; ++m) { const int rl = ai * HALF + wr * 64 + m * 16 + fr; const float tot = xch[rl * 4 + wc] + xch[rl * 4 + (wc ^ 1)];
                    rs[ai][m] = __builtin_amdgcn_rsqf(tot * (1.f / 128.f) + EPS) * qsc; }
        }
        const bool dorope = u.pm < (S / BM);
#pragma unroll
        for (int ai = 0; ai < 2; ++ai)
#pragma unroll
            for (int m = 0; m < 4; ++m) {
                const int r = rowb + ai * HALF + m * 16;
                const int pos = half == 0 ? ((r >> 6) & 255) : (r & 63);
                const float* rp = rope + (size_t)(pos * 32 + 8 * fq) * 2;
                f32x4 y1[2], y2[2];
#pragma unroll
                for (int n = 0; n < 2; ++n) {
                    f32x4 x1 = acc[ai][0][m][n] * rs[ai][m] * gg[0][n], x2 = acc[ai][1][m][n] * rs[ai][m] * gg[1][n];
                    if (dorope) {
                        const f32x4 cs0 = *(const f32x4*)(rp + 8 * n), cs1 = *(const f32x4*)(rp + 8 * n + 4);
                        const f32x4 cc = {cs0[0], cs0[2], cs1[0], cs1[2]}, sn = {cs0[1], cs0[3], cs1[1], cs1[3]};
                        y1[n] = x1 * cc - x2 * sn; y2[n] = x2 * cc + x1 * sn;
                    } else { y1[n] = x1; y2[n] = x2; }
                }
                bf16_t* rowp = QKV + (size_t)r * NQKV + pn * BM + 64 * wc + 8 * fq;
                *(u32x4*)rowp = pack8(y1[0], y1[1]); *(u32x4*)(rowp + 32) = pack8(y2[0], y2[1]);
            }
    }
};
struct EpiBranchF {
    static constexpr bool PERM = true, HAS_MID = true; static constexpr int MID1 = 12, MID2 = 24;
    const bf16_t* G; bf16_t* MB;
    static __device__ __forceinline__ float ex(float x) { return fminf(__builtin_amdgcn_exp2f(-1.4426950408889634f * x), 1e30f); }
    __device__ __forceinline__ void mid(AccM acc, const Unit& u, int t, int tid) const {
        const int wid_ = __builtin_amdgcn_readfirstlane(tid >> 6), wr = wid_ >> 2, wc = wid_ & 3, fr = tid & 15, fq = (tid >> 4) & 3;
        const int gi = (t == MID1) ? 0 : 1;
        const bf16_t* gb = G + (size_t)(u.pm * BM + wr * 64 + fr) * NGATE + gi * D + u.pn * BM + wc * 32 + 8 * fq;
#pragma unroll
        for (int ai = 0; ai < 2; ++ai)
#pragma unroll
            for (int m = 0; m < 4; ++m) {
#pragma unroll
                for (int bj = 0; bj < 2; ++bj) { const bf16_t* gp = gb + (size_t)(ai * HALF + m * 16) * NGATE + bj * HALF;
                    const u32x4 ga = *(const u32x4*)gp, gc = *(const u32x4*)(gp + D);
                    const f32x4 a0 = unpack_lo4(ga.x, ga.y), a1 = unpack_lo4(ga.z, ga.w), c0 = unpack_lo4(gc.x, gc.y), c1 = unpack_lo4(gc.z, gc.w);
#pragma unroll
                    for (int j = 0; j < 4; ++j) {
                        acc[ai][bj][m][0][j] *= (1.f + ex(c0[j])) * __builtin_amdgcn_rcpf(1.f + ex(a0[j]));
                        acc[ai][bj][m][1][j] *= (1.f + ex(c1[j])) * __builtin_amdgcn_rcpf(1.f + ex(a1[j])); } }
                asm volatile("" ::: "memory");
            }
    }
    __device__ __forceinline__ void operator()(AccC acc, const Unit& u, int tid) const {
        const int wid_ = __builtin_amdgcn_readfirstlane(tid >> 6), wr = wid_ >> 2, wc = wid_ & 3, fr = tid & 15, fq = (tid >> 4) & 3;
        const int rowb = u.pm * BM + wr * 64 + fr, colb = u.pn * BM + wc * 32 + 8 * fq;
#pragma unroll
        for (int ai = 0; ai < 2; ++ai)
#pragma unroll
            for (int m = 0; m < 4; ++m) { const size_t r = (size_t)(rowb + ai * HALF + m * 16);
#pragma unroll
                for (int bj = 0; bj < 2; ++bj) { const u32x4 gc = *(const u32x4*)(G + r * NGATE + 2 * D + colb + bj * HALF);
                    const f32x4 c0 = unpack_lo4(gc.x, gc.y), c1 = unpack_lo4(gc.z, gc.w);
                    *(u32x4*)(MB + r * D + colb + bj * HALF) = pack8(acc[ai][bj][m][0] * sig4(c0), acc[ai][bj][m][1] * sig4(c1)); } }
    }
};
struct EpiOutF {
    static constexpr bool PERM = false, HAS_MID = false;
    const float* blat; const float* bctx; const float* MODl; float* X;
    __device__ __forceinline__ void operator()(AccC acc, const Unit& u, int tid) const {
        const int wid_ = __builtin_amdgcn_readfirstlane(tid >> 6), wr = wid_ >> 2, wc = wid_ & 3, fr = tid & 15, fq = (tid >> 4) & 3;
        const int rowb = u.pm * BM + wr * 64 + fr, colb = u.pn * BM + wc * 32 + 4 * fq; const bool isctx = u.pm >= (S / BM);
        const float* md = MODl + (isctx ? NMOD : 0) + 2 * D + colb;
        f32x4 gv[2][2];
#pragma unroll
        for (int bj = 0; bj < 2; ++bj)
#pragma unroll
            for (int n = 0; n < 2; ++n) gv[bj][n] = *(const f32x4*)(md + bj * HALF + n * 16);
#pragma unroll
        for (int ai = 0; ai < 2; ++ai)
#pragma unroll
            for (int m = 0; m < 4; ++m) { const int r = rowb + ai * HALF + m * 16; const float* bp = (isctx ? bctx + (size_t)(r - S) * D : blat + (size_t)r * D) + colb; float* xp = X + (size_t)r * D + colb;
#pragma unroll
                for (int bj = 0; bj < 2; ++bj)
#pragma unroll
                    for (int n = 0; n < 2; ++n) *(f32x4*)(xp + bj * HALF + n * 16) = *(const f32x4*)(bp + bj * HALF + n * 16) + gv[bj][n] * acc[ai][bj][m][n]; }
    }
};
struct EpiQsplitF {
    static constexpr bool PERM = true, HAS_MID = false;
    bf16_t* QS;
    __device__ __forceinline__ void operator()(AccC acc, const Unit& u, int tid) const {
        const int wid_ = __builtin_amdgcn_readfirstlane(tid >> 6), wr = wid_ >> 2, wc = wid_ & 3, fr = tid & 15, fq = (tid >> 4) & 3;
        const int rowb = u.pm * BM + wr * 64 + fr, colb = u.pn * BM + wc * 32 + 8 * fq;
#pragma unroll
        for (int ai = 0; ai < 2; ++ai)
#pragma unroll
            for (int m = 0; m < 4; ++m) { bf16_t* rp = QS + (size_t)(rowb + ai * HALF + m * 16) * (2 * D) + colb;
#pragma unroll
                for (int bj = 0; bj < 2; ++bj) { const f32x4 v0 = acc[ai][bj][m][0], v1 = acc[ai][bj][m][1]; const u32x4 hi = pack8(v0, v1);
                    const f32x4 h0 = unpack_lo4(hi.x, hi.y), h1 = unpack_lo4(hi.z, hi.w);
                    *(u32x4*)(rp + bj * HALF) = hi; *(u32x4*)(rp + D + bj * HALF) = pack8(v0 - h0, v1 - h1); } }
    }
};
}
template <bool F16 = false>
__device__ __forceinline__ f32x4 ctx_dot(const bf16_t* __restrict__ Ap, const bf16_t* __restrict__ Bp, int nk32) {
    typedef unsigned cuv4 __attribute__((ext_vector_type(4))); typedef __attribute__((address_space(1))) cuv4 CG4;
    f32x4 acc0 = {0.f, 0.f, 0.f, 0.f}, acc1 = {0.f, 0.f, 0.f, 0.f};
    cuv4 a0[8], b0[8], a1[8], b1[8];
#pragma unroll
    for (int i = 0; i < 8; ++i) { a0[i] = *(const CG4*)(Ap + 32 * i); b0[i] = *(const CG4*)(Bp + 32 * i); }
    for (int k = 0; k < nk32; k += 16) {
        const bool more1 = k + 8 < nk32, more2 = k + 16 < nk32;
        if (more1) {
#pragma unroll
            for (int i = 0; i < 8; ++i) { a1[i] = *(const CG4*)(Ap + 32 * (k + 8 + i)); b1[i] = *(const CG4*)(Bp + 32 * (k + 8 + i)); } }
#pragma unroll
        for (int i = 0; i < 8; i += 2) { acc0 = pg8::mma16<F16>(__builtin_bit_cast(bf16x8, b0[i]), __builtin_bit_cast(bf16x8, a0[i]), acc0); acc1 = pg8::mma16<F16>(__builtin_bit_cast(bf16x8, b0[i + 1]), __builtin_bit_cast(bf16x8, a0[i + 1]), acc1); }
        if (more2) {
#pragma unroll
            for (int i = 0; i < 8; ++i) { a0[i] = *(const CG4*)(Ap + 32 * (k + 16 + i)); b0[i] = *(const CG4*)(Bp + 32 * (k + 16 + i)); } }
        if (more1) {
#pragma unroll
            for (int i = 0; i < 8; i += 2) { acc0 = pg8::mma16<F16>(__builtin_bit_cast(bf16x8, b1[i]), __builtin_bit_cast(bf16x8, a1[i]), acc0); acc1 = pg8::mma16<F16>(__builtin_bit_cast(bf16x8, b1[i + 1]), __builtin_bit_cast(bf16x8, a1[i + 1]), acc1); } }
    }
    return acc0 + acc1;
}
template <int MODE>
__device__ __forceinline__ void ctx_gemm(const bf16_t* __restrict__ A, const bf16_t* __restrict__ Bt, const bf16_t* __restrict__ Gr, const float* __restrict__ base, const float* __restrict__ gvec,
                                         void* __restrict__ outp, int tid) {
    const int wave = tid >> 6, lane = tid & 63, fr = lane & 15, fq = lane >> 4;
    for (int item = blockIdx.x; item < 256; item += grid_x()) {
        const int n0 = (item >> 1) * 16, r0 = S + (item & 1) * 128 + wave * 16, row = r0 + fr, col = n0 + 4 * fq;
        if (MODE == 0) {
            const bf16_t* Ap = A + (size_t)row * D + 8 * fq; const bf16_t* Bp = Bt + (size_t)(n0 + fr) * D + 8 * fq;
            const f32x4 aa = ctx_dot(Ap, Bp, 24), ab = ctx_dot(Ap + 768, Bp + 768, 24), ac = ctx_dot(Ap + 1536, Bp + 1536, 16);
            const bf16_t* gp = Gr + (size_t)row * NGATE + col;
            const uint2 g0 = *(const uint2*)gp, g1 = *(const uint2*)(gp + D), g2 = *(const uint2*)(gp + 2 * D);
            const f32x4 s0 = pg8::sig4(pg8::unpack_lo4(g0.x, g0.y)), s1 = pg8::sig4(pg8::unpack_lo4(g1.x, g1.y)), s2 = pg8::sig4(pg8::unpack_lo4(g2.x, g2.y));
            const f32x4 m = s0 * aa + s1 * ab + s2 * ac;
            uint2 p; p.x = pk2(m[0], m[1]); p.y = pk2(m[2], m[3]); *(uint2*)((bf16_t*)outp + (size_t)row * D + col) = p;
        } else if (MODE == 1) {
            const f32x4 acc = ctx_dot(A + (size_t)row * D + 8 * fq, Bt + (size_t)(n0 + fr) * D + 8 * fq, 64);
            const f32x4 b = *(const f32x4*)(base + (size_t)(row - S) * D + col), g = *(const f32x4*)(gvec + col);
            *(f32x4*)((float*)outp + (size_t)row * D + col) = b + g * acc;
        } else {
            const f32x4 acc = ctx_dot<true>(A + (size_t)row * D + 8 * fq, Bt + (size_t)(n0 + fr) * D + 8 * fq, 64);
            uint2 hi; hi.x = pk2(acc[0], acc[1]); hi.y = pk2(acc[2], acc[3]);
            uint2 lo; lo.x = pk2(acc[0] - bf2f(hi.x), acc[1] - bf2f(hi.x >> 16)); lo.y = pk2(acc[2] - bf2f(hi.y), acc[3] - bf2f(hi.y >> 16));
            bf16_t* qp = (bf16_t*)outp + (size_t)row * (2 * D) + col; *(uint2*)qp = hi; *(uint2*)(qp + D) = lo;
        }
    }
}
#define WAVE_LDS_SYNC() asm volatile("s_waitcnt lgkmcnt(0)" ::: "memory")
__device__ __forceinline__ int winperm(int n) {
    const int pn = n >> 8; if (!((pn >= 9 && pn <= 12) || (pn >= 14 && pn <= 16))) return n;
    const int cl = n & 255, wc = cl >> 6, bj = (cl >> 5) & 1, x = cl & 31; return (n & ~255) + 128 * bj + 32 * wc + x;
}
template <int MODE>
__device__ __forceinline__ void cvt_T_phase(const float* __restrict__ W, int K, int N, bf16_t* __restrict__ WT, int ldt, int koff, float* scr, int tid, int b0, int nb) {
    const int nnb = N / 32, nitems = nnb * (K / 64);
    for (int it = b0; it < nitems; it += nb) {
        const int nb = it % nnb, kb = it / nnb, n0 = nb * 32, k0 = kb * 64;
        __syncthreads();
        { const int k = tid >> 3, n4 = (tid & 7) * 4; const float4 v = *(const float4*)(W + (size_t)(k0 + k) * N + n0 + n4); float* d = scr + k * 33 + n4; d[0] = v.x; d[1] = v.y; d[2] = v.z; d[3] = v.w; }
        __syncthreads();
        { const int n = tid >> 4, k4 = (tid & 15) * 4; const float v0 = scr[(k4 + 0) * 33 + n], v1 = scr[(k4 + 1) * 33 + n], v2 = scr[(k4 + 2) * 33 + n], v3 = scr[(k4 + 3) * 33 + n];
          const int dn = MODE == 1 ? winperm(n0 + n) : n0 + n; bf16_t* dp = WT + (size_t)dn * ldt + koff + k0 + k4;
          uint2 h;
          if (MODE == 3) { typedef _Float16 hf2_ __attribute__((ext_vector_type(2))); hf2_ a_; a_.x = (_Float16)v0; a_.y = (_Float16)v1; hf2_ b_; b_.x = (_Float16)v2; b_.y = (_Float16)v3; h.x = __builtin_bit_cast(unsigned, a_); h.y = __builtin_bit_cast(unsigned, b_); }
          else { h.x = pk2(v0, v1); h.y = pk2(v2, v3); }
          *(uint2*)dp = h;
          if (MODE == 2) { uint2 lo; lo.x = pk2(v0 - bf2f(h.x), v1 - bf2f(h.x >> 16)); lo.y = pk2(v2 - bf2f(h.y), v3 - bf2f(h.y >> 16)); *(uint2*)(dp + K) = lo; } }
    }
}
__device__ __forceinline__ void cvt_plain_phase(const float* __restrict__ src, bf16_t* __restrict__ dst, size_t n8, int tid) {
    for (size_t i = (size_t)blockIdx.x * 512 + tid; i < n8; i += (size_t)grid_x() * 512) {
        const float4 a = *(const float4*)(src + i * 8), b = *(const float4*)(src + i * 8 + 4);
        uint4 o; o.x = pk2(a.x, a.y); o.y = pk2(a.z, a.w); o.z = pk2(b.x, b.y); o.w = pk2(b.z, b.w); *(uint4*)(dst + i * 8) = o;
    }
}
__device__ __forceinline__ void rope_table_phase(float* __restrict__ rope, int tid) {
    for (int i = blockIdx.x * 512 + tid; i < 256 * 32; i += grid_x() * 512) {
        const int pos = i >> 5, f = i & 31; const float inv = powf(10000.f, -(float)f / 32.f); float sn, cs; sincosf((float)pos * inv, &sn, &cs);
        rope[2 * i] = cs; rope[2 * i + 1] = sn;
    }
}
__device__ __forceinline__ void modvec_phase(const float* __restrict__ c, const float* __restrict__ c_ctx, const float* __restrict__ w_mod, const float* __restrict__ b_mod, float* __restrict__ MOD, int tid, int l, int b0, int nb) {
    const int wave = tid >> 6, lane = tid & 63;
    for (int item = b0 * 8 + wave; item < NMOD / 12; item += nb * 8) {
        const int n0 = item * 12;
        const float* w = w_mod + n0;
        float a0[12], a1[12];
#pragma unroll
        for (int j = 0; j < 12; ++j) { a0[j] = 0.f; a1[j] = 0.f; }
#pragma unroll 4
        for (int i = 0; i < 32; ++i) { const int k = lane + 64 * i; const float s0 = silu_f(c[k]), s1 = silu_f(c_ctx[k]); const float4* wp = (const float4*)(w + (size_t)k * NMOD);
            const float4 w0 = wp[0], w1 = wp[1], w2 = wp[2]; const float wv[12] = {w0.x, w0.y, w0.z, w0.w, w1.x, w1.y, w1.z, w1.w, w2.x, w2.y, w2.z, w2.w};
#pragma unroll
            for (int j = 0; j < 12; ++j) { a0[j] += s0 * wv[j]; a1[j] += s1 * wv[j]; } }
#pragma unroll
        for (int j = 0; j < 12; ++j) { a0[j] = wsum(a0[j]); a1[j] = wsum(a1[j]); }
        if (lane == 0) {
#pragma unroll
            for (int j = 0; j < 12; ++j) { const float b = b_mod[n0 + j]; MOD[n0 + j] = a0[j] + b; MOD[NMOD + n0 + j] = a1[j] + b; } }
    }
}
template <int OUT>
__device__ __forceinline__ void norm_mod_phase(const float* __restrict__ xlat, const float* __restrict__ xctx, const float* __restrict__ gnorm, const float* __restrict__ MODl,
                                               int sh_off, int sc_off, bf16_t* __restrict__ Hb, _Float16* __restrict__ Hf, int rows, int tid) {
    const int wave = tid >> 6, lane = tid & 63, nw = grid_x() * 8;
    for (int row0 = blockIdx.x * 8 + wave; row0 < rows; row0 += 2 * nw) {
        const int row1 = row0 + nw; const bool has1 = row1 < rows;
        const float* xr0 = row0 < S ? xlat + (size_t)row0 * D : xctx + (size_t)(row0 - S) * D;
        const float* xr1 = has1 ? (row1 < S ? xlat + (size_t)row1 * D : xctx + (size_t)(row1 - S) * D) : xr0;
        float4 v0[8], v1[8]; float ss0 = 0.f, ss1 = 0.f;
#pragma unroll
        for (int i = 0; i < 8; ++i) { v0[i] = *(const float4*)(xr0 + 4 * lane + 256 * i); v1[i] = *(const float4*)(xr1 + 4 * lane + 256 * i); }
#pragma unroll
        for (int i = 0; i < 8; ++i) { ss0 += v0[i].x * v0[i].x + v0[i].y * v0[i].y + v0[i].z * v0[i].z + v0[i].w * v0[i].w; ss1 += v1[i].x * v1[i].x + v1[i].y * v1[i].y + v1[i].z * v1[i].z + v1[i].w * v1[i].w; }
        ss0 = wsum(ss0); ss1 = wsum(ss1);
        const float rs0 = rsqrtf(ss0 * (1.f / D) + EPS), rs1 = rsqrtf(ss1 * (1.f / D) + EPS);
        const float* md0 = MODl + (row0 < S ? 0 : NMOD); const float* md1 = MODl + (row1 < S ? 0 : NMOD);
#pragma unroll
        for (int i = 0; i < 8; ++i) {
            const int col = 4 * lane + 256 * i;
            const float4 g = *(const float4*)(gnorm + col);
#pragma unroll
            for (int r = 0; r < 2; ++r) {
                if (r == 1 && !has1) break;
                const int row = r ? row1 : row0; const float* md = r ? md1 : md0; const float rs = r ? rs1 : rs0; const float4 v = r ? v1[i] : v0[i];
                const float4 sh = *(const float4*)(md + sh_off + col), sc = *(const float4*)(md + sc_off + col);
                float4 o;
                o.x = v.x * rs * g.x * (1.f + sc.x) + sh.x; o.y = v.y * rs * g.y * (1.f + sc.y) + sh.y;
                o.z = v.z * rs * g.z * (1.f + sc.z) + sh.z; o.w = v.w * rs * g.w * (1.f + sc.w) + sh.w;
                uint2 p; p.x = pk2(o.x, o.y); p.y = pk2(o.z, o.w);
                if (OUT == 0) *(uint2*)(Hb + (size_t)row * D + col) = p;
                else if (OUT == 2) { typedef _Float16 hf4_ __attribute__((ext_vector_type(4))); hf4_ hv; hv.x = (_Float16)o.x; hv.y = (_Float16)o.y; hv.z = (_Float16)o.z; hv.w = (_Float16)o.w; *(hf4_*)(Hf + (size_t)row * D + col) = hv; }
                else { uint2 q; q.x = pk2(o.x - bf2f(p.x), o.y - bf2f(p.x >> 16)); q.y = pk2(o.z - bf2f(p.y), o.w - bf2f(p.y >> 16));
                    *(uint2*)(Hb + (size_t)row * (2 * D) + col) = p; *(uint2*)(Hb + (size_t)row * (2 * D) + D + col) = q;
                    typedef _Float16 hf4_ __attribute__((ext_vector_type(4))); hf4_ hv; hv.x = (_Float16)o.x; hv.y = (_Float16)o.y; hv.z = (_Float16)o.z; hv.w = (_Float16)o.w; *(hf4_*)(Hf + (size_t)row * D + col) = hv; }
            }
        }
    }
}
__device__ __forceinline__ void norm2_q_phase(const float* __restrict__ X, const float* __restrict__ gnorm, const float* __restrict__ MODl, _Float16* __restrict__ Hf, signed char* __restrict__ Hq,
                                              float* __restrict__ SH, int rows, int tid) {
    const int wave = tid >> 6, lane = tid & 63, nw = grid_x() * 8;
    for (int rowi = blockIdx.x * 8 + wave; rowi < rows; rowi += 2 * nw) {
        int row0 = rowi; asm volatile("" : "+v"(row0) :: "memory");
        const int row1 = row0 + nw; const bool has1 = row1 < rows; const int row1c = has1 ? row1 : row0;
        float4 v0[8], v1[8]; float ss0 = 0.f, ss1 = 0.f;
#pragma unroll
        for (int i = 0; i < 8; ++i) { v0[i] = *(const float4*)(X + (size_t)row0 * D + 4 * lane + 256 * i); v1[i] = *(const float4*)(X + (size_t)row1c * D + 4 * lane + 256 * i); }
#pragma unroll
        for (int i = 0; i < 8; ++i) { ss0 += v0[i].x * v0[i].x + v0[i].y * v0[i].y + v0[i].z * v0[i].z + v0[i].w * v0[i].w; ss1 += v1[i].x * v1[i].x + v1[i].y * v1[i].y + v1[i].z * v1[i].z + v1[i].w * v1[i].w; }
        ss0 = wsum(ss0); ss1 = wsum(ss1);
        const float rs0 = rsqrtf(ss0 * (1.f / D) + EPS), rs1 = rsqrtf(ss1 * (1.f / D) + EPS);
        const float* md0 = MODl + (row0 < S ? 0 : NMOD); const float* md1 = MODl + (row1c < S ? 0 : NMOD);
        float mx0 = 0.f, mx1 = 0.f;
#pragma unroll
        for (int i = 0; i < 8; ++i) {
            const int col = 4 * lane + 256 * i; const float4 g = *(const float4*)(gnorm + col);
            { const float4 sh = *(const float4*)(md0 + 3 * D + col), sc = *(const float4*)(md0 + 4 * D + col); float4 o;
              o.x = v0[i].x * rs0 * g.x * (1.f + sc.x) + sh.x; o.y = v0[i].y * rs0 * g.y * (1.f + sc.y) + sh.y; o.z = v0[i].z * rs0 * g.z * (1.f + sc.z) + sh.z; o.w = v0[i].w * rs0 * g.w * (1.f + sc.w) + sh.w;
              v0[i] = o; mx0 = fmaxf(mx0, fmaxf(fmaxf(fabsf(o.x), fabsf(o.y)), fmaxf(fabsf(o.z), fabsf(o.w)))); }
            { const float4 sh = *(const float4*)(md1 + 3 * D + col), sc = *(const float4*)(md1 + 4 * D + col); float4 o;
              o.x = v1[i].x * rs1 * g.x * (1.f + sc.x) + sh.x; o.y = v1[i].y * rs1 * g.y * (1.f + sc.y) + sh.y; o.z = v1[i].z * rs1 * g.z * (1.f + sc.z) + sh.z; o.w = v1[i].w * rs1 * g.w * (1.f + sc.w) + sh.w;
              v1[i] = o; mx1 = fmaxf(mx1, fmaxf(fmaxf(fabsf(o.x), fabsf(o.y)), fmaxf(fabsf(o.z), fabsf(o.w)))); }
        }
        mx0 = wmax(mx0); mx1 = wmax(mx1);
        const float s0 = mx0 > 0.f ? mx0 * (1.f / 127.f) : 1.f, s1 = mx1 > 0.f ? mx1 * (1.f / 127.f) : 1.f, i0 = 1.f / s0, i1 = 1.f / s1;
        typedef _Float16 hf4_ __attribute__((ext_vector_type(4)));
#pragma unroll
        for (int i = 0; i < 8; ++i) {
            const int col = 4 * lane + 256 * i;
            { hf4_ hv; hv.x = (_Float16)v0[i].x; hv.y = (_Float16)v0[i].y; hv.z = (_Float16)v0[i].z; hv.w = (_Float16)v0[i].w; *(hf4_*)(Hf + (size_t)row0 * D + col) = hv;
              const unsigned b0 = (unsigned)__float2int_rn(v0[i].x * i0) & 255u, b1 = (unsigned)__float2int_rn(v0[i].y * i0) & 255u, b2 = (unsigned)__float2int_rn(v0[i].z * i0) & 255u, b3 = (unsigned)__float2int_rn(v0[i].w * i0) & 255u;
              *(unsigned*)(Hq + (size_t)row0 * D + col) = b0 | (b1 << 8) | (b2 << 16) | (b3 << 24); }
            if (has1) { hf4_ hv; hv.x = (_Float16)v1[i].x; hv.y = (_Float16)v1[i].y; hv.z = (_Float16)v1[i].z; hv.w = (_Float16)v1[i].w; *(hf4_*)(Hf + (size_t)row1 * D + col) = hv;
              const unsigned b0 = (unsigned)__float2int_rn(v1[i].x * i1) & 255u, b1 = (unsigned)__float2int_rn(v1[i].y * i1) & 255u, b2 = (unsigned)__float2int_rn(v1[i].z * i1) & 255u, b3 = (unsigned)__float2int_rn(v1[i].w * i1) & 255u;
              *(unsigned*)(Hq + (size_t)row1 * D + col) = b0 | (b1 << 8) | (b2 << 16) | (b3 << 24); }
        }
        if (lane == 0) { SH[row0] = s0; if (has1) SH[row1] = s1; }
    }
}
namespace att {
using s16x4  = __attribute__((ext_vector_type(4))) short;
using f32x16 = __attribute__((ext_vector_type(16))) float;
using u32x4  = __attribute__((ext_vector_type(4))) unsigned;
constexpr int KVBLK = 64, QBLK = 32, NW = 8, LDQ = NQKV, LDK = NQKV, LDO = D;
constexpr float SCALE = 0.088388347648318440f, THR = 8.f, C2 = SCALE * 1.4426950408889634f;
constexpr size_t SHM_V = KVBLK * 128 * 2, SHM_K = KVBLK * 128 * 2, SHM_ATTN = 2 * SHM_V + 2 * SHM_K + NW * 64 * 4;
constexpr int RPB_OFF = 68 * 1024;
#define KSWZ(row, colB) ((row) * 256 + ((colB) ^ (((row) & 7) << 4)))
#define SBAR() __builtin_amdgcn_sched_barrier(0)
__device__ __forceinline__ int crow(int r, int hi) { return (r & 3) + 8 * (r >> 2) + 4 * hi; }
__device__ __forceinline__ unsigned cvtpk(float lo, float hi) { unsigned r; asm volatile("v_cvt_pk_bf16_f32 %0, %1, %2" : "=v"(r) : "v"(lo), "v"(hi)); return r; }
__device__ __forceinline__ void partialSM(f32x16& p0, f32x16& p1, float& m_reg, float& mn, float& alpha) {
  float pmax = p0[0]; for (int r = 1; r < 16; ++r) pmax = fmaxf(pmax, p0[r]); for (int r = 0; r < 16; ++r) pmax = fmaxf(pmax, p1[r]);
  { auto rr = __builtin_amdgcn_permlane32_swap(__float_as_uint(pmax), __float_as_uint(pmax), false, false);
    pmax = fmaxf(__uint_as_float(rr[0]), __uint_as_float(rr[1])); }
  if (__builtin_expect(__all(pmax - m_reg <= THR / SCALE), 1)) { mn = m_reg; alpha = 1.f; }
  else { mn = fmaxf(m_reg, pmax); alpha = __builtin_amdgcn_exp2f((m_reg - mn) * C2); m_reg = mn; }
  float mnC = -mn * C2;
  for (int r = 0; r < 16; ++r) p0[r] = fmaf(p0[r], C2, mnC); for (int r = 0; r < 16; ++r) p1[r] = fmaf(p1[r], C2, mnC);
  for (int r = 0; r < 16; ++r) p0[r] = __builtin_amdgcn_exp2f(p0[r]);
}
template <bool SHIFT>
__device__ __forceinline__ void partialSM_fixed(f32x16& p0, f32x16& p1, float m_reg, float& mn, float& alpha) {
  mn = m_reg; alpha = 1.f;
  if constexpr (SHIFT) { const float mnC = -m_reg * C2; for (int r = 0; r < 16; ++r) p0[r] += mnC; for (int r = 0; r < 16; ++r) p1[r] += mnC; }
  for (int r = 0; r < 16; ++r) p0[r] = __builtin_amdgcn_exp2f(p0[r]);
}
__device__ __forceinline__ void finishSM(f32x16& p0, f32x16& p1, float alpha, float& l_reg, bf16x8& pa0, bf16x8& pa1, bf16x8& pa2, bf16x8& pa3) {
  for (int r = 0; r < 16; ++r) p1[r] = __builtin_amdgcn_exp2f(p1[r]);
  float ps = 0; for (int r = 0; r < 16; ++r) ps += p0[r]; for (int r = 0; r < 16; ++r) ps += p1[r];
  { auto rr = __builtin_amdgcn_permlane32_swap(__float_as_uint(ps), __float_as_uint(ps), false, false);
    ps = __uint_as_float(rr[0]) + __uint_as_float(rr[1]); }
  l_reg = l_reg * alpha + ps;
#define PK4(P, BASE, OUT) do { unsigned a0 = cvtpk(P[BASE + 0], P[BASE + 1]), a1 = cvtpk(P[BASE + 2], P[BASE + 3]);   \
    unsigned b0 = cvtpk(P[BASE + 4], P[BASE + 5]), b1 = cvtpk(P[BASE + 6], P[BASE + 7]);                              \
    auto r0 = __builtin_amdgcn_permlane32_swap(a0, b0, false, false); auto r1 = __builtin_amdgcn_permlane32_swap(a1, b1, false, false); \
    u32x4 w = {r0[0], r1[0], r0[1], r1[1]}; OUT = *reinterpret_cast<bf16x8*>(&w); } while (0)
  PK4(p0, 0, pa0); PK4(p0, 8, pa1); PK4(p1, 0, pa2); PK4(p1, 8, pa3);
#undef PK4
}
__device__ __forceinline__ void qkt(f32x16& p0, f32x16& p1, const char* Ks, const bf16x8* qr, int r32, int hi) {
  p0 = f32x16{}; p1 = f32x16{};
  for (int d0 = 0; d0 < 8; ++d0) { int cb = (d0 * 16 + hi * 8) * 2;
    bf16x8 b0 = *reinterpret_cast<const bf16x8*>(Ks + KSWZ(r32, cb));
    bf16x8 b1 = *reinterpret_cast<const bf16x8*>(Ks + KSWZ(32 + r32, cb));
    p0 = __builtin_amdgcn_mfma_f32_32x32x16_bf16(b0, qr[d0], p0, 0, 0, 0);
    p1 = __builtin_amdgcn_mfma_f32_32x32x16_bf16(b1, qr[d0], p1, 0, 0, 0); }
}
__device__ __forceinline__ int v_st(int k, int c) { const int kk = (k & ~0xC) | ((k & 4) << 1) | ((k & 8) >> 1); return ((kk >> 3) * 4 + (c >> 5)) * 512 + ((kk & 7) * 32 + (c & 31)) * 2; }
__device__ __forceinline__ int v_rd_base(int lane) { return ((lane & 3) << 3) | (((lane >> 2) & 3) << 6) | (((lane >> 4) & 1) << 5) | (((lane >> 5) & 1) << 8); }
constexpr int v_rd_off(int d0, int ks, int half) { return d0 * 512 + ks * 4096 + half * 2048; }
template <int OFF> __device__ __forceinline__ s16x4 tr_read(int vb) { s16x4 r; asm volatile("ds_read_b64_tr_b16 %0, %1 offset:%2" : "=&v"(r) : "v"(vb), "i"(OFF) : "memory"); return r; }
template <int D0> __device__ __forceinline__ void pv_one(f32x16& od, int vb, bf16x8 pa0, bf16x8 pa1, bf16x8 pa2, bf16x8 pa3) {
  const s16x4 l0 = tr_read<v_rd_off(D0, 0, 0)>(vb), h0 = tr_read<v_rd_off(D0, 0, 1)>(vb), l1 = tr_read<v_rd_off(D0, 1, 0)>(vb), h1 = tr_read<v_rd_off(D0, 1, 1)>(vb);
  const s16x4 l2 = tr_read<v_rd_off(D0, 2, 0)>(vb), h2 = tr_read<v_rd_off(D0, 2, 1)>(vb), l3 = tr_read<v_rd_off(D0, 3, 0)>(vb), h3 = tr_read<v_rd_off(D0, 3, 1)>(vb);
  asm volatile("s_waitcnt lgkmcnt(0)" ::: "memory"); SBAR();
#define PK(L, H) (bf16x8){L[0], L[1], L[2], L[3], H[0], H[1], H[2], H[3]}
  od = __builtin_amdgcn_mfma_f32_32x32x16_bf16(pa0, PK(l0, h0), od, 0, 0, 0);
  od = __builtin_amdgcn_mfma_f32_32x32x16_bf16(pa1, PK(l1, h1), od, 0, 0, 0);
  od = __builtin_amdgcn_mfma_f32_32x32x16_bf16(pa2, PK(l2, h2), od, 0, 0, 0);
  od = __builtin_amdgcn_mfma_f32_32x32x16_bf16(pa3, PK(l3, h3), od, 0, 0, 0);
#undef PK
}
__device__ __forceinline__ void pv_d0(f32x16* o, int vb, bf16x8 pa0, bf16x8 pa1, bf16x8 pa2, bf16x8 pa3) {
  pv_one<0>(o[0], vb, pa0, pa1, pa2, pa3); pv_one<1>(o[1], vb, pa0, pa1, pa2, pa3); pv_one<2>(o[2], vb, pa0, pa1, pa2, pa3); pv_one<3>(o[3], vb, pa0, pa1, pa2, pa3);
}
struct UnitP { int q0, nt, kstart, nlat, r0, hq; float sinkl2, mfix; int j0; float* pmine; const float* pother; unsigned* cnt; };
template <int KIND> __device__ __forceinline__ int krow_of(const UnitP& u, int j) {
  if (KIND == 1) return 64 * (u.j0 + j);
  if (KIND == 3) return S + 64 * j;
  return j < u.nlat ? u.kstart + 64 * j : S + 64 * (j - u.nlat);
}
template <int KIND> __device__ __forceinline__ bool tile_on(const UnitP& u, int j, int wid) {
  if (KIND == 0) { if (j >= u.nlat) return true; const int kr = u.kstart / 64 + j, qr = u.r0 + (wid >> 1), rsq = min(max(qr - 4, 0), 248); return kr >= rsq && kr < rsq + 8; }
  if (KIND == 2) { if (j >= u.nlat) return true; const int krow = u.kstart + 64 * j, tw = u.q0 + wid * 32; return !(krow + 63 < tw - 128 || krow > tw + 31 + 128); }
  return true;
}
template <int KIND> __device__ __forceinline__ void apply_mask(f32x16& p0, f32x16& p1, const UnitP& u, int j, int wid, int r32, int hi, const float* rpbs) {
  if (KIND == 2) {
    if (j < u.nlat) {
      const int krow = u.kstart + 64 * j, tw = u.q0 + wid * 32;
      if (!(krow >= tw + 31 - 128 && krow + 63 <= tw + 128)) {
        const int t = tw + r32;
#pragma unroll
        for (int r = 0; r < 16; ++r) { const int d0 = krow + crow(r, hi) - t, d1 = d0 + 32;
          p0[r] = (d0 >= -128 && d0 <= 128) ? p0[r] : -INFINITY; p1[r] = (d1 >= -128 && d1 <= 128) ? p1[r] : -INFINITY; }
      }
    }
  } else if (KIND == 0) {
    if (j < u.nlat) {
      const int kr = u.kstart / 64 + j, qr = u.r0 + (wid >> 1), qc = (wid & 1) * 32 + r32;
      const int rsq = min(max(qr - 4, 0), 248), cs = min(max(qc - 8, 0), 48);
      const bool row_ok = (kr >= rsq) && (kr < rsq + 8);
      const int bidx = min(max(kr - qr + 7, 0), 14) * 31 + 15 - qc;
#pragma unroll
      for (int r = 0; r < 16; ++r) { const int kc0 = crow(r, hi);
        const bool ok0 = row_ok && kc0 >= cs && kc0 < cs + 16;
        const float b0 = rpbs[ok0 ? bidx + kc0 : 0];
        p0[r] = ok0 ? p0[r] + b0 : -INFINITY;
        if ((r & 3) == 3) asm volatile("" ::: "memory"); }
#pragma unroll
      for (int r = 0; r < 16; ++r) { const int kc1 = crow(r, hi) + 32;
        const bool ok1 = row_ok && kc1 >= cs && kc1 < cs + 16;
        const float b1 = rpbs[ok1 ? bidx + kc1 : 0];
        p1[r] = ok1 ? p1[r] + b1 : -INFINITY;
        if ((r & 3) == 3) asm volatile("" ::: "memory"); }
    }
  }
}
template <int KIND, int SDEPTH, bool PART = false, bool SHIFT = false>
__device__ __forceinline__ void attn_unit(const bf16_t* __restrict__ Qb, const bf16_t* __restrict__ Kh, const bf16_t* __restrict__ Vh, bf16_t* __restrict__ Ob, const UnitP u, char* lds, int tid) {
  const int wid = tid >> 6, lane = tid & 63, r32 = lane & 31, hi = lane >> 5;
  char* V_lds = lds; char* K_lds = lds + 2 * SHM_V;
  float* wsf = (float*)(lds + 2 * SHM_V + 2 * SHM_K) + wid * 64; float* li_l = wsf; float* al_l = wsf + 32;
  const float* rpbs = (const float*)(lds + RPB_OFF);
  float m_reg = (KIND == 1) ? u.mfix : -1e30f, l_reg = 0; f32x16 o[4] = {}; bf16x8 qr[8];
#define PSM(P0, P1, MN, AL) do { if constexpr (KIND == 1) partialSM_fixed<SHIFT>(P0, P1, m_reg, MN, AL); else partialSM(P0, P1, m_reg, MN, AL); } while (0)
#define QKT(P0, P1, KS) qkt(P0, P1, KS, qr, r32, hi)
#define QKM(P0, P1, KS, J) do { if ((KIND != 0 && KIND != 2) || __builtin_amdgcn_readfirstlane((int)tile_on<KIND>(u, (J), wid))) { QKT(P0, P1, KS); apply_mask<KIND>(P0, P1, u, (J), wid, r32, hi, rpbs); } \
    else { for (int r = 0; r < 16; ++r) { P0[r] = -INFINITY; P1[r] = -INFINITY; } } } while (0)
#define PVJ(VB, J) do { if ((KIND != 0 && KIND != 2) || __builtin_amdgcn_readfirstlane((int)tile_on<KIND>(u, (J), wid))) pv_d0(o, (VB), pa0, pa1, pa2, pa3); } while (0)
  const bf16_t* Qw = Qb + (long)(wid * QBLK + r32) * LDQ + hi * 8;
#pragma unroll
  for (int d0 = 0; d0 < 8; ++d0) qr[d0] = *reinterpret_cast<const bf16x8*>(Qw + d0 * 16);
  const int sr = tid >> 4, sc = (tid & 15) * 8, vst0 = v_st(sr, sc), vst1 = v_st(32 + sr, sc);
  const int vb0 = (int)(uintptr_t)V_lds + v_rd_base(lane);
  struct { bf16x8 vs0, vs1, ks0, ks1; } sr_[SDEPTH];
  const unsigned goff0 = (unsigned)(sr * LDK + sc) * 2u, goff1 = goff0 + 32u * LDK * 2u;
  const char* Kc = (const char*)Kh; const char* Vc = (const char*)Vh;
#define SLOAD(i, jj) do { const unsigned tb_ = (unsigned)krow_of<KIND>(u, (jj)) * (unsigned)(LDK * 2); const char* kp_ = Kc + tb_; const char* vp_ = Vc + tb_; \
    sr_[i].vs0 = *reinterpret_cast<const bf16x8*>(vp_ + goff0); sr_[i].vs1 = *reinterpret_cast<const bf16x8*>(vp_ + goff1); \
    sr_[i].ks0 = *reinterpret_cast<const bf16x8*>(kp_ + goff0); sr_[i].ks1 = *reinterpret_cast<const bf16x8*>(kp_ + goff1); } while (0)
#define SWRITE(b, i) do { *(bf16x8*)(V_lds + (b) * SHM_V + vst0) = sr_[i].vs0; *(bf16x8*)(V_lds + (b) * SHM_V + vst1) = sr_[i].vs1; int kc = sc * 2;               \
    *(bf16x8*)(K_lds + (b) * SHM_K + KSWZ(sr, kc)) = sr_[i].ks0; *(bf16x8*)(K_lds + (b) * SHM_K + KSWZ(32 + sr, kc)) = sr_[i].ks1; } while (0)
#define SWAIT() do { if constexpr (SDEPTH == 2) asm volatile("s_waitcnt vmcnt(4)" ::: "memory"); else asm volatile("s_waitcnt vmcnt(0)" ::: "memory"); } while (0)
#define RESC(a) do { if (KIND != 1 && __any((a) < 1.f)) { if (hi == 0) al_l[r32] = (a); asm volatile("s_waitcnt lgkmcnt(0)" ::: "memory"); \
    for (int d = 0; d < 4; ++d) for (int r = 0; r < 16; ++r) o[d][r] *= al_l[crow(r, hi)]; } } while (0)
  f32x16 pA0, pA1, pB0, pB1; float mnA, mnB, alA, alB; bf16x8 pa0, pa1, pa2, pa3; const int NT = u.nt;
  constexpr int SE = 0, SO = SDEPTH - 1;
  SLOAD(SE, 0); asm volatile("s_waitcnt vmcnt(0)" ::: "memory"); SWRITE(0, SE); __syncthreads();
  QKM(pA0, pA1, K_lds, 0); PSM(pA0, pA1, mnA, alA);
  SLOAD(SO, 1); if constexpr (SDEPTH == 2) { if (2 < NT) SLOAD(SE, 2); }
  SWAIT(); SWRITE(1, SO); __syncthreads();
  for (int j = 1; j + 1 < NT; j += 2) {
    SBAR(); QKM(pB0, pB1, K_lds + SHM_K, j);
    finishSM(pA0, pA1, alA, l_reg, pa0, pa1, pa2, pa3); SBAR();
    SLOAD(SO, j + SDEPTH); SBAR();
    PVJ(vb0, j - 1); PSM(pB0, pB1, mnB, alB);
    __syncthreads(); SWAIT(); SWRITE(0, SE);
    RESC(alB); __syncthreads();
    SBAR(); QKM(pA0, pA1, K_lds, j + 1);
    finishSM(pB0, pB1, alB, l_reg, pa0, pa1, pa2, pa3); SBAR();
    if (SDEPTH == 1 || j + 3 < NT) SLOAD(SE, j + 1 + SDEPTH); SBAR();
    PVJ(vb0 + (int)SHM_V, j); PSM(pA0, pA1, mnA, alA);
    __syncthreads(); SWAIT(); SWRITE(1, SO);
    RESC(alA); __syncthreads();
  }
  SBAR(); QKM(pB0, pB1, K_lds + SHM_K, NT - 1);
  finishSM(pA0, pA1, alA, l_reg, pa0, pa1, pa2, pa3); SBAR();
  PVJ(vb0, NT - 2); PSM(pB0, pB1, mnB, alB);
  __syncthreads(); RESC(alB);
  finishSM(pB0, pB1, alB, l_reg, pa0, pa1, pa2, pa3); SBAR();
  PVJ(vb0 + (int)SHM_V, NT - 1);
  if (KIND >= 2) l_reg += __builtin_amdgcn_exp2f(u.sinkl2 - m_reg * C2);
  if constexpr (PART) {
    unsigned* pm = (unsigned*)u.pmine + (size_t)wid * 64 * 65 + lane;
#pragma unroll
    for (int d = 0; d < 4; ++d)
#pragma unroll
      for (int r = 0; r < 16; ++r) __hip_atomic_store(pm + (d * 16 + r) * 64, __float_as_uint(o[d][r]), __ATOMIC_RELAXED, __HIP_MEMORY_SCOPE_AGENT);
    __hip_atomic_store(pm + 64 * 64, __float_as_uint(l_reg), __ATOMIC_RELAXED, __HIP_MEMORY_SCOPE_AGENT);
    asm volatile("s_waitcnt vmcnt(0)" ::: "memory");
    __syncthreads();
    unsigned* flag = (unsigned*)(lds + 2 * SHM_V + 2 * SHM_K + NW * 64 * 4);
    if (tid == 0) { const unsigned old = __hip_atomic_fetch_add(u.cnt, 1u, __ATOMIC_RELAXED, __HIP_MEMORY_SCOPE_AGENT); *flag = old; }
    __syncthreads();
    if (*flag == 0u) { __syncthreads(); return; }
    const unsigned* po = (const unsigned*)u.pother + (size_t)wid * 64 * 65 + lane;
#pragma unroll
    for (int d = 0; d < 4; ++d)
#pragma unroll
      for (int r = 0; r < 16; ++r) o[d][r] += __uint_as_float(__hip_atomic_load(po + (d * 16 + r) * 64, __ATOMIC_RELAXED, __HIP_MEMORY_SCOPE_AGENT));
    l_reg += __uint_as_float(__hip_atomic_load(po + 64 * 64, __ATOMIC_RELAXED, __HIP_MEMORY_SCOPE_AGENT));
  }
  if (hi == 0) li_l[r32] = l_reg; asm volatile("s_waitcnt lgkmcnt(0)" ::: "memory");
  float rli[16];
#pragma unroll
  for (int r = 0; r < 16; ++r) rli[r] = __builtin_amdgcn_rcpf(li_l[crow(r, hi)]);
  bf16_t* Ow = Ob + (long)(wid * QBLK) * LDO;
#pragma unroll
  for (int r = 0; r < 16; ++r) { const int orow = crow(r, hi);
#pragma unroll
    for (int d0 = 0; d0 < 4; ++d0) Ow[(long)orow * LDO + d0 * 32 + r32] = f2bf(o[d0][r] * rli[r]); }
  __syncthreads();
#undef PSM
#undef SLOAD
#undef SWRITE
#undef SWAIT
#undef RESC
}
#undef KSWZ
#undef SBAR

__device__ __forceinline__ void attn_phase(const bf16_t* __restrict__ QKV, bf16_t* __restrict__ O, const float* __restrict__ rpb, const float* __restrict__ sink, const float* __restrict__ qn, const float* __restrict__ kn, float* __restrict__ pbuf, unsigned* __restrict__ pcnt, bool do_ctx, char* lds, int wave_s) {
  const int G = grid_x(), c = blockIdx.x;
  const bool bal = (G == 256);
  float mfix;
  { unsigned zz_ = 0u; asm volatile("" : "+v"(zz_)); const int lane_ = (int)__builtin_amdgcn_mbcnt_hi(~0u, __builtin_amdgcn_mbcnt_lo(~0u, zz_)); const float gq = wmax(fmaxf(fabsf(qn[lane_]), fabsf(qn[lane_ + 64]))), gk = wmax(fmaxf(fabsf(kn[lane_]), fabsf(kn[lane_ + 64]))); mfix = __builtin_bit_cast(float, __builtin_amdgcn_readfirstlane(__builtin_bit_cast(int, 128.f * gq * gk * 1.03f))); }
  for (int p = c; p < ((bal && MK_PARTSPLIT) ? 256 : 384); p += G) {
    unsigned z_ = 0u; asm volatile("" : "+v"(z_)); int tid = wave_s * 64 + (int)__builtin_amdgcn_mbcnt_hi(~0u, __builtin_amdgcn_mbcnt_lo(~0u, z_)); asm volatile("" : "+v"(tid));
    UnitP u; u.sinkl2 = -INFINITY; u.r0 = 0; u.kstart = 0; u.nlat = 0; u.hq = 0; u.j0 = 0; u.pmine = nullptr; u.pother = nullptr; u.cnt = nullptr; const int qb = p / 6, h = p % 6;
    u.q0 = qb * 256; u.nt = MT / 64; u.mfix = mfix;
    if (__builtin_amdgcn_readfirstlane((int)(mfix * C2 <= 64.f))) attn_unit<1, 2, false, false>(QKV + (size_t)u.q0 * NQKV + QB + h * 128, QKV + KB + (h / 3) * 128, QKV + VB + (h / 3) * 128, O + (size_t)u.q0 * D + 768 + h * 128, u, lds, tid);
    else attn_unit<1, 1, false, true>(QKV + (size_t)u.q0 * NQKV + QB + h * 128, QKV + KB + (h / 3) * 128, QKV + VB + (h / 3) * 128, O + (size_t)u.q0 * D + 768 + h * 128, u, lds, tid);
  }
  if (bal && MK_PARTSPLIT) {
    unsigned z_ = 0u; asm volatile("" : "+v"(z_)); int tid = wave_s * 64 + (int)__builtin_amdgcn_mbcnt_hi(~0u, __builtin_amdgcn_mbcnt_lo(~0u, z_)); asm volatile("" : "+v"(tid));
    constexpr int KSPLIT = 186;
    const int ub = c & 127, half = c >> 7, p = 256 + ub, qb = p / 6, h = p % 6;
    UnitP u; u.sinkl2 = -INFINITY; u.r0 = 0; u.kstart = 0; u.nlat = 0; u.hq = 0; u.q0 = qb * 256; u.mfix = mfix;
    u.j0 = half ? KSPLIT : 0; u.nt = half ? MT / 64 - KSPLIT : KSPLIT;
    u.pmine = pbuf + (size_t)(ub * 2 + half) * (8 * 64 * 65); u.pother = pbuf + (size_t)(ub * 2 + (half ^ 1)) * (8 * 64 * 65); u.cnt = pcnt + 64 * ub;
    attn_unit<1, 2, true, true>(QKV + (size_t)u.q0 * NQKV + QB + h * 128, QKV + KB + (h / 3) * 128, QKV + VB + (h / 3) * 128, O + (size_t)u.q0 * D + 768 + h * 128, u, lds, tid);
  }
  const int c2 = bal ? c - 128 : c, G2 = bal ? 128 : G;
  if (c2 >= 0) {
    for (int p = c2; p < 384; p += G2) {
      unsigned z_ = 0u; asm volatile("" : "+v"(z_)); int tid = wave_s * 64 + (int)__builtin_amdgcn_mbcnt_hi(~0u, __builtin_amdgcn_mbcnt_lo(~0u, z_)); asm volatile("" : "+v"(tid));
      UnitP u; u.sinkl2 = -INFINITY; u.hq = 0; u.mfix = 0.f; u.j0 = 0; u.pmine = nullptr; u.pother = nullptr; u.cnt = nullptr; const int qb = p / 6, h = p % 6;
      u.q0 = qb * 256; u.r0 = qb * 4; const int rstart = min(max(u.r0 - 4, 0), 244); u.kstart = rstart * 64; u.nlat = 12; u.nt = 16;
      { float* rp = (float*)(lds + RPB_OFF); for (int t = tid; t < 465; t += 512) rp[t] = rpb[h * 465 + t] * (1.f / SCALE); }
      __syncthreads();
      attn_unit<0, 1>(QKV + (size_t)u.q0 * NQKV + QA + h * 128, QKV + KA + h * 128, QKV + VA + h * 128, O + (size_t)u.q0 * D + h * 128, u, lds, tid);
    }
    for (int p = c2; p < 256; p += G2) {
      unsigned z_ = 0u; asm volatile("" : "+v"(z_)); int tid = wave_s * 64 + (int)__builtin_amdgcn_mbcnt_hi(~0u, __builtin_amdgcn_mbcnt_lo(~0u, z_)); asm volatile("" : "+v"(tid));
      UnitP u; u.r0 = 0; u.hq = 0; u.mfix = 0.f; u.j0 = 0; u.pmine = nullptr; u.pother = nullptr; u.cnt = nullptr; const int qb = p / 4, h = p % 4;
      u.q0 = qb * 256; u.kstart = max(u.q0 - 128, 0); const int kend = min(u.q0 + 384, S); u.nlat = (kend - u.kstart) / 64; u.nt = u.nlat + 4; u.sinkl2 = sink[h] * 1.4426950408889634f;
      attn_unit<2, 2>(QKV + (size_t)u.q0 * NQKV + QC + h * 128, QKV + KC + (h / 2) * 128, QKV + VC + (h / 2) * 128, O + (size_t)u.q0 * D + 1536 + h * 128, u, lds, tid);
    }
    if (do_ctx) for (int p = c2; p < 16; p += G2) {
      unsigned z_ = 0u; asm volatile("" : "+v"(z_)); int tid = wave_s * 64 + (int)__builtin_amdgcn_mbcnt_hi(~0u, __builtin_amdgcn_mbcnt_lo(~0u, z_)); asm volatile("" : "+v"(tid));
      UnitP u; u.sinkl2 = -INFINITY; u.r0 = 0; u.kstart = 0; u.nlat = 0; u.hq = 0; u.mfix = 0.f; u.j0 = 0; u.pmine = nullptr; u.pother = nullptr; u.cnt = nullptr; u.q0 = S; u.nt = 4;
      int qcol, kcol, vcol, ocol;
      if (p < 6) { qcol = QA + p * 128; kcol = KA + p * 128; vcol = VA + p * 128; ocol = p * 128; }
      else if (p < 12) { const int hh = p - 6; qcol = QB + hh * 128; kcol = KB + (hh / 3) * 128; vcol = VB + (hh / 3) * 128; ocol = 768 + hh * 128; }
      else { const int hh = p - 12; qcol = QC + hh * 128; kcol = KC + (hh / 2) * 128; vcol = VC + (hh / 2) * 128; ocol = 1536 + hh * 128; u.sinkl2 = sink[hh] * 1.4426950408889634f; }
      attn_unit<3, 1>(QKV + (size_t)S * NQKV + qcol, QKV + kcol, QKV + vcol, O + (size_t)S * D + ocol, u, lds, tid);
    }
  }
}
}
__device__ __forceinline__ void peer_select_phase(const bf16_t* __restrict__ QS, const float* __restrict__ keys, int* __restrict__ IDX, float* __restrict__ GWT, int rows, char* lds, int tid) {
    const int wave = tid >> 6, lane = tid & 63;
    float* sq = (float*)lds + wave * 256; float* ss = (float*)(lds + 8192) + wave * 32; int* si = (int*)(lds + 8192 + 1024) + wave * 32;
    for (int item = blockIdx.x * 8 + wave; item < rows * 8; item += grid_x() * 8) {
        const int token = item >> 3, h = item & 7;
        { const bf16_t* qp = QS + (size_t)token * (2 * D) + h * 256 + lane * 4; const uint2 hi = *(const uint2*)qp, lo = *(const uint2*)(qp + D);
          *(float4*)(sq + lane * 4) = make_float4(bf2f(hi.x) + bf2f(lo.x), bf2f(hi.x >> 16) + bf2f(lo.x >> 16), bf2f(hi.y) + bf2f(lo.y), bf2f(hi.y >> 16) + bf2f(lo.y >> 16)); }
        WAVE_LDS_SYNC();
        float sc[2][2];
#pragma unroll
        for (int p = 0; p < 2; ++p)
#pragma unroll
            for (int r = 0; r < 2; ++r) {
                const float4* kp = (const float4*)(keys + ((size_t)((h * 2 + p) * 128 + lane + 64 * r)) * 128);
                float acc = 0.f;
#pragma unroll 8
                for (int d4 = 0; d4 < 32; ++d4) { const float4 kv = kp[d4]; const float4 q = *(const float4*)(sq + p * 128 + d4 * 4); acc += q.x * kv.x + q.y * kv.y + q.z * kv.z + q.w * kv.w; }
                sc[p][r] = acc;
            }
#pragma unroll
        for (int p = 0; p < 2; ++p) {
            float v0 = sc[p][0], v1 = sc[p][1];
            for (int k = 0; k < 16; ++k) {
                float bv; int bi; if (v0 >= v1) { bv = v0; bi = lane; } else { bv = v1; bi = lane + 64; }
                wave_argmax(bv, bi);
                if (lane == 0) { ss[p * 16 + k] = bv; si[p * 16 + k] = bi; }
                if (bi == lane) v0 = -INFINITY; else if (bi == lane + 64) v1 = -INFINITY;
            }
        }
        WAVE_LDS_SYNC();
        float cv[4];
#pragma unroll
        for (int r = 0; r < 4; ++r) { const int ci = lane + 64 * r; cv[r] = ss[ci >> 4] + ss[16 + (ci & 15)]; }
        float my_s = 0.f; int my_i = 0;
        for (int k = 0; k < 16; ++k) {
            float bv = cv[0]; int bi = lane;
#pragma unroll
            for (int r = 1; r < 4; ++r) if (cv[r] > bv) { bv = cv[r]; bi = lane + 64 * r; }
            wave_argmax(bv, bi);
            if (lane == k) { my_s = bv; my_i = bi; }
#pragma unroll
            for (int r = 0; r < 4; ++r) if (bi == lane + 64 * r) cv[r] = -INFINITY;
        }
        const float mx = __shfl(my_s, 0);
        const float e = lane < 16 ? __expf(my_s - mx) : 0.f;
        const float sum = wsum(e);
        if (lane < 16) { IDX[(size_t)token * 128 + h * 16 + lane] = si[my_i >> 4] * 128 + si[16 + (my_i & 15)]; GWT[(size_t)token * 128 + h * 16 + lane] = e / sum; }
        WAVE_LDS_SYNC();
    }
}
__device__ __forceinline__ float gelu_fast(float x) {
    const float u2 = 1.5957691216057308f * (x + 0.044715f * x * x * x);
    return x * (1.f - __builtin_amdgcn_rcpf(1.f + __builtin_amdgcn_exp2f(fminf(1.4426950408889634f * u2, 126.f))));
}
__device__ __forceinline__ void unpack8(const uint4 w, float (&f)[8]) {
    f[0] = __uint_as_float(w.x << 16); f[1] = __uint_as_float(w.x & 0xffff0000u); f[2] = __uint_as_float(w.y << 16); f[3] = __uint_as_float(w.y & 0xffff0000u);
    f[4] = __uint_as_float(w.z << 16); f[5] = __uint_as_float(w.z & 0xffff0000u); f[6] = __uint_as_float(w.w << 16); f[7] = __uint_as_float(w.w & 0xffff0000u);
}
template <bool LAST>
__device__ __forceinline__ void peer_expert_phase(const bf16_t* __restrict__ HS, const int* __restrict__ IDX, const float* __restrict__ GWT, const bf16_t* __restrict__ UB, const bf16_t* __restrict__ VB,
                                                  const float* __restrict__ MODl, float* __restrict__ X, const float* __restrict__ gnext, const float* __restrict__ MODn, bf16_t* __restrict__ Hn,
                                                  float* __restrict__ out, int rows, int tid) {
    const int wave = tid >> 6, lane = tid & 63;
    for (int row = blockIdx.x * 8 + wave; row < rows; row += grid_x() * 8) {
        float h[4][8], acc[4][8];
#pragma unroll
        for (int i = 0; i < 4; ++i) { const bf16_t* hp = HS + (size_t)row * (2 * D) + 8 * lane + 512 * i; float a[8], b[8]; unpack8(*(const uint4*)hp, a); unpack8(*(const uint4*)(hp + D), b);
#pragma unroll
            for (int j = 0; j < 8; ++j) { h[i][j] = a[j] + b[j]; acc[i][j] = 0.f; } }
        const int idx_lo = IDX[(size_t)row * 128 + lane], idx_hi = IDX[(size_t)row * 128 + 64 + lane];
        const float gw_lo = GWT[(size_t)row * 128 + lane], gw_hi = GWT[(size_t)row * 128 + 64 + lane];
        for (int j0 = 0; j0 < 128; j0 += 4) {
            int e[4]; float w[4], d[4];
#pragma unroll
            for (int k = 0; k < 4; ++k) { const int j = j0 + k;
                e[k] = j0 < 64 ? __builtin_amdgcn_readlane(idx_lo, j & 63) : __builtin_amdgcn_readlane(idx_hi, j & 63);
                w[k] = __uint_as_float(j0 < 64 ? __builtin_amdgcn_readlane(__float_as_uint(gw_lo), j & 63) : __builtin_amdgcn_readlane(__float_as_uint(gw_hi), j & 63)); }
            uint4 ur[4][4];
#pragma unroll
            for (int k = 0; k < 4; ++k) { const uint4* up = (const uint4*)(UB + (size_t)e[k] * D) + lane;
#pragma unroll
                for (int i = 0; i < 4; ++i) ur[k][i] = up[64 * i]; }
#pragma unroll
            for (int k = 0; k < 4; ++k) { float s = 0.f;
#pragma unroll
                for (int i = 0; i < 4; ++i) { float f[8]; unpack8(ur[k][i], f);
#pragma unroll
                    for (int j = 0; j < 8; ++j) s += h[i][j] * f[j]; }
                d[k] = s; }
            asm volatile("" : "+v"(d[0]), "+v"(d[1]), "+v"(d[2]), "+v"(d[3]) :: "memory");
            uint4 vr[4][4];
#pragma unroll
            for (int k = 0; k < 4; ++k) { const uint4* vp = (const uint4*)(VB + (size_t)e[k] * D) + lane;
#pragma unroll
                for (int i = 0; i < 4; ++i) vr[k][i] = vp[64 * i]; }
#pragma unroll
            for (int k = 0; k < 4; ++k) d[k] = wsum(d[k]);
#pragma unroll
            for (int k = 0; k < 4; ++k) { const float a = gelu_fast(d[k]) * w[k];
#pragma unroll
                for (int i = 0; i < 4; ++i) { float f[8]; unpack8(vr[k][i], f);
#pragma unroll
                    for (int j = 0; j < 8; ++j) acc[i][j] += a * f[j]; } }
        }
        const float* md = MODl + (row < S ? 0 : NMOD) + 5 * D;
        float xn[4][8]; float ss = 0.f;
#pragma unroll
        for (int i = 0; i < 4; ++i) { const int col = 8 * lane + 512 * i; const float4 g0 = *(const float4*)(md + col), g1 = *(const float4*)(md + col + 4);
            const float4 x0 = *(const float4*)(X + (size_t)row * D + col), x1 = *(const float4*)(X + (size_t)row * D + col + 4);
            xn[i][0] = x0.x + g0.x * acc[i][0]; xn[i][1] = x0.y + g0.y * acc[i][1]; xn[i][2] = x0.z + g0.z * acc[i][2]; xn[i][3] = x0.w + g0.w * acc[i][3];
            xn[i][4] = x1.x + g1.x * acc[i][4]; xn[i][5] = x1.y + g1.y * acc[i][5]; xn[i][6] = x1.z + g1.z * acc[i][6]; xn[i][7] = x1.w + g1.w * acc[i][7];
#pragma unroll
            for (int j = 0; j < 8; ++j) ss += xn[i][j] * xn[i][j];
            if (!LAST) { *(float4*)(X + (size_t)row * D + col) = make_float4(xn[i][0], xn[i][1], xn[i][2], xn[i][3]); *(float4*)(X + (size_t)row * D + col + 4) = make_float4(xn[i][4], xn[i][5], xn[i][6], xn[i][7]); } }
        ss = wsum(ss);
        const float rs = rsqrtf(ss * (1.f / D) + EPS);
        if (LAST) {
#pragma unroll
            for (int i = 0; i < 4; ++i) { const int col = 8 * lane + 512 * i; const float4 g0 = *(const float4*)(gnext + col), g1 = *(const float4*)(gnext + col + 4);
                *(float4*)(out + (size_t)row * D + col) = make_float4(xn[i][0] * rs * g0.x, xn[i][1] * rs * g0.y, xn[i][2] * rs * g0.z, xn[i][3] * rs * g0.w);
                *(float4*)(out + (size_t)row * D + col + 4) = make_float4(xn[i][4] * rs * g1.x, xn[i][5] * rs * g1.y, xn[i][6] * rs * g1.z, xn[i][7] * rs * g1.w); }
        } else {
            const float* mn = MODn + (row < S ? 0 : NMOD);
#pragma unroll
            for (int i = 0; i < 4; ++i) { const int col = 8 * lane + 512 * i; float o[8];
#pragma unroll
                for (int j4 = 0; j4 < 2; ++j4) { const float4 g = *(const float4*)(gnext + col + 4 * j4), sh = *(const float4*)(mn + col + 4 * j4), sc = *(const float4*)(mn + D + col + 4 * j4);
                    o[4 * j4 + 0] = xn[i][4 * j4 + 0] * rs * g.x * (1.f + sc.x) + sh.x; o[4 * j4 + 1] = xn[i][4 * j4 + 1] * rs * g.y * (1.f + sc.y) + sh.y;
                    o[4 * j4 + 2] = xn[i][4 * j4 + 2] * rs * g.z * (1.f + sc.z) + sh.z; o[4 * j4 + 3] = xn[i][4 * j4 + 3] * rs * g.w * (1.f + sc.w) + sh.w; }
                uint4 p; p.x = pk2(o[0], o[1]); p.y = pk2(o[2], o[3]); p.z = pk2(o[4], o[5]); p.w = pk2(o[6], o[7]); *(uint4*)(Hn + (size_t)row * D + col) = p; }
        }
    }
}
__device__ __forceinline__ void quant_rows_phase(const float* __restrict__ src, unsigned char* __restrict__ dst, float* __restrict__ scl, int nrows, int c2, int G2, int tid) {
    const int wave = tid >> 6, lane = tid & 63;
    for (int row = c2 * 8 + wave; row < nrows; row += G2 * 8) {
        const float4* sp = (const float4*)(src + (size_t)row * D) + lane;
        float4 v[8]; float mx = 0.f;
#pragma unroll
        for (int i = 0; i < 8; ++i) { v[i] = sp[64 * i]; mx = fmaxf(mx, fmaxf(fmaxf(fabsf(v[i].x), fabsf(v[i].y)), fmaxf(fabsf(v[i].z), fabsf(v[i].w)))); }
        mx = wmax(mx);
        const float s = mx > 0.f ? mx * (1.f / 127.f) : 1.f, inv = 1.f / s;
#pragma unroll
        for (int i = 0; i < 8; ++i) {
            const unsigned b0 = (unsigned)(__float2int_rn(v[i].x * inv) + 128), b1 = (unsigned)(__float2int_rn(v[i].y * inv) + 128), b2 = (unsigned)(__float2int_rn(v[i].z * inv) + 128), b3 = (unsigned)(__float2int_rn(v[i].w * inv) + 128);
            *(unsigned*)(dst + (size_t)row * D + 4 * lane + 256 * i) = (b0 & 255u) | ((b1 & 255u) << 8) | ((b2 & 255u) << 16) | ((b3 & 255u) << 24);
        }
        if (lane == 0) scl[row] = s;
    }
}
__device__ __forceinline__ void ub16(const uint4 w, float (&f)[16]) {
    f[0] = (float)(w.x & 0xffu); f[1] = (float)((w.x >> 8) & 0xffu); f[2] = (float)((w.x >> 16) & 0xffu); f[3] = (float)(w.x >> 24);
    f[4] = (float)(w.y & 0xffu); f[5] = (float)((w.y >> 8) & 0xffu); f[6] = (float)((w.y >> 16) & 0xffu); f[7] = (float)(w.y >> 24);
    f[8] = (float)(w.z & 0xffu); f[9] = (float)((w.z >> 8) & 0xffu); f[10] = (float)((w.z >> 16) & 0xffu); f[11] = (float)(w.z >> 24);
    f[12] = (float)(w.w & 0xffu); f[13] = (float)((w.w >> 8) & 0xffu); f[14] = (float)((w.w >> 16) & 0xffu); f[15] = (float)(w.w >> 24);
}
template <bool LAST>
__device__ __forceinline__ void peer_expert_q8_phase(const bf16_t* __restrict__ HS, const int* __restrict__ IDX, const float* __restrict__ GWT, const unsigned char* __restrict__ UQ, const unsigned char* __restrict__ VQ,
                                                     const float* __restrict__ SU, const float* __restrict__ SV, const float* __restrict__ MODl, float* __restrict__ X, const float* __restrict__ gnext,
                                                     const float* __restrict__ MODn, bf16_t* __restrict__ Hn, float* __restrict__ out, int rows, int tid) {
    const int wave = tid >> 6, lane = tid & 63;
    for (int row = blockIdx.x * 8 + wave; row < rows; row += grid_x() * 8) {
        float h[2][16], acc[2][16]; float hs = 0.f, accb = 0.f;
#pragma unroll
        for (int i = 0; i < 2; ++i) { const bf16_t* hp = HS + (size_t)row * (2 * D) + 16 * lane + 1024 * i;
#pragma unroll
            for (int c = 0; c < 2; ++c) { float a[8], b[8]; unpack8(*(const uint4*)(hp + 8 * c), a); unpack8(*(const uint4*)(hp + D + 8 * c), b);
#pragma unroll
                for (int j = 0; j < 8; ++j) { h[i][8 * c + j] = a[j] + b[j]; hs += a[j] + b[j]; acc[i][8 * c + j] = 0.f; } } }
        hs = wsum(hs) * 128.f;
        const int idx_lo = IDX[(size_t)row * 128 + lane], idx_hi = IDX[(size_t)row * 128 + 64 + lane];
        const float gw_lo = GWT[(size_t)row * 128 + lane], gw_hi = GWT[(size_t)row * 128 + 64 + lane];
        for (int j0 = 0; j0 < 128; j0 += 8) {
            int e[8]; float w[8], d[8];
#pragma unroll
            for (int k = 0; k < 8; ++k) { const int j = j0 + k;
                e[k] = j0 < 64 ? __builtin_amdgcn_readlane(idx_lo, j & 63) : __builtin_amdgcn_readlane(idx_hi, j & 63);
                w[k] = __uint_as_float(j0 < 64 ? __builtin_amdgcn_readlane(__float_as_uint(gw_lo), j & 63) : __builtin_amdgcn_readlane(__float_as_uint(gw_hi), j & 63)); }
            uint4 ur[8][2];
#pragma unroll
            for (int k = 0; k < 8; ++k) { const uint4* up = (const uint4*)(UQ + (size_t)e[k] * D) + lane; ur[k][0] = up[0]; ur[k][1] = up[64]; }
#pragma unroll
            for (int k = 0; k < 8; ++k) { float s = 0.f;
#pragma unroll
                for (int i = 0; i < 2; ++i) { float f[16]; ub16(ur[k][i], f);
#pragma unroll
                    for (int j = 0; j < 16; ++j) s += h[i][j] * f[j]; }
                d[k] = s; }
            asm volatile("" : "+v"(d[0]), "+v"(d[1]), "+v"(d[2]), "+v"(d[3]), "+v"(d[4]), "+v"(d[5]), "+v"(d[6]), "+v"(d[7]) :: "memory");
            uint4 vr[8][2];
#pragma unroll
            for (int k = 0; k < 8; ++k) { const uint4* vp = (const uint4*)(VQ + (size_t)e[k] * D) + lane; vr[k][0] = vp[0]; vr[k][1] = vp[64]; }
#pragma unroll
            for (int k = 0; k < 8; ++k) d[k] = wsum(d[k]);
#pragma unroll
            for (int k = 0; k < 8; ++k) { const float dd = (d[k] - hs) * SU[e[k]]; const float c = gelu_fast(dd) * w[k] * SV[e[k]]; accb += 128.f * c;
#pragma unroll
                for (int i = 0; i < 2; ++i) { float f[16]; ub16(vr[k][i], f);
#pragma unroll
                    for (int j = 0; j < 16; ++j) acc[i][j] += c * f[j]; } }
        }
        const float* md = MODl + (row < S ? 0 : NMOD) + 5 * D;
        float ss = 0.f;
#pragma unroll
        for (int i = 0; i < 2; ++i)
#pragma unroll
            for (int c4 = 0; c4 < 4; ++c4) { const int col = 16 * lane + 1024 * i + 4 * c4; const float4 g = *(const float4*)(md + col); const float4 x0 = *(const float4*)(X + (size_t)row * D + col);
                float* a = &acc[i][4 * c4];
                a[0] = x0.x + g.x * (a[0] - accb); a[1] = x0.y + g.y * (a[1] - accb); a[2] = x0.z + g.z * (a[2] - accb); a[3] = x0.w + g.w * (a[3] - accb);
                ss += a[0] * a[0] + a[1] * a[1] + a[2] * a[2] + a[3] * a[3];
                if (!LAST) *(float4*)(X + (size_t)row * D + col) = make_float4(a[0], a[1], a[2], a[3]); }
        ss = wsum(ss);
        const float rs = rsqrtf(ss * (1.f / D) + EPS);
        if (LAST) {
#pragma unroll
            for (int i = 0; i < 2; ++i)
#pragma unroll
                for (int c4 = 0; c4 < 4; ++c4) { const int col = 16 * lane + 1024 * i + 4 * c4; const float4 g = *(const float4*)(gnext + col); const float* a = &acc[i][4 * c4];
                    *(float4*)(out + (size_t)row * D + col) = make_float4(a[0] * rs * g.x, a[1] * rs * g.y, a[2] * rs * g.z, a[3] * rs * g.w); }
        } else {
            const float* mn = MODn + (row < S ? 0 : NMOD);
#pragma unroll
            for (int i = 0; i < 2; ++i)
#pragma unroll
                for (int c8 = 0; c8 < 2; ++c8) { const int col = 16 * lane + 1024 * i + 8 * c8; float o[8];
#pragma unroll
                    for (int j4 = 0; j4 < 2; ++j4) { const float4 g = *(const float4*)(gnext + col + 4 * j4), sh = *(const float4*)(mn + col + 4 * j4), sc = *(const float4*)(mn + D + col + 4 * j4); const float* a = &acc[i][8 * c8 + 4 * j4];
                        o[4 * j4 + 0] = a[0] * rs * g.x * (1.f + sc.x) + sh.x; o[4 * j4 + 1] = a[1] * rs * g.y * (1.f + sc.y) + sh.y; o[4 * j4 + 2] = a[2] * rs * g.z * (1.f + sc.z) + sh.z; o[4 * j4 + 3] = a[3] * rs * g.w * (1.f + sc.w) + sh.w; }
                    uint4 p; p.x = pk2(o[0], o[1]); p.y = pk2(o[2], o[3]); p.z = pk2(o[4], o[5]); p.w = pk2(o[6], o[7]); *(uint4*)(Hn + (size_t)row * D + col) = p; }
        }
    }
}
#define XB_TMO      128
#define XB_XCNT(j)  (256  + 64 * (j))
#define XB_XSUB(j)  (1280 + 64 * (j))
#define XB_XGEN(j)  (2304 + 64 * (j))
#define XB_TOP      3328
#define XB_TOPGEN   3392
#define XCD_BAR_WORDS 3456
#define XB_SPIN_CAP (1u << 22)
#define LAS __attribute__((address_space(3)))
__device__ __forceinline__ unsigned xb_ld(unsigned* p)              { return __hip_atomic_load(p, __ATOMIC_RELAXED, __HIP_MEMORY_SCOPE_AGENT); }
__device__ __forceinline__ unsigned xb_add(unsigned* p, unsigned v) { return __hip_atomic_fetch_add(p, v, __ATOMIC_RELAXED, __HIP_MEMORY_SCOPE_AGENT); }
__device__ __forceinline__ unsigned xb_xcc_id() { return (unsigned)__builtin_amdgcn_s_getreg((3 << 11) | 20) & 0xFu; }
#define XB_SPIN(cond, bar) do { unsigned _sp = 0; while (cond) { __builtin_amdgcn_s_sleep(1); \
    if ((++_sp & 255u) == 0u) { if (xb_ld(&(bar)[XB_TMO])) break; if (_sp > XB_SPIN_CAP) { atomicAdd(&(bar)[XB_TMO], 1u); break; } } } } while (0)
struct XcdBarrier { unsigned* bar; unsigned x; volatile LAS unsigned* st; };
__device__ __forceinline__ XcdBarrier xcd_barrier_post(unsigned* bar, volatile LAS unsigned* st) {
    XcdBarrier b; b.bar = bar; b.x = xb_xcc_id(); b.st = st;
    if (threadIdx.x == 0) (void)xb_add(&bar[XB_XCNT(b.x)], 1u);
    return b;
}
__device__ __forceinline__ void xcd_barrier_complete(unsigned* bar, unsigned x, unsigned& nloc, unsigned& nx) {
    const unsigned G = (unsigned)grid_x();
    unsigned sum, cnt, mine, sp = 0u;
    for (;;) {
        sum = 0u; cnt = 0u; mine = 0u;
#pragma unroll
        for (unsigned j = 0; j < 16; ++j) { const unsigned c = xb_ld(&bar[XB_XCNT(j)]); sum += c; cnt += (c > 0u) ? 1u : 0u; mine = (j == x) ? c : mine; }
        if (sum == G) break;
        __builtin_amdgcn_s_sleep(1);
        if ((++sp & 255u) == 0u) { if (xb_ld(&bar[XB_TMO])) break; if (sp > XB_SPIN_CAP) { atomicAdd(&bar[XB_TMO], 1u); break; } }
    }
    nloc = mine > 0u ? mine : 1u; nx = cnt > 0u ? cnt : 1u;
}
__device__ __forceinline__ void xcd_barrier(const XcdBarrier& b) {
    asm volatile("s_waitcnt vmcnt(0)" ::: "memory");
    __syncthreads();
    if (threadIdx.x == 0) {
        unsigned* bar = b.bar; unsigned bx = b.x; asm volatile("" : "+s"(bar), "+s"(bx));
        __builtin_amdgcn_s_waitcnt(0);
        unsigned nloc = b.st[0], nx = b.st[1];
        if (nloc == 0u) { xcd_barrier_complete(bar, bx, nloc, nx); b.st[0] = nloc; b.st[1] = nx; }
        const unsigned old = xb_add(&bar[XB_XSUB(bx)], 1u);
        const unsigned gen = old / nloc;
        if (old + 1u == (gen + 1u) * nloc) {
            __builtin_amdgcn_fence(__ATOMIC_RELEASE, "agent");
            asm volatile("s_waitcnt vmcnt(0)" ::: "memory");
            const unsigned og = xb_add(&bar[XB_TOP], 1u);
            const unsigned tg = og / nx;
            if (og + 1u == (tg + 1u) * nx) xb_add(&bar[XB_TOPGEN], 1u);
            else XB_SPIN(xb_ld(&bar[XB_TOPGEN]) == tg, bar);
            __builtin_amdgcn_fence(__ATOMIC_ACQUIRE, "agent");
            xb_add(&bar[XB_XGEN(bx)], 1u);
            asm volatile("s_waitcnt vmcnt(0)" ::: "memory");
        } else {
            XB_SPIN(xb_ld(&bar[XB_XGEN(bx)]) == gen, bar);
            __builtin_amdgcn_fence(__ATOMIC_ACQUIRE, "agent");
            asm volatile("s_waitcnt vmcnt(0)" ::: "memory");
        }
    }
    __syncthreads();
}

template <bool SIGNED>
__device__ __forceinline__ void quant_rows_sliced_phase(const float* __restrict__ src, unsigned char* __restrict__ dst, float* __restrict__ scl, int nrows, int c2, int G2, int tid) {
    const int wave = tid >> 6, lane = tid & 63;
    for (int row = c2 * 8 + wave; row < nrows; row += G2 * 8) {
        const float4* sp = (const float4*)(src + (size_t)row * D) + lane;
        float4 v[8]; float mx = 0.f;
#pragma unroll
        for (int i = 0; i < 8; ++i) { v[i] = sp[64 * i]; mx = fmaxf(mx, fmaxf(fmaxf(fabsf(v[i].x), fabsf(v[i].y)), fmaxf(fabsf(v[i].z), fabsf(v[i].w)))); }
        mx = wmax(mx);
        const float s = mx > 0.f ? mx * (1.f / 127.f) : 1.f, inv = 1.f / s;
#pragma unroll
        for (int i = 0; i < 8; ++i) {
            constexpr int OFS = SIGNED ? 0 : 128; const unsigned b0 = (unsigned)(__float2int_rn(v[i].x * inv) + OFS), b1 = (unsigned)(__float2int_rn(v[i].y * inv) + OFS), b2 = (unsigned)(__float2int_rn(v[i].z * inv) + OFS), b3 = (unsigned)(__float2int_rn(v[i].w * inv) + OFS);
            const int slice = 2 * i + (lane >> 5), cin = (4 * lane) & 127;
            *(unsigned*)(dst + ((size_t)slice * 16384 + row) * 128 + cin) = (b0 & 255u) | ((b1 & 255u) << 8) | ((b2 & 255u) << 16) | ((b3 & 255u) << 24);
        }
        if (lane == 0) scl[row] = s;
    }
}
struct SliceDeal { int x, nx, r, R; __device__ __forceinline__ void init() {
    unsigned base = ARG_OFF; asm volatile("" : "+v"(base)); const __attribute__((address_space(3))) unsigned* p = (const __attribute__((address_space(3))) unsigned*)(size_t)base;
    unsigned a = p[51], b = p[52], c = p[53], d = p[54]; asm volatile("" : "+v"(a), "+v"(b), "+v"(c), "+v"(d));
    r = (int)__builtin_amdgcn_readfirstlane(a); x = (int)__builtin_amdgcn_readfirstlane(b); nx = (int)__builtin_amdgcn_readfirstlane(c); R = (int)__builtin_amdgcn_readfirstlane(d); } };
typedef _Float16 hf2 __attribute__((ext_vector_type(2)));
typedef unsigned uv4 __attribute__((ext_vector_type(4))); typedef float fv4 __attribute__((ext_vector_type(4)));
typedef __attribute__((address_space(1))) uv4 GU4; typedef __attribute__((address_space(1))) float GF32; typedef __attribute__((address_space(1))) fv4 GF4;
__device__ __forceinline__ uint4 ldg4(const void* p) { const uv4 v = *(const GU4*)p; return make_uint4(v.x, v.y, v.z, v.w); }
__device__ __forceinline__ float4 ldgf4(const void* p) { const fv4 v = *(const GF4*)p; return make_float4(v.x, v.y, v.z, v.w); }
template <int CTRL> __device__ __forceinline__ float dppmov(float v) { return __builtin_bit_cast(float, __builtin_amdgcn_update_dpp(0, __builtin_bit_cast(int, v), CTRL, 0xF, 0xF, true)); }
__device__ __forceinline__ float sum8(float p) { p += dppmov<0xB1>(p); p += dppmov<0x4E>(p); p += dppmov<0x141>(p); return p; }
__device__ __forceinline__ float sum_x8_16_32(float a) { a += dppmov<0x128>(a);
    { auto r = __builtin_amdgcn_permlane16_swap(__builtin_bit_cast(unsigned, a), __builtin_bit_cast(unsigned, a), false, false); a = __builtin_bit_cast(float, r[0]) + __builtin_bit_cast(float, r[1]); }
    { auto r = __builtin_amdgcn_permlane32_swap(__builtin_bit_cast(unsigned, a), __builtin_bit_cast(unsigned, a), false, false); a = __builtin_bit_cast(float, r[0]) + __builtin_bit_cast(float, r[1]); }
    return a; }
struct UItem { int s, row; };
__device__ __forceinline__ UItem u_item(int k, int n, int nrw, const SliceDeal& sd, int wave) { const int kk = k < n ? k : n - 1; UItem it; it.s = sd.x + (kk / nrw) * sd.nx; it.row = sd.r * 8 + wave + (kk % nrw) * sd.R * 8; return it; }
template <unsigned EMASK>
__device__ __forceinline__ void peer_u_pass(const signed char* __restrict__ HQ, const int* __restrict__ IDX, const unsigned char* __restrict__ UQ, int* __restrict__ PART, int rows, int tid) {
    const int wave = __builtin_amdgcn_readfirstlane(tid >> 6), lane = tid & 63, g = lane >> 3, c8 = lane & 7;
    SliceDeal sd; sd.init();
    const int first = sd.r * 8 + wave, stepw = sd.R * 8;
    const int nrw = first < rows ? (rows - first + stepw - 1) / stepw : 0, nsl = sd.x < 16 ? (16 - sd.x + sd.nx - 1) / sd.nx : 0, n = nrw * nsl;
    if (n == 0) return;
    uint4 hrA, hrB, idg; uint4 er[4]; uint4 tA[16], tB[16];
    typedef __attribute__((address_space(3))) uv4 L4;
    const unsigned wl = (unsigned)wave * 512u, wr_id = wl + 16u * (lane & 31), rd_id = wl + 64u * g;
#define U_GLOAD(IT) do { idg = ldg4(IDX + (size_t)(IT).row * 128 + 4 * (lane & 31)); } while (0)
#define U_LDS_E() do { *(L4*)(size_t)wr_id = (uv4){idg.x, idg.y, idg.z, idg.w}; _Pragma("unroll") for (int i_ = 0; i_ < 4; ++i_) { const uv4 v_ = *(const L4*)(size_t)(rd_id + 16u * i_); er[i_] = make_uint4(v_.x, v_.y, v_.z, v_.w); } } while (0)
#define U_LOAD_H(HR, IT) do { HR = ldg4(HQ + (size_t)(IT).row * D + 128 * (IT).s + 16 * c8); } while (0)
#define U_LOAD_T(T, IT) do { const unsigned char* us_ = UQ + (size_t)(IT).s * 16384 * 128 + 16 * c8; _Pragma("unroll") for (int i_ = 0; i_ < 4; ++i_) { \
        T[4 * i_] = ldg4(us_ + (er[i_].x & EMASK) * 128u); T[4 * i_ + 1] = ldg4(us_ + (er[i_].y & EMASK) * 128u); T[4 * i_ + 2] = ldg4(us_ + (er[i_].z & EMASK) * 128u); T[4 * i_ + 3] = ldg4(us_ + (er[i_].w & EMASK) * 128u); } } while (0)
#define U_STEP(HRC, TC, HRN, TN) do { \
        U_LDS_E(); U_GLOAD(itn2); U_LOAD_H(HRN, itn); \
        const unsigned char* us_ = UQ + (size_t)itn.s * 16384 * 128 + 16 * c8; const unsigned e_[16] = {er[0].x, er[0].y, er[0].z, er[0].w, er[1].x, er[1].y, er[1].z, er[1].w, er[2].x, er[2].y, er[2].z, er[2].w, er[3].x, er[3].y, er[3].z, er[3].w}; \
        int keep0_ = 0, keep1_ = 0; \
        _Pragma("unroll") for (int i_ = 0; i_ < 16; ++i_) { \
            TN[i_] = ldg4(us_ + (e_[i_] & EMASK) * 128u); \
            int p_ = __builtin_amdgcn_sdot4((int)TC[i_].x, (int)HRC.x, 0, false); p_ = __builtin_amdgcn_sdot4((int)TC[i_].y, (int)HRC.y, p_, false); \
            p_ = __builtin_amdgcn_sdot4((int)TC[i_].z, (int)HRC.z, p_, false); p_ = __builtin_amdgcn_sdot4((int)TC[i_].w, (int)HRC.w, p_, false); \
            p_ += __builtin_amdgcn_update_dpp(0, p_, 0xB1, 0xF, 0xF, true); p_ += __builtin_amdgcn_update_dpp(0, p_, 0x4E, 0xF, 0xF, true); p_ += __builtin_amdgcn_update_dpp(0, p_, 0x141, 0xF, 0xF, true); \
            if ((i_ & 7) == c8) { if (i_ < 8) keep0_ = p_; else keep1_ = p_; } \
            __builtin_amdgcn_sched_barrier(0); } \
        typedef int i2_ __attribute__((ext_vector_type(2))); \
        *(__attribute__((address_space(1))) i2_*)(PART + ((size_t)itc.s * rows + itc.row) * 128 + 16 * g + 2 * c8) = (i2_){keep0_, keep1_}; \
        __builtin_amdgcn_sched_barrier(0); \
        asm volatile("" :: "v"(idg.x), "v"(HRN.x));     \
        __builtin_amdgcn_sched_barrier(0); \
        itc = itn; itn = itn2; } while (0)
    UItem itc = u_item(0, n, nrw, sd, wave), itn = u_item(1, n, nrw, sd, wave), itn2;
    U_GLOAD(itc); U_LDS_E();
    __builtin_amdgcn_sched_barrier(0);
    U_GLOAD(itn); U_LOAD_H(hrA, itc);
    __builtin_amdgcn_sched_barrier(0);
    U_LOAD_T(tA, itc);
    __builtin_amdgcn_sched_barrier(0);
    { const UItem ita = u_item(2, n, nrw, sd, wave), itb = u_item(3, n, nrw, sd, wave);
      __builtin_amdgcn_sched_barrier(0);
      itn2 = ita; U_STEP(hrA, tA, hrB, tB);
      itn2 = itb; U_STEP(hrB, tB, hrA, tA); }
    for (int k = 2; k < n; k += 2) {
        const UItem ita = u_item(k + 2, n, nrw, sd, wave), itb = u_item(k + 3, n, nrw, sd, wave);
        __builtin_amdgcn_sched_barrier(0);
        itn2 = ita;
        U_STEP(hrA, tA, hrB, tB);
        itn2 = itb;
        U_STEP(hrB, tB, hrA, tA);
    }
#undef U_GLOAD
#undef U_LDS_E
#undef U_LOAD_H
#undef U_LOAD_T
#undef U_STEP
}
__device__ __forceinline__ void peer_coef_pass(const int* __restrict__ PART, const int* __restrict__ IDX, const float* __restrict__ GWT, const float* __restrict__ SU, const float* __restrict__ SV,
                                               const float* __restrict__ SH, signed char* __restrict__ COEFQ, float* __restrict__ CS, int rows, int tid) {
    const int wave = tid >> 6, lane = tid & 63, j0 = 16 * (lane >> 3) + (lane & 7), j1 = j0 + 8;
    for (int row = blockIdx.x * 8 + wave; row < rows; row += grid_x() * 8) {
        const size_t i = (size_t)row * 128;
        int d0 = 0, d1 = 0;
#pragma unroll
        for (int s = 0; s < 16; ++s) { const int2 v = *(const int2*)(PART + (size_t)s * rows * 128 + i + 2 * lane); d0 += v.x; d1 += v.y; }
        const int e0 = IDX[i + j0], e1 = IDX[i + j1]; const float sh = SH[row];
        const float c0 = gelu_fast((float)d0 * SU[e0] * sh) * GWT[i + j0] * SV[e0], c1 = gelu_fast((float)d1 * SU[e1] * sh) * GWT[i + j1] * SV[e1];
        const float mx = wmax(fmaxf(fabsf(c0), fabsf(c1)));
        const float sc = mx > 0.f ? mx * (1.f / 16383.f) : 1.f, inv = 1.f / sc;
        const int q0 = __float2int_rn(c0 * inv), q1 = __float2int_rn(c1 * inv);
        signed char* cq = COEFQ + (size_t)row * 256;
        cq[j0] = (signed char)(q0 >> 7); cq[j1] = (signed char)(q1 >> 7); cq[128 + j0] = (signed char)(q0 & 127); cq[128 + j1] = (signed char)(q1 & 127);
        if (lane == 0) CS[row] = sc;
    }
}
typedef unsigned uv2_ __attribute__((ext_vector_type(2))); typedef int v4i_ __attribute__((ext_vector_type(4)));
__device__ __forceinline__ void peer_v_pass(const signed char* __restrict__ COEFQ, const float* __restrict__ CS, const int* __restrict__ IDX, const unsigned char* __restrict__ VQ, float* __restrict__ F, int rows, int tid) {
    const int wave = __builtin_amdgcn_readfirstlane(tid >> 6), lane = tid & 63, n16 = lane & 15, kg = lane >> 4, rsel = n16 >> 3, c8 = n16 & 7;
    SliceDeal sd; sd.init();
    const int npairs = rows >> 1, first = sd.r * 8 + wave, stepw = sd.R * 8;
    const int nrw = first < npairs ? (npairs - first + stepw - 1) / stepw : 0, nsl = sd.x < 16 ? (16 - sd.x + sd.nx - 1) / sd.nx : 0, n = nrw * nsl;
    if (n == 0) return;
    uint4 rawA[8], rawB[8], ee[2], idg, cfg; uv2_ aq; v4i_ acc[16]; unsigned tr[32];
    const int arow = n16 & 3;
    typedef __attribute__((address_space(3))) uv4 L4; typedef __attribute__((address_space(3))) uv2_ L2_;
    const unsigned wl = (unsigned)wave * 3072u, wr_id = 16u * lane, wr_cf = 1024u + 16u * (lane & 31), rd_id = (unsigned)rsel * 512u + 128u * kg, rd_cf = 1024u + (unsigned)(arow >> 1) * 256u + (unsigned)(arow & 1) * 128u + 32u * kg;
#define V_GLOAD(IT) do { idg = ldg4(IDX + (size_t)(2 * (IT).row) * 128 + 4 * lane); cfg = ldg4(COEFQ + (size_t)(2 * (IT).row) * 256 + 16 * (lane & 31)); } while (0)
#define V_LWRITE(SL) do { *(L4*)(size_t)(wl + (SL) + wr_id) = (uv4){idg.x, idg.y, idg.z, idg.w}; *(L4*)(size_t)(wl + (SL) + wr_cf) = (uv4){cfg.x, cfg.y, cfg.z, cfg.w}; } while (0)
#define V_LREAD(SL_E, Q_E, SL_A, Q_A) do { const uv4 a_ = *(const L4*)(size_t)(wl + (SL_E) + rd_id + 32u * (Q_E)), b_ = *(const L4*)(size_t)(wl + (SL_E) + rd_id + 32u * (Q_E) + 16u); \
        ee[0] = make_uint4(a_.x, a_.y, a_.z, a_.w); ee[1] = make_uint4(b_.x, b_.y, b_.z, b_.w); aq = *(const L2_*)(size_t)(wl + (SL_A) + rd_cf + 8u * (Q_A)); } while (0)
#define V_LOAD_T(RAW, IT) do { const unsigned char* vs_ = VQ + (size_t)(IT).s * 16384 * 128 + 16 * c8; \
        RAW[0] = ldg4(vs_ + ee[0].x * 128u); RAW[1] = ldg4(vs_ + ee[0].y * 128u); RAW[2] = ldg4(vs_ + ee[0].z * 128u); RAW[3] = ldg4(vs_ + ee[0].w * 128u); \
        RAW[4] = ldg4(vs_ + ee[1].x * 128u); RAW[5] = ldg4(vs_ + ee[1].y * 128u); RAW[6] = ldg4(vs_ + ee[1].z * 128u); RAW[7] = ldg4(vs_ + ee[1].w * 128u); } while (0)
#define V_T4(A_, B_, C_, D_, O_) do { const unsigned abl_ = __builtin_amdgcn_perm(B_, A_, 0x05010400u), abh_ = __builtin_amdgcn_perm(B_, A_, 0x07030602u), \
        cdl_ = __builtin_amdgcn_perm(D_, C_, 0x05010400u), cdh_ = __builtin_amdgcn_perm(D_, C_, 0x07030602u); \
        tr[(O_)] = __builtin_amdgcn_perm(cdl_, abl_, 0x05040100u); tr[(O_) + 2] = __builtin_amdgcn_perm(cdl_, abl_, 0x07060302u); \
        tr[(O_) + 4] = __builtin_amdgcn_perm(cdh_, abh_, 0x05040100u); tr[(O_) + 6] = __builtin_amdgcn_perm(cdh_, abh_, 0x07060302u); } while (0)
#define V_TRANS(RAW) do { V_T4(RAW[0].x, RAW[1].x, RAW[2].x, RAW[3].x, 0); V_T4(RAW[4].x, RAW[5].x, RAW[6].x, RAW[7].x, 1); V_T4(RAW[0].y, RAW[1].y, RAW[2].y, RAW[3].y, 8); V_T4(RAW[4].y, RAW[5].y, RAW[6].y, RAW[7].y, 9); \
        V_T4(RAW[0].z, RAW[1].z, RAW[2].z, RAW[3].z, 16); V_T4(RAW[4].z, RAW[5].z, RAW[6].z, RAW[7].z, 17); V_T4(RAW[0].w, RAW[1].w, RAW[2].w, RAW[3].w, 24); V_T4(RAW[4].w, RAW[5].w, RAW[6].w, RAW[7].w, 25); } while (0)
#define V_MMA(FIRST) do { const v4i_ vzero_ = {0, 0, 0, 0}; const uv2_ am_ = n16 < 4 ? aq : (uv2_){0u, 0u}; const long al_ = __builtin_bit_cast(long, am_); \
        _Pragma("unroll") for (int t_ = 0; t_ < 16; ++t_) { const long bl_ = __builtin_bit_cast(long, (uv2_){tr[2 * t_], tr[2 * t_ + 1]}); \
            acc[t_] = __builtin_amdgcn_mfma_i32_16x16x32_i8(al_, bl_, (FIRST) ? vzero_ : acc[t_], 0, 0, 0); } } while (0)
#define V_STEP(RAW, SL_E, Q_E, SL_A, Q_A, IT_T, FIRST) do { \
        V_LREAD(SL_E, Q_E, SL_A, Q_A); \
        V_TRANS(RAW); \
        __builtin_amdgcn_sched_barrier(0); \
        V_LOAD_T(RAW, IT_T); \
        __builtin_amdgcn_sched_barrier(0); \
        V_MMA(FIRST); \
        __builtin_amdgcn_sched_barrier(0); } while (0)
    UItem itc = u_item(0, n, nrw, sd, wave), itn = u_item(1, n, nrw, sd, wave);
    V_GLOAD(itc); V_LWRITE(0u);
    V_LREAD(0u, 0, 0u, 0); V_LOAD_T(rawA, itc);
    __builtin_amdgcn_sched_barrier(0);
    V_LREAD(0u, 1, 0u, 1); V_LOAD_T(rawB, itc);
    __builtin_amdgcn_sched_barrier(0);
    unsigned cur = 0u;
    for (int k = 0; k < n; ++k) {
        const unsigned nxt = 1536u - cur;
        V_GLOAD(itn);
        __builtin_amdgcn_sched_barrier(0);
        V_STEP(rawA, cur, 2, cur, 0, itc, true);
        V_STEP(rawB, cur, 3, cur, 1, itc, false);
        V_LWRITE(nxt);
        __builtin_amdgcn_sched_barrier(0);
        V_STEP(rawA, nxt, 0, cur, 2, itn, false);
        V_STEP(rawB, nxt, 1, cur, 3, itn, false);
        {
            typedef __attribute__((address_space(3))) fv4 LF4;
            const unsigned fs_ = 24576u + (unsigned)wave * 1024u;
            if (kg == 0) { const float cs_ = CS[2 * itc.row + rsel];
#pragma unroll
                for (int q4 = 0; q4 < 4; ++q4) { fv4 o_;
#pragma unroll
                    for (int tt = 0; tt < 4; ++tt) { const v4i_ a_ = acc[4 * q4 + tt]; const int hv_ = rsel ? a_.z : a_.x, lv_ = rsel ? a_.w : a_.y; o_[tt] = (float)(hv_ * 128 + lv_) * cs_; }
                    *(LF4*)(size_t)(fs_ + (unsigned)n16 * 64u + 16u * q4) = o_; } }
            const fv4 w_ = *(const LF4*)(size_t)(fs_ + 16u * lane);
            *(GF4*)(F + (size_t)(2 * itc.row + (lane >> 5)) * D + 128 * itc.s + 4 * (lane & 31)) = w_;
        }
        __builtin_amdgcn_sched_barrier(0);
        itc = itn; itn = u_item(k + 2, n, nrw, sd, wave); cur = nxt;
    }
#undef V_GLOAD
#undef V_LWRITE
#undef V_LREAD
#undef V_LOAD_T
#undef V_T4
#undef V_TRANS
#undef V_MMA
#undef V_STEP
}
template <bool LAST>
__device__ __forceinline__ void peer_row_pass(float* __restrict__ X, const float* __restrict__ F, const float* __restrict__ MODl, const float* __restrict__ gnext, const float* __restrict__ MODn,
                                              bf16_t* __restrict__ Hn, float* __restrict__ out, int rows, int tid) {
    const int wave = tid >> 6, lane = tid & 63;
    for (int row = blockIdx.x * 8 + wave; row < rows; row += grid_x() * 8) {
        const float* md = MODl + (row < S ? 0 : NMOD) + 5 * D;
        float4 v[8]; float ss = 0.f;
#pragma unroll
        for (int i = 0; i < 8; ++i) { const int col = 4 * lane + 256 * i; const float4 x = *(const float4*)(X + (size_t)row * D + col), f = *(const float4*)(F + (size_t)row * D + col), g2 = *(const float4*)(md + col);
            v[i] = make_float4(x.x + g2.x * f.x, x.y + g2.y * f.y, x.z + g2.z * f.z, x.w + g2.w * f.w);
            ss += v[i].x * v[i].x + v[i].y * v[i].y + v[i].z * v[i].z + v[i].w * v[i].w;
            if (!LAST) *(float4*)(X + (size_t)row * D + col) = v[i]; }
        ss = wsum(ss);
        const float rs = rsqrtf(ss * (1.f / D) + EPS);
        const float* mn = LAST ? nullptr : MODn + (row < S ? 0 : NMOD);
#pragma unroll
        for (int i = 0; i < 8; ++i) { const int col = 4 * lane + 256 * i; const float4 g = *(const float4*)(gnext + col);
            if (LAST) *(float4*)(out + (size_t)row * D + col) = make_float4(v[i].x * rs * g.x, v[i].y * rs * g.y, v[i].z * rs * g.z, v[i].w * rs * g.w);
            else { const float4 sh = *(const float4*)(mn + col), sc = *(const float4*)(mn + D + col);
                uint2 p; p.x = pk2(v[i].x * rs * g.x * (1.f + sc.x) + sh.x, v[i].y * rs * g.y * (1.f + sc.y) + sh.y); p.y = pk2(v[i].z * rs * g.z * (1.f + sc.z) + sh.z, v[i].w * rs * g.w * (1.f + sc.w) + sh.w);
                *(uint2*)(Hn + (size_t)row * D + col) = p; } }
    }
}
__device__ __forceinline__ void keys_split_phase(const float* __restrict__ keys, bf16_t* __restrict__ KS, int n_rows, int tid) {
    for (int i = blockIdx.x * 512 + tid; i < n_rows * 32; i += grid_x() * 512) {
        const int row = i >> 5, c4 = (i & 31) * 4; const float4 v = *(const float4*)(keys + (size_t)row * 128 + c4);
        uint2 h; h.x = pk2(v.x, v.y); h.y = pk2(v.z, v.w);
        uint2 lo; lo.x = pk2(v.x - bf2f(h.x), v.y - bf2f(h.x >> 16)); lo.y = pk2(v.z - bf2f(h.y), v.w - bf2f(h.y >> 16));
        *(uint2*)(KS + (size_t)row * 256 + c4) = h; *(uint2*)(KS + (size_t)row * 256 + 128 + c4) = lo;
    }
}
#define SORT16_DESC(K) do { \
    { const unsigned hi_ = max(K[0], K[1]), lo_ = min(K[0], K[1]); K[0] = hi_; K[1] = lo_; } \
    { const unsigned hi_ = max(K[3], K[2]), lo_ = min(K[3], K[2]); K[3] = hi_; K[2] = lo_; } \
    { const unsigned hi_ = max(K[4], K[5]), lo_ = min(K[4], K[5]); K[4] = hi_; K[5] = lo_; } \
    { const unsigned hi_ = max(K[7], K[6]), lo_ = min(K[7], K[6]); K[7] = hi_; K[6] = lo_; } \
    { const unsigned hi_ = max(K[8], K[9]), lo_ = min(K[8], K[9]); K[8] = hi_; K[9] = lo_; } \
    { const unsigned hi_ = max(K[11], K[10]), lo_ = min(K[11], K[10]); K[11] = hi_; K[10] = lo_; } \
    { const unsigned hi_ = max(K[12], K[13]), lo_ = min(K[12], K[13]); K[12] = hi_; K[13] = lo_; } \
    { const unsigned hi_ = max(K[15], K[14]), lo_ = min(K[15], K[14]); K[15] = hi_; K[14] = lo_; } \
    { const unsigned hi_ = max(K[0], K[2]), lo_ = min(K[0], K[2]); K[0] = hi_; K[2] = lo_; } \
    { const unsigned hi_ = max(K[1], K[3]), lo_ = min(K[1], K[3]); K[1] = hi_; K[3] = lo_; } \
    { const unsigned hi_ = max(K[6], K[4]), lo_ = min(K[6], K[4]); K[6] = hi_; K[4] = lo_; } \
    { const unsigned hi_ = max(K[7], K[5]), lo_ = min(K[7], K[5]); K[7] = hi_; K[5] = lo_; } \
    { const unsigned hi_ = max(K[8], K[10]), lo_ = min(K[8], K[10]); K[8] = hi_; K[10] = lo_; } \
    { const unsigned hi_ = max(K[9], K[11]), lo_ = min(K[9], K[11]); K[9] = hi_; K[11] = lo_; } \
    { const unsigned hi_ = max(K[14], K[12]), lo_ = min(K[14], K[12]); K[14] = hi_; K[12] = lo_; } \
    { const unsigned hi_ = max(K[15], K[13]), lo_ = min(K[15], K[13]); K[15] = hi_; K[13] = lo_; } \
    { const unsigned hi_ = max(K[0], K[1]), lo_ = min(K[0], K[1]); K[0] = hi_; K[1] = lo_; } \
    { const unsigned hi_ = max(K[2], K[3]), lo_ = min(K[2], K[3]); K[2] = hi_; K[3] = lo_; } \
    { const unsigned hi_ = max(K[5], K[4]), lo_ = min(K[5], K[4]); K[5] = hi_; K[4] = lo_; } \
    { const unsigned hi_ = max(K[7], K[6]), lo_ = min(K[7], K[6]); K[7] = hi_; K[6] = lo_; } \
    { const unsigned hi_ = max(K[8], K[9]), lo_ = min(K[8], K[9]); K[8] = hi_; K[9] = lo_; } \
    { const unsigned hi_ = max(K[10], K[11]), lo_ = min(K[10], K[11]); K[10] = hi_; K[11] = lo_; } \
    { const unsigned hi_ = max(K[13], K[12]), lo_ = min(K[13], K[12]); K[13] = hi_; K[12] = lo_; } \
    { const unsigned hi_ = max(K[15], K[14]), lo_ = min(K[15], K[14]); K[15] = hi_; K[14] = lo_; } \
    { const unsigned hi_ = max(K[0], K[4]), lo_ = min(K[0], K[4]); K[0] = hi_; K[4] = lo_; } \
    { const unsigned hi_ = max(K[1], K[5]), lo_ = min(K[1], K[5]); K[1] = hi_; K[5] = lo_; } \
    { const unsigned hi_ = max(K[2], K[6]), lo_ = min(K[2], K[6]); K[2] = hi_; K[6] = lo_; } \
    { const unsigned hi_ = max(K[3], K[7]), lo_ = min(K[3], K[7]); K[3] = hi_; K[7] = lo_; } \
    { const unsigned hi_ = max(K[12], K[8]), lo_ = min(K[12], K[8]); K[12] = hi_; K[8] = lo_; } \
    { const unsigned hi_ = max(K[13], K[9]), lo_ = min(K[13], K[9]); K[13] = hi_; K[9] = lo_; } \
    { const unsigned hi_ = max(K[14], K[10]), lo_ = min(K[14], K[10]); K[14] = hi_; K[10] = lo_; } \
    { const unsigned hi_ = max(K[15], K[11]), lo_ = min(K[15], K[11]); K[15] = hi_; K[11] = lo_; } \
    { const unsigned hi_ = max(K[0], K[2]), lo_ = min(K[0], K[2]); K[0] = hi_; K[2] = lo_; } \
    { const unsigned hi_ = max(K[1], K[3]), lo_ = min(K[1], K[3]); K[1] = hi_; K[3] = lo_; } \
    { const unsigned hi_ = max(K[4], K[6]), lo_ = min(K[4], K[6]); K[4] = hi_; K[6] = lo_; } \
    { const unsigned hi_ = max(K[5], K[7]), lo_ = min(K[5], K[7]); K[5] = hi_; K[7] = lo_; } \
    { const unsigned hi_ = max(K[10], K[8]), lo_ = min(K[10], K[8]); K[10] = hi_; K[8] = lo_; } \
    { const unsigned hi_ = max(K[11], K[9]), lo_ = min(K[11], K[9]); K[11] = hi_; K[9] = lo_; } \
    { const unsigned hi_ = max(K[14], K[12]), lo_ = min(K[14], K[12]); K[14] = hi_; K[12] = lo_; } \
    { const unsigned hi_ = max(K[15], K[13]), lo_ = min(K[15], K[13]); K[15] = hi_; K[13] = lo_; } \
    { const unsigned hi_ = max(K[0], K[1]), lo_ = min(K[0], K[1]); K[0] = hi_; K[1] = lo_; } \
    { const unsigned hi_ = max(K[2], K[3]), lo_ = min(K[2], K[3]); K[2] = hi_; K[3] = lo_; } \
    { const unsigned hi_ = max(K[4], K[5]), lo_ = min(K[4], K[5]); K[4] = hi_; K[5] = lo_; } \
    { const unsigned hi_ = max(K[6], K[7]), lo_ = min(K[6], K[7]); K[6] = hi_; K[7] = lo_; } \
    { const unsigned hi_ = max(K[9], K[8]), lo_ = min(K[9], K[8]); K[9] = hi_; K[8] = lo_; } \
    { const unsigned hi_ = max(K[11], K[10]), lo_ = min(K[11], K[10]); K[11] = hi_; K[10] = lo_; } \
    { const unsigned hi_ = max(K[13], K[12]), lo_ = min(K[13], K[12]); K[13] = hi_; K[12] = lo_; } \
    { const unsigned hi_ = max(K[15], K[14]), lo_ = min(K[15], K[14]); K[15] = hi_; K[14] = lo_; } \
    { const unsigned hi_ = max(K[0], K[8]), lo_ = min(K[0], K[8]); K[0] = hi_; K[8] = lo_; } \
    { const unsigned hi_ = max(K[1], K[9]), lo_ = min(K[1], K[9]); K[1] = hi_; K[9] = lo_; } \
    { const unsigned hi_ = max(K[2], K[10]), lo_ = min(K[2], K[10]); K[2] = hi_; K[10] = lo_; } \
    { const unsigned hi_ = max(K[3], K[11]), lo_ = min(K[3], K[11]); K[3] = hi_; K[11] = lo_; } \
    { const unsigned hi_ = max(K[4], K[12]), lo_ = min(K[4], K[12]); K[4] = hi_; K[12] = lo_; } \
    { const unsigned hi_ = max(K[5], K[13]), lo_ = min(K[5], K[13]); K[5] = hi_; K[13] = lo_; } \
    { const unsigned hi_ = max(K[6], K[14]), lo_ = min(K[6], K[14]); K[6] = hi_; K[14] = lo_; } \
    { const unsigned hi_ = max(K[7], K[15]), lo_ = min(K[7], K[15]); K[7] = hi_; K[15] = lo_; } \
    { const unsigned hi_ = max(K[0], K[4]), lo_ = min(K[0], K[4]); K[0] = hi_; K[4] = lo_; } \
    { const unsigned hi_ = max(K[1], K[5]), lo_ = min(K[1], K[5]); K[1] = hi_; K[5] = lo_; } \
    { const unsigned hi_ = max(K[2], K[6]), lo_ = min(K[2], K[6]); K[2] = hi_; K[6] = lo_; } \
    { const unsigned hi_ = max(K[3], K[7]), lo_ = min(K[3], K[7]); K[3] = hi_; K[7] = lo_; } \
    { const unsigned hi_ = max(K[8], K[12]), lo_ = min(K[8], K[12]); K[8] = hi_; K[12] = lo_; } \
    { const unsigned hi_ = max(K[9], K[13]), lo_ = min(K[9], K[13]); K[9] = hi_; K[13] = lo_; } \
    { const unsigned hi_ = max(K[10], K[14]), lo_ = min(K[10], K[14]); K[10] = hi_; K[14] = lo_; } \
    { const unsigned hi_ = max(K[11], K[15]), lo_ = min(K[11], K[15]); K[11] = hi_; K[15] = lo_; } \
    { const unsigned hi_ = max(K[0], K[2]), lo_ = min(K[0], K[2]); K[0] = hi_; K[2] = lo_; } \
    { const unsigned hi_ = max(K[1], K[3]), lo_ = min(K[1], K[3]); K[1] = hi_; K[3] = lo_; } \
    { const unsigned hi_ = max(K[4], K[6]), lo_ = min(K[4], K[6]); K[4] = hi_; K[6] = lo_; } \
    { const unsigned hi_ = max(K[5], K[7]), lo_ = min(K[5], K[7]); K[5] = hi_; K[7] = lo_; } \
    { const unsigned hi_ = max(K[8], K[10]), lo_ = min(K[8], K[10]); K[8] = hi_; K[10] = lo_; } \
    { const unsigned hi_ = max(K[9], K[11]), lo_ = min(K[9], K[11]); K[9] = hi_; K[11] = lo_; } \
    { const unsigned hi_ = max(K[12], K[14]), lo_ = min(K[12], K[14]); K[12] = hi_; K[14] = lo_; } \
    { const unsigned hi_ = max(K[13], K[15]), lo_ = min(K[13], K[15]); K[13] = hi_; K[15] = lo_; } \
    { const unsigned hi_ = max(K[0], K[1]), lo_ = min(K[0], K[1]); K[0] = hi_; K[1] = lo_; } \
    { const unsigned hi_ = max(K[2], K[3]), lo_ = min(K[2], K[3]); K[2] = hi_; K[3] = lo_; } \
    { const unsigned hi_ = max(K[4], K[5]), lo_ = min(K[4], K[5]); K[4] = hi_; K[5] = lo_; } \
    { const unsigned hi_ = max(K[6], K[7]), lo_ = min(K[6], K[7]); K[6] = hi_; K[7] = lo_; } \
    { const unsigned hi_ = max(K[8], K[9]), lo_ = min(K[8], K[9]); K[8] = hi_; K[9] = lo_; } \
    { const unsigned hi_ = max(K[10], K[11]), lo_ = min(K[10], K[11]); K[10] = hi_; K[11] = lo_; } \
    { const unsigned hi_ = max(K[12], K[13]), lo_ = min(K[12], K[13]); K[12] = hi_; K[13] = lo_; } \
    { const unsigned hi_ = max(K[14], K[15]), lo_ = min(K[14], K[15]); K[14] = hi_; K[15] = lo_; } \
} while (0)
#define MERGE16_DESC(K) do { \
    { const unsigned hi_ = max(K[0], K[8]), lo_ = min(K[0], K[8]); K[0] = hi_; K[8] = lo_; } \
    { const unsigned hi_ = max(K[1], K[9]), lo_ = min(K[1], K[9]); K[1] = hi_; K[9] = lo_; } \
    { const unsigned hi_ = max(K[2], K[10]), lo_ = min(K[2], K[10]); K[2] = hi_; K[10] = lo_; } \
    { const unsigned hi_ = max(K[3], K[11]), lo_ = min(K[3], K[11]); K[3] = hi_; K[11] = lo_; } \
    { const unsigned hi_ = max(K[4], K[12]), lo_ = min(K[4], K[12]); K[4] = hi_; K[12] = lo_; } \
    { const unsigned hi_ = max(K[5], K[13]), lo_ = min(K[5], K[13]); K[5] = hi_; K[13] = lo_; } \
    { const unsigned hi_ = max(K[6], K[14]), lo_ = min(K[6], K[14]); K[6] = hi_; K[14] = lo_; } \
    { const unsigned hi_ = max(K[7], K[15]), lo_ = min(K[7], K[15]); K[7] = hi_; K[15] = lo_; } \
    { const unsigned hi_ = max(K[0], K[4]), lo_ = min(K[0], K[4]); K[0] = hi_; K[4] = lo_; } \
    { const unsigned hi_ = max(K[1], K[5]), lo_ = min(K[1], K[5]); K[1] = hi_; K[5] = lo_; } \
    { const unsigned hi_ = max(K[2], K[6]), lo_ = min(K[2], K[6]); K[2] = hi_; K[6] = lo_; } \
    { const unsigned hi_ = max(K[3], K[7]), lo_ = min(K[3], K[7]); K[3] = hi_; K[7] = lo_; } \
    { const unsigned hi_ = max(K[8], K[12]), lo_ = min(K[8], K[12]); K[8] = hi_; K[12] = lo_; } \
    { const unsigned hi_ = max(K[9], K[13]), lo_ = min(K[9], K[13]); K[9] = hi_; K[13] = lo_; } \
    { const unsigned hi_ = max(K[10], K[14]), lo_ = min(K[10], K[14]); K[10] = hi_; K[14] = lo_; } \
    { const unsigned hi_ = max(K[11], K[15]), lo_ = min(K[11], K[15]); K[11] = hi_; K[15] = lo_; } \
    { const unsigned hi_ = max(K[0], K[2]), lo_ = min(K[0], K[2]); K[0] = hi_; K[2] = lo_; } \
    { const unsigned hi_ = max(K[1], K[3]), lo_ = min(K[1], K[3]); K[1] = hi_; K[3] = lo_; } \
    { const unsigned hi_ = max(K[4], K[6]), lo_ = min(K[4], K[6]); K[4] = hi_; K[6] = lo_; } \
    { const unsigned hi_ = max(K[5], K[7]), lo_ = min(K[5], K[7]); K[5] = hi_; K[7] = lo_; } \
    { const unsigned hi_ = max(K[8], K[10]), lo_ = min(K[8], K[10]); K[8] = hi_; K[10] = lo_; } \
    { const unsigned hi_ = max(K[9], K[11]), lo_ = min(K[9], K[11]); K[9] = hi_; K[11] = lo_; } \
    { const unsigned hi_ = max(K[12], K[14]), lo_ = min(K[12], K[14]); K[12] = hi_; K[14] = lo_; } \
    { const unsigned hi_ = max(K[13], K[15]), lo_ = min(K[13], K[15]); K[13] = hi_; K[15] = lo_; } \
    { const unsigned hi_ = max(K[0], K[1]), lo_ = min(K[0], K[1]); K[0] = hi_; K[1] = lo_; } \
    { const unsigned hi_ = max(K[2], K[3]), lo_ = min(K[2], K[3]); K[2] = hi_; K[3] = lo_; } \
    { const unsigned hi_ = max(K[4], K[5]), lo_ = min(K[4], K[5]); K[4] = hi_; K[5] = lo_; } \
    { const unsigned hi_ = max(K[6], K[7]), lo_ = min(K[6], K[7]); K[6] = hi_; K[7] = lo_; } \
    { const unsigned hi_ = max(K[8], K[9]), lo_ = min(K[8], K[9]); K[8] = hi_; K[9] = lo_; } \
    { const unsigned hi_ = max(K[10], K[11]), lo_ = min(K[10], K[11]); K[10] = hi_; K[11] = lo_; } \
    { const unsigned hi_ = max(K[12], K[13]), lo_ = min(K[12], K[13]); K[12] = hi_; K[13] = lo_; } \
    { const unsigned hi_ = max(K[14], K[15]), lo_ = min(K[14], K[15]); K[14] = hi_; K[15] = lo_; } \
} while (0)

__device__ __forceinline__ unsigned enc_key(float f, unsigned tag, unsigned mask) { unsigned u = __float_as_uint(f); u = (u & 0x80000000u) ? ~u : (u | 0x80000000u); return (u & mask) | tag; }
__device__ __forceinline__ float dec_key(unsigned k, unsigned mask) { unsigned u = k & mask; u = (u & 0x80000000u) ? (u & 0x7fffffffu) : ~u; return __uint_as_float(u); }
__device__ __forceinline__ unsigned sel4(int q, unsigned a, unsigned b, unsigned c, unsigned d) { const unsigned lo = (q & 1) ? b : a, hi = (q & 1) ? d : c; return (q & 2) ? hi : lo; }
template <int XM> __device__ __forceinline__ void xmerge16(unsigned (&K)[16], int lane) {
    unsigned o[16];
#pragma unroll
    for (int i = 0; i < 16; ++i) o[i] = (unsigned)shxl_i((int)K[15 - i], XM, lane);
#pragma unroll
    for (int i = 0; i < 16; ++i) K[i] = max(K[i], o[i]);
    MERGE16_DESC(K);
}
constexpr int SEL_KROW = 528;
constexpr int SEL_TAB = 256 * SEL_KROW;
__device__ __forceinline__ void peer_select_sort_phase(const bf16_t* __restrict__ QS, const bf16_t* __restrict__ KS, int* __restrict__ IDX, float* __restrict__ GWT, int rows, char* lds, int tid) {
    const int wave = tid >> 6, lane = tid & 63, n = lane & 15, q = lane >> 4;
    const int G = grid_x(), ngroups = rows / 16;
    const bool byhead = (G % 8) == 0;
    int* li = (int*)(lds + SEL_TAB + wave * 2048);
    for (int h = byhead ? (int)(blockIdx.x & 7) : 0; h < 8; h += byhead ? 8 : 1) {
        __syncthreads();
        for (int c = tid; c < 256 * 32; c += 512) { const int r = c >> 5, ch = c & 31;
            *(uint4*)(lds + r * SEL_KROW + ch * 16) = *(const uint4*)((const char*)KS + ((size_t)(h * 256 + r)) * 512 + ch * 16); }
        __syncthreads();
        const int rank = byhead ? (int)(blockIdx.x >> 3) : (int)blockIdx.x, nrank = byhead ? G / 8 : G;
        for (int grp = rank * 8 + wave; grp < ngroups; grp += nrank * 8) {
            const int token = grp * 16 + n;
            unsigned t12[2][16];
#pragma unroll
            for (int p = 0; p < 2; ++p) {
                bf16x8 qh[4], ql[4];
                const bf16_t* qp = QS + (size_t)token * (2 * D) + h * 256 + p * 128 + 8 * q;
#pragma unroll
                for (int ks = 0; ks < 4; ++ks) { qh[ks] = *(const bf16x8*)(qp + 32 * ks); ql[ks] = *(const bf16x8*)(qp + D + 32 * ks); }
                unsigned ka[16], kb[16];
                const char* kbase = lds + (p * 128 + n) * SEL_KROW + 16 * q;
#pragma unroll
                for (int g = 0; g < 8; ++g) { f32x4 acc = {0.f, 0.f, 0.f, 0.f};
#pragma unroll
                    for (int ks = 0; ks < 4; ++ks) { const bf16x8 kh = *(const bf16x8*)(kbase + 16 * g * SEL_KROW + 64 * ks), kl = *(const bf16x8*)(kbase + 16 * g * SEL_KROW + 256 + 64 * ks);
                        acc = __builtin_amdgcn_mfma_f32_16x16x32_bf16(kh, qh[ks], acc, 0, 0, 0);
                        acc = __builtin_amdgcn_mfma_f32_16x16x32_bf16(kh, ql[ks], acc, 0, 0, 0);
                        acc = __builtin_amdgcn_mfma_f32_16x16x32_bf16(kl, qh[ks], acc, 0, 0, 0); }
#pragma unroll
                    for (int j = 0; j < 4; ++j) { const unsigned k = enc_key(acc[j], (unsigned)(127 - (16 * g + 4 * q + j)), 0xFFFFFF80u); if (g < 4) ka[4 * g + j] = k; else kb[4 * (g - 4) + j] = k; } }
                SORT16_DESC(ka); SORT16_DESC(kb);
#pragma unroll
                for (int i = 0; i < 16; ++i) ka[i] = max(ka[i], kb[15 - i]);
                MERGE16_DESC(ka);
                xmerge16<16>(ka, lane); xmerge16<32>(ka, lane);
#pragma unroll
                for (int i = 0; i < 16; ++i) t12[p][i] = ka[i];
            }
#pragma unroll
            for (int p = 0; p < 2; ++p)
#pragma unroll
                for (int j = 0; j < 4; ++j) li[n * 32 + p * 16 + 4 * q + j] = 127 - (int)(sel4(q, t12[p][j], t12[p][4 + j], t12[p][8 + j], t12[p][12 + j]) & 127u);
            unsigned ck[16];
#pragma unroll
            for (int t = 0; t < 16; ++t) {
                if (t >= 13) { ck[t] = 0u; continue; }
                unsigned sa[4], sb[4];
#pragma unroll
                for (int qq = 0; qq < 4; ++qq) { const int c = qq + 4 * t; int a_, b_;
                    if (c < 16) { a_ = 0; b_ = c; } else if (c < 24) { a_ = 1; b_ = c - 16; } else if (c < 29) { a_ = 2; b_ = c - 24; } else if (c < 33) { a_ = 3; b_ = c - 29; }
                    else if (c < 36) { a_ = 4; b_ = c - 33; } else if (c < 42) { a_ = 5 + ((c - 36) >> 1); b_ = (c - 36) & 1; } else if (c < 50) { a_ = 8 + (c - 42); b_ = 0; } else { a_ = 0; b_ = 0; }
                    sa[qq] = t12[0][a_]; sb[qq] = t12[1][b_]; }
                const int c = q + 4 * t;
                const float sum = dec_key(sel4(q, sa[0], sa[1], sa[2], sa[3]), 0xFFFFFF80u) + dec_key(sel4(q, sb[0], sb[1], sb[2], sb[3]), 0xFFFFFF80u);
                ck[t] = c < 50 ? enc_key(sum, (unsigned)(63 - c), 0xFFFFFFC0u) : 0u;
            }
            SORT16_DESC(ck); xmerge16<16>(ck, lane); xmerge16<32>(ck, lane);
            const float top0 = dec_key(ck[0], 0xFFFFFFC0u);
            float e[4], es = 0.f; int oi[4];
            WAVE_LDS_SYNC();
#pragma unroll
            for (int j = 0; j < 4; ++j) {
                const unsigned kw = sel4(q, ck[j], ck[4 + j], ck[8 + j], ck[12 + j]);
                e[j] = __expf(dec_key(kw, 0xFFFFFFC0u) - top0); es += e[j];
                const int c = 63 - (int)(kw & 63u); int a_, b_;
                if (c < 16) { a_ = 0; b_ = c; } else if (c < 24) { a_ = 1; b_ = c - 16; } else if (c < 29) { a_ = 2; b_ = c - 24; } else if (c < 33) { a_ = 3; b_ = c - 29; }
                else if (c < 36) { a_ = 4; b_ = c - 33; } else if (c < 42) { a_ = 5 + ((c - 36) >> 1); b_ = (c - 36) & 1; } else { a_ = 8 + (c - 42); b_ = 0; }
                oi[j] = li[n * 32 + a_] * 128 + li[n * 32 + 16 + b_];
            }
            es += shxl_f(es, 16, lane); es += shxl_f(es, 32, lane);
            const float inv = 1.f / es;
            *(int4*)(IDX + (size_t)token * 128 + h * 16 + 4 * q) = make_int4(oi[0], oi[1], oi[2], oi[3]);
            *(float4*)(GWT + (size_t)token * 128 + h * 16 + 4 * q) = make_float4(e[0] * inv, e[1] * inv, e[2] * inv, e[3] * inv);
            WAVE_LDS_SYNC();
        }
    }
    __syncthreads();
}
constexpr int LDS_BYTES = 163840, XCH_OFF = 131072, XBW_OFF = 155648;
constexpr size_t W2_BAR = 65536, W2_RANK = 98304, W2_ACNT = 393216  , W2_ROPE = 131072, W2_MOD = 1 * MiB, W2_WIN = 2 * MiB, W2_WBR = 86 * MiB, W2_WOUT = 102 * MiB, W2_WQS = 118 * MiB, W2_X = 150 * MiB,
                 W2_QKV = 280 * MiB, W2_G = 427 * MiB, W2_HS = 280 * MiB, W2_QS = 427 * MiB, W2_B1 = 622 * MiB, W2_O = 687 * MiB, W2_IDX = 752 * MiB, W2_GWT = 761 * MiB,
                 W2_UB = 770 * MiB, W2_VB = 802 * MiB, W2_SU = 834 * MiB, W2_SV = 835 * MiB, W2_KS = 836 * MiB, W2_COEF = 838 * MiB, W2_PART = 557 * MiB, W2_APART = 848 * MiB  , W2_END = 884 * MiB;
struct FArgs { const float* in[22]; float* out; char* ws; };
struct AP {
    static __device__ __forceinline__ const void* ld(int i) {
        unsigned base = ARG_OFF; asm volatile("" : "+v"(base));
        const PG8_LAS unsigned* p = (const PG8_LAS unsigned*)(size_t)base;
        unsigned lo = p[2 * i], hi = p[2 * i + 1]; asm volatile("" : "+v"(lo), "+v"(hi));
        lo = __builtin_amdgcn_readfirstlane(lo); hi = __builtin_amdgcn_readfirstlane(hi);
        return (const void*)(const __attribute__((address_space(1))) void*)(((unsigned long long)hi << 32) | lo);
    }
    static __device__ __forceinline__ const float* in(int i) { return (const float*)ld(i); }
    static __device__ __forceinline__ float* out() { return (float*)ld(22); }
    static __device__ __forceinline__ char* ws() { return (char*)ld(23); }
};
__device__ __forceinline__ int make_tid(int wave_s) { unsigned z = 0u; asm volatile("" : "+v"(z)); int t = wave_s * 64 + (int)__builtin_amdgcn_mbcnt_hi(~0u, __builtin_amdgcn_mbcnt_lo(~0u, z)); asm volatile("" : "+v"(t)); return t; }
#ifndef MK_EMASK
#define MK_EMASK 0xFFFFu
#endif
#ifndef MK_DUP
#define MK_DUP -1
#define MK_DUP_L 0
#endif
#ifndef MK_MASK
#define MK_MASK 1023
#endif
#ifndef MK_PH_LO
#define MK_PH_LO 0
#define MK_PH_HI 1000
#endif
__global__ void __launch_bounds__(512, 2) mk_fwd(FArgs a_unused) {
    extern __shared__ __attribute__((aligned(16))) unsigned char lds[];
    PG8_LAS unsigned char* L = (PG8_LAS unsigned char*)lds;
    const int wave_s = __builtin_amdgcn_readfirstlane((int)threadIdx.x >> 6);
    if (threadIdx.x == 0) *(uint4*)(lds + XBW_OFF) = make_uint4(0u, 0u, 0u, 0u);
    if (threadIdx.x < 24) ((unsigned long long*)(lds + ARG_OFF))[threadIdx.x] = ((const unsigned long long*)&a_unused)[threadIdx.x];
    if (threadIdx.x == 24) ((unsigned long long*)(lds + ARG_OFF))[24] = (unsigned long long)gridDim.x;
    if (threadIdx.x == 25) { const unsigned myx = xb_xcc_id(); const unsigned rk = xb_add((unsigned*)(a_unused.ws + W2_RANK) + 64 * myx, 1u);
        ((unsigned*)(lds + ARG_OFF))[50] = myx; ((unsigned*)(lds + ARG_OFF))[51] = rk; }
    __syncthreads();
    XcdBarrier bar = xcd_barrier_post((unsigned*)(AP::ws() + W2_BAR), (volatile LAS unsigned*)(L + XBW_OFF));
#define WSP(T, off) ((T*)(AP::ws() + (off)))

#if MK_MASK & 1
    { const int tid = make_tid(wave_s); rope_table_phase(WSP(float, W2_ROPE), tid); keys_split_phase(AP::in(18), WSP(bf16_t, W2_KS), NL * 16 * 128, tid); }
#define CONVERT_LAYER(l, b0, nb) do { \
        { const int tid = make_tid(wave_s); cvt_T_phase<1>(AP::in(8) + (size_t)(l) * D * NCOL, D, NCOL, WSP(bf16_t, W2_WIN + (size_t)(l) * 42 * MiB), D, 0, (float*)lds, tid, b0, nb); } \
        { const int tid = make_tid(wave_s); cvt_T_phase<0>(AP::in(13) + (size_t)(l) * 768 * D, 768, D, WSP(bf16_t, W2_WBR + (size_t)(l) * 8 * MiB), D, 0, (float*)lds, tid, b0, nb); } \
        { const int tid = make_tid(wave_s); cvt_T_phase<0>(AP::in(14) + (size_t)(l) * 768 * D, 768, D, WSP(bf16_t, W2_WBR + (size_t)(l) * 8 * MiB), D, 768, (float*)lds, tid, b0, nb); } \
        { const int tid = make_tid(wave_s); cvt_T_phase<0>(AP::in(15) + (size_t)(l) * 512 * D, 512, D, WSP(bf16_t, W2_WBR + (size_t)(l) * 8 * MiB), D, 1536, (float*)lds, tid, b0, nb); } \
        { const int tid = make_tid(wave_s); cvt_T_phase<0>(AP::in(16) + (size_t)(l) * D * D, D, D, WSP(bf16_t, W2_WOUT + (size_t)(l) * 8 * MiB), D, 0, (float*)lds, tid, b0, nb); } \
        { const int tid = make_tid(wave_s); cvt_T_phase<3>(AP::in(17) + (size_t)(l) * D * D, D, D, WSP(bf16_t, W2_WQS + (size_t)(l) * 16 * MiB), D, 0, (float*)lds, tid, b0, nb); } \
        { const int tid = make_tid(wave_s); modvec_phase(AP::in(1), AP::in(3), AP::in(4) + (size_t)(l) * D * NMOD, AP::in(5) + (size_t)(l) * NMOD, WSP(float, W2_MOD) + (size_t)(l) * 2 * NMOD, tid, l, b0, nb); } } while (0)
    CONVERT_LAYER(0, (int)blockIdx.x, grid_x());
#endif
    xcd_barrier(bar);
    if (threadIdx.x == 0) {
        unsigned* bw = (unsigned*)(AP::ws() + W2_BAR); const unsigned myx = ((unsigned*)(lds + ARG_OFF))[50]; unsigned xi = 0, nx = 0, cnt = 1;
        for (unsigned j = 0; j < 16; ++j) { const unsigned c = xb_ld(&bw[XB_XCNT(j)]); if (c > 0u) { if (j < myx) ++xi; ++nx; } if (j == myx) cnt = c > 0u ? c : 1u; }
        ((unsigned*)(lds + ARG_OFF))[52] = xi; ((unsigned*)(lds + ARG_OFF))[53] = nx > 0u ? nx : 1u; ((unsigned*)(lds + ARG_OFF))[54] = cnt; }
    __syncthreads();
#if MK_MASK & 2
    {
        const int tid = make_tid(wave_s);
        norm_mod_phase<0>(AP::in(0), AP::in(2), AP::in(6), WSP(float, W2_MOD), 0, D, WSP(bf16_t, W2_B1), nullptr, MT, tid);
    }
#endif
    xcd_barrier(bar);
    for (int l = 0; l < NL; ++l) {
        const int rows = l < NL - 1 ? MT : S;
        for (int rep = 0; rep < ((MK_DUP == 2 && l == MK_DUP_L) ? 2 : 1); ++rep) {
#if MK_MASK & 4
        {
            const int tid = make_tid(wave_s);
            pg8::Gemm g{WSP(bf16_t, W2_B1), WSP(bf16_t, W2_WIN + (size_t)l * 42 * MiB), };
            int bx_ = (int)blockIdx.x; asm volatile("" : "+s"(bx_));
            pg8::StaticOrder so; so.init(MT, NCOL, grid_x(), bx_);
            pg8::EpiInprojF E{WSP(bf16_t, W2_QKV), WSP(bf16_t, W2_G), AP::in(10) + l * 128, AP::in(11) + l * 128, WSP(float, W2_ROPE), (PG8_LAS float*)(L + XCH_OFF)};
            pg8::gemm_phase<pg8::EpiInprojF, pg8::StaticOrder, 0, D, D, 32>(L, g, so, E, tid);
        }
#endif
        xcd_barrier(bar);
        }
        for (int rep = 0; rep < ((MK_DUP == 3 && l == MK_DUP_L) ? 2 : 1); ++rep) {
#if MK_MASK & 8
        {
            att::attn_phase(WSP(bf16_t, W2_QKV), WSP(bf16_t, W2_O), AP::in(9) + (size_t)l * 6 * 465, AP::in(12) + l * 4, AP::in(10) + l * 128, AP::in(11) + l * 128, WSP(float, W2_APART), (unsigned*)(AP::ws() + W2_ACNT) + (size_t)l * 128 * 64, l < NL - 1, (char*)lds, wave_s);
            const int G_ = grid_x(), c2 = G_ == 256 ? (int)blockIdx.x - 128 : (int)blockIdx.x, G2 = G_ == 256 ? 128 : G_;
            if (c2 >= 0) {
                const int tid = make_tid(wave_s);
                quant_rows_sliced_phase<true>(AP::in(19) + (size_t)l * 16384 * D, WSP(unsigned char, W2_UB), WSP(float, W2_SU), 16384, c2, G2, tid);
                quant_rows_sliced_phase<true>(AP::in(20) + (size_t)l * 16384 * D, WSP(unsigned char, W2_VB), WSP(float, W2_SV), 16384, c2, G2, tid);
                if (l + 1 < NL) { __syncthreads(); CONVERT_LAYER(l + 1, c2, G2); }
            }
        }
#endif
        xcd_barrier(bar);
        }
        for (int rep = 0; rep < ((MK_DUP == 4 && l == MK_DUP_L) ? 2 : 1); ++rep) {
#if MK_MASK & 16
        {
            const int tid = make_tid(wave_s);
            if (l == 0) ctx_gemm<0>(WSP(bf16_t, W2_O), WSP(bf16_t, W2_WBR), WSP(bf16_t, W2_G), nullptr, nullptr, WSP(bf16_t, W2_B1), tid);
            pg8::Gemm g{WSP(bf16_t, W2_O), WSP(bf16_t, W2_WBR + (size_t)l * 8 * MiB), };
            pg8::StaticOrder so; so.init(S, D, grid_x(), blockIdx.x);
            pg8::EpiBranchF E{WSP(bf16_t, W2_G), WSP(bf16_t, W2_B1)};
            pg8::gemm_phase<pg8::EpiBranchF, pg8::StaticOrder, 0, D, D, 32>(L, g, so, E, tid);
        }
#endif
        xcd_barrier(bar);
        }
        for (int rep = 0; rep < ((MK_DUP == 5 && l == MK_DUP_L) ? 2 : 1); ++rep) {
#if MK_MASK & 32
        {
            const int tid = make_tid(wave_s);
            float* X = WSP(float, W2_X);
            if (l == 0) ctx_gemm<1>(WSP(bf16_t, W2_B1), WSP(bf16_t, W2_WOUT), nullptr, AP::in(2), WSP(float, W2_MOD) + NMOD + 2 * D, X, tid);
            pg8::Gemm g{WSP(bf16_t, W2_B1), WSP(bf16_t, W2_WOUT + (size_t)l * 8 * MiB), };
            pg8::StaticOrder so; so.init(S, D, grid_x(), blockIdx.x);
            pg8::EpiOutF E{l == 0 ? AP::in(0) : X, l == 0 ? AP::in(2) : X + (size_t)S * D, WSP(float, W2_MOD) + (size_t)l * 2 * NMOD, X};
            pg8::gemm_phase<pg8::EpiOutF, pg8::StaticOrder, 0, D, D, 32>(L, g, so, E, tid);
        }
#endif
        xcd_barrier(bar);
        }
        for (int rep = 0; rep < ((MK_DUP == 6 && l == MK_DUP_L) ? 2 : 1); ++rep) {
#if MK_MASK & 64
        {
            const int tid = make_tid(wave_s);
            float* X = WSP(float, W2_X);
            norm2_q_phase(X, AP::in(7) + l * D, WSP(float, W2_MOD) + (size_t)l * 2 * NMOD, WSP(_Float16, W2_O), WSP(signed char, W2_HS), WSP(float, W2_SV + 512 * 1024), rows, tid);
        }
#endif
        xcd_barrier(bar);
        }
        for (int rep = 0; rep < ((MK_DUP == 7 && l == MK_DUP_L) ? 2 : 1); ++rep) {
#if MK_MASK & 128
        {
            const int tid = make_tid(wave_s);
            if (l == 0) ctx_gemm<2>(WSP(bf16_t, W2_O), WSP(bf16_t, W2_WQS), nullptr, nullptr, nullptr, WSP(bf16_t, W2_QS), tid);
            pg8::Gemm g{WSP(bf16_t, W2_O), WSP(bf16_t, W2_WQS + (size_t)l * 16 * MiB), };
            pg8::StaticOrder so; so.init(S, D, grid_x(), blockIdx.x);
            pg8::EpiQsplitF E{WSP(bf16_t, W2_QS)};
            pg8::gemm_phase<pg8::EpiQsplitF, pg8::StaticOrder, 0, D, D, 32, true>(L, g, so, E, tid);
        }
#endif
        xcd_barrier(bar);
        }
        for (int rep = 0; rep < ((MK_DUP == 8 && l == MK_DUP_L) ? 2 : 1); ++rep) {
#if MK_MASK & 256
        {
            const int tid = make_tid(wave_s);
            peer_select_sort_phase(WSP(bf16_t, W2_QS), WSP(bf16_t, W2_KS) + (size_t)l * 16 * 128 * 256, WSP(int, W2_IDX), WSP(float, W2_GWT), rows, (char*)lds, tid);
        }
#endif
        xcd_barrier(bar);
        }
        for (int rep = 0; rep < ((MK_DUP == 9 && l == NL - 1) ? 2 : 1); ++rep) {
        if (rep) xcd_barrier(bar);
        { const int tid = make_tid(wave_s); if (rep == 0) peer_u_pass<0xFFFFu>(WSP(signed char, W2_HS), WSP(int, W2_IDX), WSP(unsigned char, W2_UB), WSP(int, W2_PART), rows, tid);
#if MK_DUP == 9
          else peer_u_pass<MK_EMASK>(WSP(signed char, W2_HS), WSP(int, W2_IDX), WSP(unsigned char, W2_UB), WSP(int, 847 * MiB), rows, tid);
#endif
        }
        }
        xcd_barrier(bar);
        for (int rep = 0; rep < ((MK_DUP == 10 && l == NL - 1) ? 2 : 1); ++rep) { if (rep) xcd_barrier(bar);
        { const int tid = make_tid(wave_s); peer_coef_pass(WSP(int, W2_PART), WSP(int, W2_IDX), WSP(float, W2_GWT), WSP(float, W2_SU), WSP(float, W2_SV), WSP(float, W2_SV + 512 * 1024), WSP(signed char, W2_COEF), WSP(float, W2_SV + 768 * 1024), rows, tid); }
        }
        xcd_barrier(bar);
        for (int rep = 0; rep < ((MK_DUP == 11 && l == NL - 1) ? 2 : 1); ++rep) { if (rep) xcd_barrier(bar);
        { const int tid = make_tid(wave_s); peer_v_pass(WSP(signed char, W2_COEF), WSP(float, W2_SV + 768 * 1024), WSP(int, W2_IDX), WSP(unsigned char, W2_VB), WSP(float, W2_HS)  , rows, tid); }
        }
        xcd_barrier(bar);
        for (int rep = 0; rep < ((MK_DUP == 12 && l == NL - 1) ? 2 : 1); ++rep) { if (rep) xcd_barrier(bar);
        { const int tid = make_tid(wave_s);
          if (l < NL - 1) peer_row_pass<false>(WSP(float, W2_X), WSP(float, W2_HS), WSP(float, W2_MOD) + (size_t)l * 2 * NMOD, AP::in(6) + (l + 1) * D, WSP(float, W2_MOD) + (size_t)(l + 1) * 2 * NMOD, WSP(bf16_t, W2_B1), nullptr, rows, tid);
          else peer_row_pass<true>(WSP(float, W2_X), WSP(float, W2_HS), WSP(float, W2_MOD) + (size_t)l * 2 * NMOD, AP::in(21), nullptr, nullptr, AP::out(), rows, tid); }
        }
        if (l < NL - 1) xcd_barrier(bar);
    }
#undef WSP
}

extern "C" void kernel_launch(void* const* d_in, const int* in_sizes, int n_in, void* d_out, int out_size, void* d_ws, size_t ws_size, hipStream_t stream) {
    static int grid = 0;
    if (grid == 0) {
        if (n_in != 22 || ws_size < W2_END) { fprintf(stderr, "kernel_launch: bad args n_in %d ws %zu\n", n_in, ws_size); grid = -1; return; }
        int dev = 0, cus = 0;
        if (hipGetDevice(&dev) != hipSuccess || hipDeviceGetAttribute(&cus, hipDeviceAttributeMultiprocessorCount, dev) != hipSuccess) { grid = -1; return; }
        if (hipFuncSetAttribute((const void*)mk_fwd, hipFuncAttributeMaxDynamicSharedMemorySize, LDS_BYTES) != hipSuccess) { grid = -1; return; }
        int per_cu = 0;
        if (hipOccupancyMaxActiveBlocksPerMultiprocessor(&per_cu, (const void*)mk_fwd, 512, LDS_BYTES) != hipSuccess || per_cu < 1) { fprintf(stderr, "kernel_launch: occupancy query says %d\n", per_cu); }
        (void)hipGetLastError();
        grid = cus;
    }
    if (grid < 0) return;
    (void)hipMemsetAsync((char*)d_ws, 0, 1 * MiB, stream);
    FArgs a{};
    for (int i = 0; i < 22; ++i) a.in[i] = (const float*)d_in[i];
    a.out = (float*)d_out; a.ws = (char*)d_ws;
    hipLaunchKernelGGL(mk_fwd, dim3(grid), dim3(512), LDS_BYTES, stream, a);
}
```

```cpp
#include <hip/hip_runtime.h>
#include <stdint.h>
#include <stdio.h>
#ifndef MK_PARTSPLIT
#define MK_PARTSPLIT 0
#endif

constexpr int D = 2048, S = 16384, CT = 256, MT = S + CT, NL = 2;
constexpr int NCOL = 10752, NQKV = 4608, NGATE = 6144, NMOD = 12288;
constexpr int QA = 0, KA = 768, VA = 1536, QB = 2304, KB = 3072, VB = 3328, QC = 3584, KC = 4096, VC = 4352;
constexpr float EPS = 1e-6f;
constexpr float QSCALE = 0.08838834764831845f;

typedef unsigned short bf16_t;
typedef short bf16x8 __attribute__((ext_vector_type(8)));
typedef float f32x4 __attribute__((ext_vector_type(4)));

__device__ __forceinline__ float bf2f(unsigned b) { return __uint_as_float((b & 0xffffu) << 16); }
__device__ __forceinline__ bf16_t f2bf(float f) { unsigned u = __float_as_uint(f); u += 0x7fffu + ((u >> 16) & 1u); return (bf16_t)(u >> 16); }
__device__ __forceinline__ unsigned pk2(float lo, float hi) { return (unsigned)f2bf(lo) | ((unsigned)f2bf(hi) << 16); }
template <int CTRL> __device__ __forceinline__ float dpp_mov_f(float v) { return __builtin_bit_cast(float, __builtin_amdgcn_update_dpp(0, __builtin_bit_cast(int, v), CTRL, 0xF, 0xF, true)); }
__device__ __forceinline__ float swz16_f(float v) { return __builtin_bit_cast(float, __builtin_amdgcn_ds_swizzle(__builtin_bit_cast(int, v), 0x401F)); }
__device__ __forceinline__ float wsum(float v) {
    v += dpp_mov_f<0xB1>(v); v += dpp_mov_f<0x4E>(v); v += dpp_mov_f<0x141>(v); v += dpp_mov_f<0x140>(v); v += swz16_f(v);
    return __builtin_bit_cast(float, __builtin_amdgcn_readlane(__builtin_bit_cast(int, v), 0)) + __builtin_bit_cast(float, __builtin_amdgcn_readlane(__builtin_bit_cast(int, v), 32)); }
__device__ __forceinline__ float wmax(float v) {
    v = fmaxf(v, dpp_mov_f<0xB1>(v)); v = fmaxf(v, dpp_mov_f<0x4E>(v)); v = fmaxf(v, dpp_mov_f<0x141>(v)); v = fmaxf(v, dpp_mov_f<0x140>(v)); v = fmaxf(v, swz16_f(v));
    return fmaxf(__builtin_bit_cast(float, __builtin_amdgcn_readlane(__builtin_bit_cast(int, v), 0)), __builtin_bit_cast(float, __builtin_amdgcn_readlane(__builtin_bit_cast(int, v), 32))); }
__device__ __forceinline__ int shxl_i(int v, int M, int lane) { return __builtin_amdgcn_ds_bpermute((lane ^ M) << 2, v); }
__device__ __forceinline__ float shxl_f(float v, int M, int lane) { return __builtin_bit_cast(float, shxl_i(__builtin_bit_cast(int, v), M, lane)); }
__device__ __forceinline__ float silu_f(float x) { return x / (1.f + __expf(-x)); }
__device__ __forceinline__ float sigmoid_f(float x) { return 1.f / (1.f + __expf(-x)); }
__device__ __forceinline__ float gelu_tanh(float x) { const float u = 0.7978845608028654f * (x + 0.044715f * x * x * x); return 0.5f * x * (1.f + tanhf(u)); }

constexpr size_t MiB = 1u << 20;
__device__ __forceinline__ void wave_argmax(float& v, int& i) {
    for (int o = 32; o >= 1; o >>= 1) { const float ov = __shfl_xor(v, o); const int oi = __shfl_xor(i, o); if (ov > v || (ov == v && oi < i)) { v = ov; i = oi; } }
}
constexpr int ARG_OFF = 156672;
__device__ __forceinline__ int grid_x() { unsigned base = ARG_OFF; asm volatile("" : "+v"(base)); const __attribute__((address_space(3))) unsigned* p = (const __attribute__((address_space(3))) unsigned*)(size_t)base; unsigned v = p[48]; asm volatile("" : "+v"(v)); return (int)__builtin_amdgcn_readfirstlane(v); }

namespace pg8 {
#define PG8_LAS __attribute__((address_space(3)))
typedef unsigned u32x4 __attribute__((ext_vector_type(4)));
constexpr int BM = 256, BK = 64, HALF = 128, HTB = HALF * BK * 2, STAGE_BYTES = 8 * HTB, NXCD = 8, WGM = 8;
__host__ __device__ __forceinline__ int lds_byte(int r, int c) { const int st = (r >> 4) * 2 + (c >> 5), rr = r & 15, cc = c & 31, ob = rr * 64 + cc * 2; return st * 1024 + (ob ^ (((ob >> 9) & 1) << 5)); }
__host__ __device__ __forceinline__ void stage_rc(int b, int& R, int& C) { const int st = b / 1024, sb = b % 1024, swz = sb ^ (((sb >> 9) & 1) << 5); R = (st >> 1) * 16 + swz / 64; C = (st & 1) * 32 + (swz % 64) / 2; }
__host__ __device__ __forceinline__ int perm32(int rho) { const int n = rho >> 4, i = rho & 15; return 8 * (i >> 2) + 4 * n + (i & 3); }
struct Unit { int pm, pn; };
struct Gemm { const bf16_t* A; const bf16_t* Bt; };
struct StaticOrder {
    int nM, nN, nwg, G, c;
    __device__ void init(int M, int N, int G_, int c_) { nM = M / BM; nN = N / BM; nwg = nM * nN; G = G_; c = c_; }
    __device__ bool next(int i, Unit& u) const {
        const long L = (long)i * G + c; if (L >= nwg) return false;
        int wgid = (int)L; { const int q = nwg / NXCD, r = nwg % NXCD, xcd = wgid % NXCD, off = wgid / NXCD; wgid = (xcd < r ? xcd * (q + 1) : r * (q + 1) + (xcd - r) * q) + off; }
        const int nig = WGM * nN, gid = wgid / nig, fm = gid * WGM, gsz = (nM - fm) < WGM ? (nM - fm) : WGM;
        u.pm = fm + ((wgid % nig) % gsz); u.pn = (wgid % nig) / gsz; return true;
    }
};
__device__ __forceinline__ unsigned cvt_pk_bf16(float lo, float hi) { unsigned r; asm volatile("v_cvt_pk_bf16_f32 %0, %1, %2" : "=v"(r) : "v"(lo), "v"(hi)); return r; }
typedef _Float16 f16x8 __attribute__((ext_vector_type(8)));
template <bool F16> __device__ __forceinline__ f32x4 mma16(bf16x8 a, bf16x8 b, f32x4 c) {
    if constexpr (F16) return __builtin_amdgcn_mfma_f32_16x16x32_f16(__builtin_bit_cast(f16x8, a), __builtin_bit_cast(f16x8, b), c, 0, 0, 0);
    else return __builtin_amdgcn_mfma_f32_16x16x32_bf16(a, b, c, 0, 0, 0); }
template <int KMAP> __device__ __forceinline__ size_t koffA(int t) { return KMAP == 0 ? (size_t)t * 128 : (size_t)(t & 31) * 128 + (((t >> 5) == 1) ? 4096 : 0); }
template <int KMAP> __device__ __forceinline__ size_t koffB(int t) { return KMAP == 0 ? (size_t)t * 128 : (size_t)(t & 31) * 128 + (((t >> 5) == 2) ? 4096 : 0); }

template <class Epi, class Sched, int KMAP, int LDA, int LDB, int NT, bool F16 = false>
__device__ __forceinline__ void gemm_phase(PG8_LAS unsigned char* lds, const Gemm g, const Sched& S, const Epi& E, int tid) {
    const int wid = __builtin_amdgcn_readfirstlane(tid >> 6), lane = tid & 63, wr = wid >> 2, wc = wid & 3, fr = lane & 15, fq = lane >> 4;
    constexpr int nt = NT;
    unsigned voffA[2], voffB[2];
#pragma unroll
    for (int i = 0; i < 2; ++i) { int R, C; stage_rc(tid * 16 + i * 8192, R, C); const int Rb = Epi::PERM ? ((R & ~31) + perm32(R & 31)) : R;
        voffA[i] = (unsigned)(R * LDA + C) * 2u; voffB[i] = (unsigned)(Rb * LDB + C) * 2u; }
    constexpr size_t kstep = (size_t)(BK * 2);
    constexpr size_t hstepA = (size_t)HALF * LDA * 2, hstepB = (size_t)HALF * LDB * 2, tstepA = 2 * hstepA, tstepB = 2 * hstepB;
    const unsigned ldsw = (unsigned)wid * 1024u;
    const int aoff = lds_byte(wr * 64 + fr, fq * 8), boff = lds_byte(wc * 32 + fr, fq * 8);
#define PG8_SA(b, h) (((b) * 2 + (h)) * HTB)
#define PG8_SB(b, h) ((4 + (b) * 2 + (h)) * HTB)
#define PG8_STAGE(bufoff, gbase, voff) do { _Pragma("unroll") for (int _i = 0; _i < 2; ++_i) \
        __builtin_amdgcn_global_load_lds((const unsigned*)((const char*)(gbase) + (voff)[_i]), (PG8_LAS unsigned*)(lds + (bufoff) + ldsw + _i * 8192), 16, 0, 0); } while (0)
#define PG8_LDA(dst, b, h) do { _Pragma("unroll") for (int m = 0; m < 4; ++m) _Pragma("unroll") for (int k = 0; k < 2; ++k) dst[m][k] = *(const PG8_LAS bf16x8*)(lds + PG8_SA(b, h) + aoff + m * 2048 + k * 1024); } while (0)
#define PG8_LDB(dst, b, h) do { _Pragma("unroll") for (int n = 0; n < 2; ++n) _Pragma("unroll") for (int k = 0; k < 2; ++k) dst[n][k] = *(const PG8_LAS bf16x8*)(lds + PG8_SB(b, h) + boff + n * 2048 + k * 1024); } while (0)
#define PG8_MMA(ai, bj, At, Bt) do { __builtin_amdgcn_s_setprio(1); _Pragma("unroll") for (int m = 0; m < 4; ++m) _Pragma("unroll") for (int n = 0; n < 2; ++n) _Pragma("unroll") for (int k = 0; k < 2; ++k) \
        acc[ai][bj][m][n] = mma16<F16>(Bt[n][k], At[m][k], acc[ai][bj][m][n]); __builtin_amdgcn_s_setprio(0); } while (0)
#define PG8_WAIT_V(n) asm volatile("s_waitcnt vmcnt(" #n ")" ::: "memory")
#define PG8_WAIT_L(n) asm volatile("s_waitcnt lgkmcnt(" #n ")" ::: "memory")
#define PG8_BAR __builtin_amdgcn_s_barrier()
#define PG8_SCHED __builtin_amdgcn_sched_barrier(0)
    Unit cur, nxt; int ui = 0;
    if (!S.next(0, cur)) return;
    f32x4 acc[2][2][4][2];
#pragma unroll
    for (int a = 0; a < 2; ++a)
#pragma unroll
        for (int b = 0; b < 2; ++b)
#pragma unroll
            for (int m = 0; m < 4; ++m)
#pragma unroll
                for (int n = 0; n < 2; ++n) acc[a][b][m][n] = (f32x4){0.f, 0.f, 0.f, 0.f};
    bf16x8 At[4][2], B0[2][2], B1[2][2];
    const char* cA = (const char*)g.A + (size_t)cur.pm * tstepA; const char* cB = (const char*)g.Bt + (size_t)cur.pn * tstepB;
    PG8_STAGE(PG8_SB(0, 0), cB, voffB); PG8_STAGE(PG8_SB(0, 1), cB + hstepB, voffB); PG8_STAGE(PG8_SA(0, 0), cA, voffA); PG8_STAGE(PG8_SA(0, 1), cA + hstepA, voffA);
    if (wr == 1) PG8_BAR;
    PG8_WAIT_V(2); PG8_BAR;
    PG8_STAGE(PG8_SB(1, 0), cB + kstep, voffB); PG8_STAGE(PG8_SA(1, 0), cA + kstep, voffA); PG8_STAGE(PG8_SB(1, 1), cB + hstepB + kstep, voffB);
    PG8_WAIT_V(6); PG8_BAR;
    for (;;) {
        const bool has_next = S.next(ui + 1, nxt);
        const char* nA = has_next ? (const char*)g.A + (size_t)nxt.pm * tstepA : cA; const char* nB = has_next ? (const char*)g.Bt + (size_t)nxt.pn * tstepB : cB;
        for (int t = 0; t < nt; t += 2) {
            const bool last = (t == nt - 2);
            const char* a1 = cA + koffA<KMAP>(t) + kstep;
            const char* a2 = last ? nA : cA + koffA<KMAP>(t + 2); const char* b2 = last ? nB : cB + koffB<KMAP>(t + 2);
            const char* a3 = a2 + kstep; const char* b3 = b2 + kstep;
            if constexpr (Epi::HAS_MID) { if (t == Epi::MID1 || t == Epi::MID2) E.mid(acc, cur, t, tid); }
            PG8_LDB(B0, 0, 0); PG8_LDB(B1, 0, 1); PG8_SCHED; PG8_LDA(At, 0, 0); PG8_STAGE(PG8_SA(1, 1), a1 + hstepA, voffA);
            PG8_WAIT_V(8); PG8_WAIT_L(0); PG8_BAR; PG8_MMA(0, 0, At, B0); PG8_MMA(0, 1, At, B1); PG8_BAR; PG8_SCHED;
            PG8_LDA(At, 0, 1); PG8_STAGE(PG8_SB(0, 0), b2, voffB); PG8_STAGE(PG8_SB(0, 1), b2 + hstepB, voffB); PG8_STAGE(PG8_SA(0, 0), a2, voffA);
            PG8_WAIT_V(8); PG8_WAIT_L(0); PG8_BAR; PG8_MMA(1, 0, At, B0); PG8_MMA(1, 1, At, B1); PG8_BAR; PG8_SCHED;
            PG8_LDB(B0, 1, 0); PG8_LDB(B1, 1, 1); PG8_SCHED; PG8_LDA(At, 1, 0); PG8_STAGE(PG8_SA(0, 1), a2 + hstepA, voffA);
            PG8_WAIT_V(8); PG8_WAIT_L(0); PG8_BAR; PG8_MMA(0, 0, At, B0); PG8_MMA(0, 1, At, B1); PG8_BAR; PG8_SCHED;
            PG8_LDA(At, 1, 1); PG8_STAGE(PG8_SB(1, 0), b3, voffB); PG8_STAGE(PG8_SB(1, 1), b3 + hstepB, voffB); PG8_STAGE(PG8_SA(1, 0), a3, voffA);
            PG8_WAIT_V(8); PG8_WAIT_L(0); PG8_BAR; PG8_MMA(1, 0, At, B0); PG8_MMA(1, 1, At, B1); PG8_BAR; PG8_SCHED;
        }
        if (wr == 0) PG8_BAR;
        E(acc, cur, tid);
        if (!has_next) break;
#pragma unroll
        for (int a = 0; a < 2; ++a)
#pragma unroll
            for (int b = 0; b < 2; ++b)
#pragma unroll
                for (int m = 0; m < 4; ++m)
#pragma unroll
                    for (int n = 0; n < 2; ++n) acc[a][b][m][n] = (f32x4){0.f, 0.f, 0.f, 0.f};
        cur = nxt; cA = nA; cB = nB; ++ui;
        if (wr == 1) PG8_BAR;
    }
    PG8_WAIT_V(0);
    PG8_BAR;
#undef PG8_SA
#undef PG8_SB
#undef PG8_STAGE
#undef PG8_LDA
#undef PG8_LDB
#undef PG8_MMA
#undef PG8_WAIT_V
#undef PG8_WAIT_L
#undef PG8_BAR
#undef PG8_SCHED
}

typedef const f32x4 (&AccC)[2][2][4][2];
typedef f32x4 (&AccM)[2][2][4][2];
__device__ __forceinline__ u32x4 pack8(f32x4 v0, f32x4 v1) { u32x4 w; w.x = cvt_pk_bf16(v0[0], v0[1]); w.y = cvt_pk_bf16(v0[2], v0[3]); w.z = cvt_pk_bf16(v1[0], v1[1]); w.w = cvt_pk_bf16(v1[2], v1[3]); return w; }
__device__ __forceinline__ f32x4 sig4(f32x4 v) { f32x4 r;
#pragma unroll
    for (int j = 0; j < 4; ++j) r[j] = __builtin_amdgcn_rcpf(1.f + __builtin_amdgcn_exp2f(-1.4426950408889634f * v[j])); return r; }
__device__ __forceinline__ f32x4 unpack_lo4(unsigned a, unsigned b) { return (f32x4){__uint_as_float(a << 16), __uint_as_float(a & 0xffff0000u), __uint_as_float(b << 16), __uint_as_float(b & 0xffff0000u)}; }

struct EpiInprojF {
    static constexpr bool PERM = true, HAS_MID = false;
    bf16_t* QKV; bf16_t* G; const float* qn; const float* kn; const float* rope; PG8_LAS float* xch;
    __device__ __forceinline__ void operator()(AccC acc, const Unit& u, int tid) const {
        const int wid_ = __builtin_amdgcn_readfirstlane(tid >> 6), wr = wid_ >> 2, wc = wid_ & 3, fr = tid & 15, fq = (tid >> 4) & 3;
        const int pn = u.pn, rowb = u.pm * BM + wr * 64 + fr;
        if (pn >= 18) {
#pragma unroll
            for (int ai = 0; ai < 2; ++ai)
#pragma unroll
                for (int m = 0; m < 4; ++m) { bf16_t* rowp = G + (size_t)(rowb + ai * HALF + m * 16) * NGATE + (pn - 18) * BM + wc * 32 + 8 * fq;
#pragma unroll
                    for (int bj = 0; bj < 2; ++bj) *(u32x4*)(rowp + bj * HALF) = pack8(acc[ai][bj][m][0], acc[ai][bj][m][1]); }
            return;
        }
        const bool ropet = (pn >= 9 && pn <= 12) || (pn >= 14 && pn <= 16);
        if (!ropet) {
#pragma unroll
            for (int ai = 0; ai < 2; ++ai)
#pragma unroll
                for (int m = 0; m < 4; ++m) { bf16_t* rowp = QKV + (size_t)(rowb + ai * HALF + m * 16) * NQKV + pn * BM + wc * 32 + 8 * fq;
#pragma unroll
                    for (int bj = 0; bj < 2; ++bj) *(u32x4*)(rowp + bj * HALF) = pack8(acc[ai][bj][m][0], acc[ai][bj][m][1]); }
            return;
        }
        const bool nrm = pn <= 12; const int half = wc & 1;
        float rs[2][4];
        f32x4 gg[2][2];
#pragma unroll
        for (int bj = 0; bj < 2; ++bj)
#pragma unroll
            for (int n = 0; n < 2; ++n) gg[bj][n] = (f32x4){1.f, 1.f, 1.f, 1.f};
#pragma unroll
        for (int ai = 0; ai < 2; ++ai)
#pragma unroll
            for (int m = 0; m < 4; ++m) rs[ai][m] = 1.f;
        if (nrm) {
            const float qsc = (pn <= 11 && u.pm < (S / BM)) ? 0.088388347648318440f * 1.4426950408889634f : 1.f;
            const float* gv = (pn <= 11 ? qn : kn) + 64 * half + 8 * fq;
#pragma unroll
            for (int bj = 0; bj < 2; ++bj)
#pragma unroll
                for (int n = 0; n < 2; ++n) gg[bj][n] = *(const f32x4*)(gv + 32 * bj + 4 * n);
#pragma unroll
            for (int ai = 0; ai < 2; ++ai)
#pragma unroll
                for (int m = 0; m < 4; ++m) { float s = 0.f;
#pragma unroll
                    for (int bj = 0; bj < 2; ++bj)
#pragma unroll
                        for (int n = 0; n < 2; ++n) { const f32x4 x = acc[ai][bj][m][n]; s += (x[0] * x[0] + x[1] * x[1]) + (x[2] * x[2] + x[3] * x[3]); }
                    s += shxl_f(s, 16, tid & 63); s += shxl_f(s, 32, tid & 63);
                    if (fq == 0) xch[(ai * HALF + wr * 64 + m * 16 + fr) * 4 + wc] = s; }
            asm volatile("s_waitcnt lgkmcnt(0)" ::: "memory"); __builtin_amdgcn_s_barrier(); asm volatile("" ::: "memory");
#pragma unroll
            for (int ai = 0; ai < 2; ++ai)
#pragma unroll
                for (int m = 0; m < 4; ++m) { const int rl = ai * HALF + wr * 64 + m * 16 + fr; const float tot = xch[rl * 4 + wc] + xch[rl * 4 + (wc ^ 1)];
                    rs[ai][m] = __builtin_amdgcn_rsqf(tot * (1.f / 128.f) + EPS) * qsc; }
        }
        const bool dorope = u.pm < (S / BM);
#pragma unroll
        for (int ai = 0; ai < 2; ++ai)
#pragma unroll
            for (int m = 0; m < 4; ++m) {
                const int r = rowb + ai * HALF + m * 16;
                const int pos = half == 0 ? ((r >> 6) & 255) : (r & 63);
                const float* rp = rope + (size_t)(pos * 32 + 8 * fq) * 2;
                f32x4 y1[2], y2[2];
#pragma unroll
                for (int n = 0; n < 2; ++n) {
                    f32x4 x1 = acc[ai][0][m][n] * rs[ai][m] * gg[0][n], x2 = acc[ai][1][m][n] * rs[ai][m] * gg[1][n];
                    if (dorope) {
                        const f32x4 cs0 = *(const f32x4*)(rp + 8 * n), cs1 = *(const f32x4*)(rp + 8 * n + 4);
                        const f32x4 cc = {cs0[0], cs0[2], cs1[0], cs1[2]}, sn = {cs0[1], cs0[3], cs1[1], cs1[3]};
                        y1[n] = x1 * cc - x2 * sn; y2[n] = x2 * cc + x1 * sn;
                    } else { y1[n] = x1; y2[n] = x2; }
                }
                bf16_t* rowp = QKV + (size_t)r * NQKV + pn * BM + 64 * wc + 8 * fq;
                *(u32x4*)rowp = pack8(y1[0], y1[1]); *(u32x4*)(rowp + 32) = pack8(y2[0], y2[1]);
            }
    }
};
struct EpiBranchF {
    static constexpr bool PERM = true, HAS_MID = true; static constexpr int MID1 = 12, MID2 = 24;
    const bf16_t* G; bf16_t* MB;
    static __device__ __forceinline__ float ex(float x) { return fminf(__builtin_amdgcn_exp2f(-1.4426950408889634f * x), 1e30f); }
    __device__ __forceinline__ void mid(AccM acc, const Unit& u, int t, int tid) const {
        const int wid_ = __builtin_amdgcn_readfirstlane(tid >> 6), wr = wid_ >> 2, wc = wid_ & 3, fr = tid & 15, fq = (tid >> 4) & 3;
        const int gi = (t == MID1) ? 0 : 1;
        const bf16_t* gb = G + (size_t)(u.pm * BM + wr * 64 + fr) * NGATE + gi * D + u.pn * BM + wc * 32 + 8 * fq;
#pragma unroll
        for (int ai = 0; ai < 2; ++ai)
#pragma unroll
            for (int m = 0; m < 4; ++m) {
#pragma unroll
                for (int bj = 0; bj < 2; ++bj) { const bf16_t* gp = gb + (size_t)(ai * HALF + m * 16) * NGATE + bj * HALF;
                    const u32x4 ga = *(const u32x4*)gp, gc = *(const u32x4*)(gp + D);
                    const f32x4 a0 = unpack_lo4(ga.x, ga.y), a1 = unpack_lo4(ga.z, ga.w), c0 = unpack_lo4(gc.x, gc.y), c1 = unpack_lo4(gc.z, gc.w);
#pragma unroll
                    for (int j = 0; j < 4; ++j) {
                        acc[ai][bj][m][0][j] *= (1.f + ex(c0[j])) * __builtin_amdgcn_rcpf(1.f + ex(a0[j]));
                        acc[ai][bj][m][1][j] *= (1.f + ex(c1[j])) * __builtin_amdgcn_rcpf(1.f + ex(a1[j])); } }
                asm volatile("" ::: "memory");
            }
    }
    __device__ __forceinline__ void operator()(AccC acc, const Unit& u, int tid) const {
        const int wid_ = __builtin_amdgcn_readfirstlane(tid >> 6), wr = wid_ >> 2, wc = wid_ & 3, fr = tid & 15, fq = (tid >> 4) & 3;
        const int rowb = u.pm * BM + wr * 64 + fr, colb = u.pn * BM + wc * 32 + 8 * fq;
#pragma unroll
        for (int ai = 0; ai < 2; ++ai)
#pragma unroll
            for (int m = 0; m < 4; ++m) { const size_t r = (size_t)(rowb + ai * HALF + m * 16);
#pragma unroll
                for (int bj = 0; bj < 2; ++bj) { const u32x4 gc = *(const u32x4*)(G + r * NGATE + 2 * D + colb + bj * HALF);
                    const f32x4 c0 = unpack_lo4(gc.x, gc.y), c1 = unpack_lo4(gc.z, gc.w);
                    *(u32x4*)(MB + r * D + colb + bj * HALF) = pack8(acc[ai][bj][m][0] * sig4(c0), acc[ai][bj][m][1] * sig4(c1)); } }
    }
};
struct EpiOutF {
    static constexpr bool PERM = false, HAS_MID = false;
    const float* blat; const float* bctx; const float* MODl; float* X;
    __device__ __forceinline__ void operator()(AccC acc, const Unit& u, int tid) const {
        const int wid_ = __builtin_amdgcn_readfirstlane(tid >> 6), wr = wid_ >> 2, wc = wid_ & 3, fr = tid & 15, fq = (tid >> 4) & 3;
        const int rowb = u.pm * BM + wr * 64 + fr, colb = u.pn * BM + wc * 32 + 4 * fq; const bool isctx = u.pm >= (S / BM);
        const float* md = MODl + (isctx ? NMOD : 0) + 2 * D + colb;
        f32x4 gv[2][2];
#pragma unroll
        for (int bj = 0; bj < 2; ++bj)
#pragma unroll
            for (int n = 0; n < 2; ++n) gv[bj][n] = *(const f32x4*)(md + bj * HALF + n * 16);
#pragma unroll
        for (int ai = 0; ai < 2; ++ai)
#pragma unroll
            for (int m = 0; m < 4; ++m) { const int r = rowb + ai * HALF + m * 16; const float* bp = (isctx ? bctx + (size_t)(r - S) * D : blat + (size_t)r * D) + colb; float* xp = X + (size_t)r * D + colb;
#pragma unroll
                for (int bj = 0; bj < 2; ++bj)
#pragma unroll
                    for (int n = 0; n < 2; ++n) *(f32x4*)(xp + bj * HALF + n * 16) = *(const f32x4*)(bp + bj * HALF + n * 16) + gv[bj][n] * acc[ai][bj][m][n]; }
    }
};
struct EpiQsplitF {
    static constexpr bool PERM = true, HAS_MID = false;
    bf16_t* QS;
    __device__ __forceinline__ void operator()(AccC acc, const Unit& u, int tid) const {
        const int wid_ = __builtin_amdgcn_readfirstlane(tid >> 6), wr = wid_ >> 2, wc = wid_ & 3, fr = tid & 15, fq = (tid >> 4) & 3;
        const int rowb = u.pm * BM + wr * 64 + fr, colb = u.pn * BM + wc * 32 + 8 * fq;
#pragma unroll
        for (int ai = 0; ai < 2; ++ai)
#pragma unroll
            for (int m = 0; m < 4; ++m) { bf16_t* rp = QS + (size_t)(rowb + ai * HALF + m * 16) * (2 * D) + colb;
#pragma unroll
                for (int bj = 0; bj < 2; ++bj) { const f32x4 v0 = acc[ai][bj][m][0], v1 = acc[ai][bj][m][1]; const u32x4 hi = pack8(v0, v1);
                    const f32x4 h0 = unpack_lo4(hi.x, hi.y), h1 = unpack_lo4(hi.z, hi.w);
                    *(u32x4*)(rp + bj * HALF) = hi; *(u32x4*)(rp + D + bj * HALF) = pack8(v0 - h0, v1 - h1); } }
    }
};
}
template <bool F16 = false>
__device__ __forceinline__ f32x4 ctx_dot(const bf16_t* __restrict__ Ap, const bf16_t* __restrict__ Bp, int nk32) {
    f32x4 acc = {0.f, 0.f, 0.f, 0.f};
#pragma unroll 8
    for (int k = 0; k < nk32; ++k) { const bf16x8 a = *(const bf16x8*)(Ap + 32 * k), b = *(const bf16x8*)(Bp + 32 * k); acc = pg8::mma16<F16>(b, a, acc); }
    return acc;
}
template <int MODE>
__device__ __forceinline__ void ctx_gemm(const bf16_t* __restrict__ A, const bf16_t* __restrict__ Bt, const bf16_t* __restrict__ Gr, const float* __restrict__ base, const float* __restrict__ gvec,
                                         void* __restrict__ outp, int tid) {
    const int wave = tid >> 6, lane = tid & 63, fr = lane & 15, fq = lane >> 4;
    for (int item = blockIdx.x; item < 256; item += grid_x()) {
        const int n0 = (item >> 1) * 16, r0 = S + (item & 1) * 128 + wave * 16, row = r0 + fr, col = n0 + 4 * fq;
        if (MODE == 0) {
            const bf16_t* Ap = A + (size_t)row * D + 8 * fq; const bf16_t* Bp = Bt + (size_t)(n0 + fr) * D + 8 * fq;
            const f32x4 aa = ctx_dot(Ap, Bp, 24), ab = ctx_dot(Ap + 768, Bp + 768, 24), ac = ctx_dot(Ap + 1536, Bp + 1536, 16);
            const bf16_t* gp = Gr + (size_t)row * NGATE + col;
            const uint2 g0 = *(const uint2*)gp, g1 = *(const uint2*)(gp + D), g2 = *(const uint2*)(gp + 2 * D);
            const f32x4 s0 = pg8::sig4(pg8::unpack_lo4(g0.x, g0.y)), s1 = pg8::sig4(pg8::unpack_lo4(g1.x, g1.y)), s2 = pg8::sig4(pg8::unpack_lo4(g2.x, g2.y));
            const f32x4 m = s0 * aa + s1 * ab + s2 * ac;
            uint2 p; p.x = pk2(m[0], m[1]); p.y = pk2(m[2], m[3]); *(uint2*)((bf16_t*)outp + (size_t)row * D + col) = p;
        } else if (MODE == 1) {
            const f32x4 acc = ctx_dot(A + (size_t)row * D + 8 * fq, Bt + (size_t)(n0 + fr) * D + 8 * fq, 64);
            const f32x4 b = *(const f32x4*)(base + (size_t)(row - S) * D + col), g = *(const f32x4*)(gvec + col);
            *(f32x4*)((float*)outp + (size_t)row * D + col) = b + g * acc;
        } else {
            const f32x4 acc = ctx_dot<true>(A + (size_t)row * D + 8 * fq, Bt + (size_t)(n0 + fr) * D + 8 * fq, 64);
            uint2 hi; hi.x = pk2(acc[0], acc[1]); hi.y = pk2(acc[2], acc[3]);
            uint2 lo; lo.x = pk2(acc[0] - bf2f(hi.x), acc[1] - bf2f(hi.x >> 16)); lo.y = pk2(acc[2] - bf2f(hi.y), acc[3] - bf2f(hi.y >> 16));
            bf16_t* qp = (bf16_t*)outp + (size_t)row * (2 * D) + col; *(uint2*)qp = hi; *(uint2*)(qp + D) = lo;
        }
    }
}
#define WAVE_LDS_SYNC() asm volatile("s_waitcnt lgkmcnt(0)" ::: "memory")
__device__ __forceinline__ int winperm(int n) {
    const int pn = n >> 8; if (!((pn >= 9 && pn <= 12) || (pn >= 14 && pn <= 16))) return n;
    const int cl = n & 255, wc = cl >> 6, bj = (cl >> 5) & 1, x = cl & 31; return (n & ~255) + 128 * bj + 32 * wc + x;
}
template <int MODE>
__device__ __forceinline__ void cvt_T_phase(const float* __restrict__ W, int K, int N, bf16_t* __restrict__ WT, int ldt, int koff, float* scr, int tid, int b0, int nb) {
    const int nnb = N / 32, nitems = nnb * (K / 64);
    for (int it = b0; it < nitems; it += nb) {
        const int nb = it % nnb, kb = it / nnb, n0 = nb * 32, k0 = kb * 64;
        __syncthreads();
        { const int k = tid >> 3, n4 = (tid & 7) * 4; const float4 v = *(const float4*)(W + (size_t)(k0 + k) * N + n0 + n4); float* d = scr + k * 33 + n4; d[0] = v.x; d[1] = v.y; d[2] = v.z; d[3] = v.w; }
        __syncthreads();
        { const int n = tid >> 4, k4 = (tid & 15) * 4; const float v0 = scr[(k4 + 0) * 33 + n], v1 = scr[(k4 + 1) * 33 + n], v2 = scr[(k4 + 2) * 33 + n], v3 = scr[(k4 + 3) * 33 + n];
          const int dn = MODE == 1 ? winperm(n0 + n) : n0 + n; bf16_t* dp = WT + (size_t)dn * ldt + koff + k0 + k4;
          uint2 h;
          if (MODE == 3) { typedef _Float16 hf2_ __attribute__((ext_vector_type(2))); hf2_ a_; a_.x = (_Float16)v0; a_.y = (_Float16)v1; hf2_ b_; b_.x = (_Float16)v2; b_.y = (_Float16)v3; h.x = __builtin_bit_cast(unsigned, a_); h.y = __builtin_bit_cast(unsigned, b_); }
          else { h.x = pk2(v0, v1); h.y = pk2(v2, v3); }
          *(uint2*)dp = h;
          if (MODE == 2) { uint2 lo; lo.x = pk2(v0 - bf2f(h.x), v1 - bf2f(h.x >> 16)); lo.y = pk2(v2 - bf2f(h.y), v3 - bf2f(h.y >> 16)); *(uint2*)(dp + K) = lo; } }
    }
}
__device__ __forceinline__ void cvt_plain_phase(const float* __restrict__ src, bf16_t* __restrict__ dst, size_t n8, int tid) {
    for (size_t i = (size_t)blockIdx.x * 512 + tid; i < n8; i += (size_t)grid_x() * 512) {
        const float4 a = *(const float4*)(src + i * 8), b = *(const float4*)(src + i * 8 + 4);
        uint4 o; o.x = pk2(a.x, a.y); o.y = pk2(a.z, a.w); o.z = pk2(b.x, b.y); o.w = pk2(b.z, b.w); *(uint4*)(dst + i * 8) = o;
    }
}
__device__ __forceinline__ void rope_table_phase(float* __restrict__ rope, int tid) {
    for (int i = blockIdx.x * 512 + tid; i < 256 * 32; i += grid_x() * 512) {
        const int pos = i >> 5, f = i & 31; const float inv = powf(10000.f, -(float)f / 32.f); float sn, cs; sincosf((float)pos * inv, &sn, &cs);
        rope[2 * i] = cs; rope[2 * i + 1] = sn;
    }
}
__device__ __forceinline__ void modvec_phase(const float* __restrict__ c, const float* __restrict__ c_ctx, const float* __restrict__ w_mod, const float* __restrict__ b_mod, float* __restrict__ MOD, int tid, int l, int b0, int nb) {
    const int wave = tid >> 6, lane = tid & 63;
    for (int item = b0 * 8 + wave; item < NMOD / 12; item += nb * 8) {
        const int n0 = item * 12;
        const float* w = w_mod + n0;
        float a0[12], a1[12];
#pragma unroll
        for (int j = 0; j < 12; ++j) { a0[j] = 0.f; a1[j] = 0.f; }
#pragma unroll 4
        for (int i = 0; i < 32; ++i) { const int k = lane + 64 * i; const float s0 = silu_f(c[k]), s1 = silu_f(c_ctx[k]); const float4* wp = (const float4*)(w + (size_t)k * NMOD);
            const float4 w0 = wp[0], w1 = wp[1], w2 = wp[2]; const float wv[12] = {w0.x, w0.y, w0.z, w0.w, w1.x, w1.y, w1.z, w1.w, w2.x, w2.y, w2.z, w2.w};
#pragma unroll
            for (int j = 0; j < 12; ++j) { a0[j] += s0 * wv[j]; a1[j] += s1 * wv[j]; } }
#pragma unroll
        for (int j = 0; j < 12; ++j) { a0[j] = wsum(a0[j]); a1[j] = wsum(a1[j]); }
        if (lane == 0) {
#pragma unroll
            for (int j = 0; j < 12; ++j) { const float b = b_mod[n0 + j]; MOD[n0 + j] = a0[j] + b; MOD[NMOD + n0 + j] = a1[j] + b; } }
    }
}
template <int OUT>
__device__ __forceinline__ void norm_mod_phase(const float* __restrict__ xlat, const float* __restrict__ xctx, const float* __restrict__ gnorm, const float* __restrict__ MODl,
                                               int sh_off, int sc_off, bf16_t* __restrict__ Hb, _Float16* __restrict__ Hf, int rows, int tid) {
    const int wave = tid >> 6, lane = tid & 63, nw = grid_x() * 8;
    for (int row0 = blockIdx.x * 8 + wave; row0 < rows; row0 += 2 * nw) {
        const int row1 = row0 + nw; const bool has1 = row1 < rows;
        const float* xr0 = row0 < S ? xlat + (size_t)row0 * D : xctx + (size_t)(row0 - S) * D;
        const float* xr1 = has1 ? (row1 < S ? xlat + (size_t)row1 * D : xctx + (size_t)(row1 - S) * D) : xr0;
        float4 v0[8], v1[8]; float ss0 = 0.f, ss1 = 0.f;
#pragma unroll
        for (int i = 0; i < 8; ++i) { v0[i] = *(const float4*)(xr0 + 4 * lane + 256 * i); v1[i] = *(const float4*)(xr1 + 4 * lane + 256 * i); }
#pragma unroll
        for (int i = 0; i < 8; ++i) { ss0 += v0[i].x * v0[i].x + v0[i].y * v0[i].y + v0[i].z * v0[i].z + v0[i].w * v0[i].w; ss1 += v1[i].x * v1[i].x + v1[i].y * v1[i].y + v1[i].z * v1[i].z + v1[i].w * v1[i].w; }
        ss0 = wsum(ss0); ss1 = wsum(ss1);
        const float rs0 = rsqrtf(ss0 * (1.f / D) + EPS), rs1 = rsqrtf(ss1 * (1.f / D) + EPS);
        const float* md0 = MODl + (row0 < S ? 0 : NMOD); const float* md1 = MODl + (row1 < S ? 0 : NMOD);
#pragma unroll
        for (int i = 0; i < 8; ++i) {
            const int col = 4 * lane + 256 * i;
            const float4 g = *(const float4*)(gnorm + col);
#pragma unroll
            for (int r = 0; r < 2; ++r) {
                if (r == 1 && !has1) break;
                const int row = r ? row1 : row0; const float* md = r ? md1 : md0; const float rs = r ? rs1 : rs0; const float4 v = r ? v1[i] : v0[i];
                const float4 sh = *(const float4*)(md + sh_off + col), sc = *(const float4*)(md + sc_off + col);
                float4 o;
                o.x = v.x * rs * g.x * (1.f + sc.x) + sh.x; o.y = v.y * rs * g.y * (1.f + sc.y) + sh.y;
                o.z = v.z * rs * g.z * (1.f + sc.z) + sh.z; o.w = v.w * rs * g.w * (1.f + sc.w) + sh.w;
                uint2 p; p.x = pk2(o.x, o.y); p.y = pk2(o.z, o.w);
                if (OUT == 0) *(uint2*)(Hb + (size_t)row * D + col) = p;
                else if (OUT == 2) { typedef _Float16 hf4_ __attribute__((ext_vector_type(4))); hf4_ hv; hv.x = (_Float16)o.x; hv.y = (_Float16)o.y; hv.z = (_Float16)o.z; hv.w = (_Float16)o.w; *(hf4_*)(Hf + (size_t)row * D + col) = hv; }
                else { uint2 q; q.x = pk2(o.x - bf2f(p.x), o.y - bf2f(p.x >> 16)); q.y = pk2(o.z - bf2f(p.y), o.w - bf2f(p.y >> 16));
                    *(uint2*)(Hb + (size_t)row * (2 * D) + col) = p; *(uint2*)(Hb + (size_t)row * (2 * D) + D + col) = q;
                    typedef _Float16 hf4_ __attribute__((ext_vector_type(4))); hf4_ hv; hv.x = (_Float16)o.x; hv.y = (_Float16)o.y; hv.z = (_Float16)o.z; hv.w = (_Float16)o.w; *(hf4_*)(Hf + (size_t)row * D + col) = hv; }
            }
        }
    }
}
__device__ __forceinline__ void norm2_q_phase(const float* __restrict__ X, const float* __restrict__ gnorm, const float* __restrict__ MODl, _Float16* __restrict__ Hf, signed char* __restrict__ Hq,
                                              float* __restrict__ SH, int rows, int tid) {
    const int wave = tid >> 6, lane = tid & 63, nw = grid_x() * 8;
    for (int rowi = blockIdx.x * 8 + wave; rowi < rows; rowi += 2 * nw) {
        int row0 = rowi; asm volatile("" : "+v"(row0) :: "memory");
        const int row1 = row0 + nw; const bool has1 = row1 < rows; const int row1c = has1 ? row1 : row0;
        float4 v0[8], v1[8]; float ss0 = 0.f, ss1 = 0.f;
#pragma unroll
        for (int i = 0; i < 8; ++i) { v0[i] = *(const float4*)(X + (size_t)row0 * D + 4 * lane + 256 * i); v1[i] = *(const float4*)(X + (size_t)row1c * D + 4 * lane + 256 * i); }
#pragma unroll
        for (int i = 0; i < 8; ++i) { ss0 += v0[i].x * v0[i].x + v0[i].y * v0[i].y + v0[i].z * v0[i].z + v0[i].w * v0[i].w; ss1 += v1[i].x * v1[i].x + v1[i].y * v1[i].y + v1[i].z * v1[i].z + v1[i].w * v1[i].w; }
        ss0 = wsum(ss0); ss1 = wsum(ss1);
        const float rs0 = rsqrtf(ss0 * (1.f / D) + EPS), rs1 = rsqrtf(ss1 * (1.f / D) + EPS);
        const float* md0 = MODl + (row0 < S ? 0 : NMOD); const float* md1 = MODl + (row1c < S ? 0 : NMOD);
        float mx0 = 0.f, mx1 = 0.f;
#pragma unroll
        for (int i = 0; i < 8; ++i) {
            const int col = 4 * lane + 256 * i; const float4 g = *(const float4*)(gnorm + col);
            { const float4 sh = *(const float4*)(md0 + 3 * D + col), sc = *(const float4*)(md0 + 4 * D + col); float4 o;
              o.x = v0[i].x * rs0 * g.x * (1.f + sc.x) + sh.x; o.y = v0[i].y * rs0 * g.y * (1.f + sc.y) + sh.y; o.z = v0[i].z * rs0 * g.z * (1.f + sc.z) + sh.z; o.w = v0[i].w * rs0 * g.w * (1.f + sc.w) + sh.w;
              v0[i] = o; mx0 = fmaxf(mx0, fmaxf(fmaxf(fabsf(o.x), fabsf(o.y)), fmaxf(fabsf(o.z), fabsf(o.w)))); }
            { const float4 sh = *(const float4*)(md1 + 3 * D + col), sc = *(const float4*)(md1 + 4 * D + col); float4 o;
              o.x = v1[i].x * rs1 * g.x * (1.f + sc.x) + sh.x; o.y = v1[i].y * rs1 * g.y * (1.f + sc.y) + sh.y; o.z = v1[i].z * rs1 * g.z * (1.f + sc.z) + sh.z; o.w = v1[i].w * rs1 * g.w * (1.f + sc.w) + sh.w;
              v1[i] = o; mx1 = fmaxf(mx1, fmaxf(fmaxf(fabsf(o.x), fabsf(o.y)), fmaxf(fabsf(o.z), fabsf(o.w)))); }
        }
        mx0 = wmax(mx0); mx1 = wmax(mx1);
        const float s0 = mx0 > 0.f ? mx0 * (1.f / 127.f) : 1.f, s1 = mx1 > 0.f ? mx1 * (1.f / 127.f) : 1.f, i0 = 1.f / s0, i1 = 1.f / s1;
        typedef _Float16 hf4_ __attribute__((ext_vector_type(4)));
#pragma unroll
        for (int i = 0; i < 8; ++i) {
            const int col = 4 * lane + 256 * i;
            { hf4_ hv; hv.x = (_Float16)v0[i].x; hv.y = (_Float16)v0[i].y; hv.z = (_Float16)v0[i].z; hv.w = (_Float16)v0[i].w; *(hf4_*)(Hf + (size_t)row0 * D + col) = hv;
              const unsigned b0 = (unsigned)__float2int_rn(v0[i].x * i0) & 255u, b1 = (unsigned)__float2int_rn(v0[i].y * i0) & 255u, b2 = (unsigned)__float2int_rn(v0[i].z * i0) & 255u, b3 = (unsigned)__float2int_rn(v0[i].w * i0) & 255u;
              *(unsigned*)(Hq + (size_t)row0 * D + col) = b0 | (b1 << 8) | (b2 << 16) | (b3 << 24); }
            if (has1) { hf4_ hv; hv.x = (_Float16)v1[i].x; hv.y = (_Float16)v1[i].y; hv.z = (_Float16)v1[i].z; hv.w = (_Float16)v1[i].w; *(hf4_*)(Hf + (size_t)row1 * D + col) = hv;
              const unsigned b0 = (unsigned)__float2int_rn(v1[i].x * i1) & 255u, b1 = (unsigned)__float2int_rn(v1[i].y * i1) & 255u, b2 = (unsigned)__float2int_rn(v1[i].z * i1) & 255u, b3 = (unsigned)__float2int_rn(v1[i].w * i1) & 255u;
              *(unsigned*)(Hq + (size_t)row1 * D + col) = b0 | (b1 << 8) | (b2 << 16) | (b3 << 24); }
        }
        if (lane == 0) { SH[row0] = s0; if (has1) SH[row1] = s1; }
    }
}
namespace att {
using s16x4  = __attribute__((ext_vector_type(4))) short;
using f32x16 = __attribute__((ext_vector_type(16))) float;
using u32x4  = __attribute__((ext_vector_type(4))) unsigned;
constexpr int KVBLK = 64, QBLK = 32, NW = 8, LDQ = NQKV, LDK = NQKV, LDO = D;
constexpr float SCALE = 0.088388347648318440f, THR = 8.f, C2 = SCALE * 1.4426950408889634f;
constexpr size_t SHM_V = KVBLK * 128 * 2, SHM_K = KVBLK * 128 * 2, SHM_ATTN = 2 * SHM_V + 2 * SHM_K + NW * 64 * 4;
constexpr int RPB_OFF = 68 * 1024;
#define KSWZ(row, colB) ((row) * 256 + ((colB) ^ (((row) & 7) << 4)))
#define SBAR() __builtin_amdgcn_sched_barrier(0)
__device__ __forceinline__ int crow(int r, int hi) { return (r & 3) + 8 * (r >> 2) + 4 * hi; }
__device__ __forceinline__ unsigned cvtpk(float lo, float hi) { unsigned r; asm volatile("v_cvt_pk_bf16_f32 %0, %1, %2" : "=v"(r) : "v"(lo), "v"(hi)); return r; }
__device__ __forceinline__ void partialSM(f32x16& p0, f32x16& p1, float& m_reg, float& mn, float& alpha) {
  float pmax = p0[0]; for (int r = 1; r < 16; ++r) pmax = fmaxf(pmax, p0[r]); for (int r = 0; r < 16; ++r) pmax = fmaxf(pmax, p1[r]);
  { auto rr = __builtin_amdgcn_permlane32_swap(__float_as_uint(pmax), __float_as_uint(pmax), false, false);
    pmax = fmaxf(__uint_as_float(rr[0]), __uint_as_float(rr[1])); }
  if (__builtin_expect(__all(pmax - m_reg <= THR / SCALE), 1)) { mn = m_reg; alpha = 1.f; }
  else { mn = fmaxf(m_reg, pmax); alpha = __builtin_amdgcn_exp2f((m_reg - mn) * C2); m_reg = mn; }
  float mnC = -mn * C2;
  for (int r = 0; r < 16; ++r) p0[r] = fmaf(p0[r], C2, mnC); for (int r = 0; r < 16; ++r) p1[r] = fmaf(p1[r], C2, mnC);
  for (int r = 0; r < 16; ++r) p0[r] = __builtin_amdgcn_exp2f(p0[r]);
}
template <bool SHIFT>
__device__ __forceinline__ void partialSM_fixed(f32x16& p0, f32x16& p1, float m_reg, float& mn, float& alpha) {
  mn = m_reg; alpha = 1.f;
  if constexpr (SHIFT) { const float mnC = -m_reg * C2; for (int r = 0; r < 16; ++r) p0[r] += mnC; for (int r = 0; r < 16; ++r) p1[r] += mnC; }
  for (int r = 0; r < 16; ++r) p0[r] = __builtin_amdgcn_exp2f(p0[r]);
}
__device__ __forceinline__ void finishSM(f32x16& p0, f32x16& p1, float alpha, float& l_reg, bf16x8& pa0, bf16x8& pa1, bf16x8& pa2, bf16x8& pa3) {
  for (int r = 0; r < 16; ++r) p1[r] = __builtin_amdgcn_exp2f(p1[r]);
  float ps = 0; for (int r = 0; r < 16; ++r) ps += p0[r]; for (int r = 0; r < 16; ++r) ps += p1[r];
  { auto rr = __builtin_amdgcn_permlane32_swap(__float_as_uint(ps), __float_as_uint(ps), false, false);
    ps = __uint_as_float(rr[0]) + __uint_as_float(rr[1]); }
  l_reg = l_reg * alpha + ps;
#define PK4(P, BASE, OUT) do { unsigned a0 = cvtpk(P[BASE + 0], P[BASE + 1]), a1 = cvtpk(P[BASE + 2], P[BASE + 3]);   \
    unsigned b0 = cvtpk(P[BASE + 4], P[BASE + 5]), b1 = cvtpk(P[BASE + 6], P[BASE + 7]);                              \
    auto r0 = __builtin_amdgcn_permlane32_swap(a0, b0, false, false); auto r1 = __builtin_amdgcn_permlane32_swap(a1, b1, false, false); \
    u32x4 w = {r0[0], r1[0], r0[1], r1[1]}; OUT = *reinterpret_cast<bf16x8*>(&w); } while (0)
  PK4(p0, 0, pa0); PK4(p0, 8, pa1); PK4(p1, 0, pa2); PK4(p1, 8, pa3);
#undef PK4
}
__device__ __forceinline__ void qkt(f32x16& p0, f32x16& p1, const char* Ks, const bf16x8* qr, int r32, int hi) {
  p0 = f32x16{}; p1 = f32x16{};
  for (int d0 = 0; d0 < 8; ++d0) { int cb = (d0 * 16 + hi * 8) * 2;
    bf16x8 b0 = *reinterpret_cast<const bf16x8*>(Ks + KSWZ(r32, cb));
    bf16x8 b1 = *reinterpret_cast<const bf16x8*>(Ks + KSWZ(32 + r32, cb));
    p0 = __builtin_amdgcn_mfma_f32_32x32x16_bf16(b0, qr[d0], p0, 0, 0, 0);
    p1 = __builtin_amdgcn_mfma_f32_32x32x16_bf16(b1, qr[d0], p1, 0, 0, 0); }
}
__device__ __forceinline__ int v_st(int k, int c) { const int kk = (k & ~0xC) | ((k & 4) << 1) | ((k & 8) >> 1); return ((kk >> 3) * 4 + (c >> 5)) * 512 + ((kk & 7) * 32 + (c & 31)) * 2; }
__device__ __forceinline__ int v_rd_base(int lane) { return ((lane & 3) << 3) | (((lane >> 2) & 3) << 6) | (((lane >> 4) & 1) << 5) | (((lane >> 5) & 1) << 8); }
constexpr int v_rd_off(int d0, int ks, int half) { return d0 * 512 + ks * 4096 + half * 2048; }
template <int OFF> __device__ __forceinline__ s16x4 tr_read(int vb) { s16x4 r; asm volatile("ds_read_b64_tr_b16 %0, %1 offset:%2" : "=&v"(r) : "v"(vb), "i"(OFF) : "memory"); return r; }
template <int D0> __device__ __forceinline__ void pv_one(f32x16& od, int vb, bf16x8 pa0, bf16x8 pa1, bf16x8 pa2, bf16x8 pa3) {
  const s16x4 l0 = tr_read<v_rd_off(D0, 0, 0)>(vb), h0 = tr_read<v_rd_off(D0, 0, 1)>(vb), l1 = tr_read<v_rd_off(D0, 1, 0)>(vb), h1 = tr_read<v_rd_off(D0, 1, 1)>(vb);
  const s16x4 l2 = tr_read<v_rd_off(D0, 2, 0)>(vb), h2 = tr_read<v_rd_off(D0, 2, 1)>(vb), l3 = tr_read<v_rd_off(D0, 3, 0)>(vb), h3 = tr_read<v_rd_off(D0, 3, 1)>(vb);
  asm volatile("s_waitcnt lgkmcnt(0)" ::: "memory"); SBAR();
#define PK(L, H) (bf16x8){L[0], L[1], L[2], L[3], H[0], H[1], H[2], H[3]}
  od = __builtin_amdgcn_mfma_f32_32x32x16_bf16(pa0, PK(l0, h0), od, 0, 0, 0);
  od = __builtin_amdgcn_mfma_f32_32x32x16_bf16(pa1, PK(l1, h1), od, 0, 0, 0);
  od = __builtin_amdgcn_mfma_f32_32x32x16_bf16(pa2, PK(l2, h2), od, 0, 0, 0);
  od = __builtin_amdgcn_mfma_f32_32x32x16_bf16(pa3, PK(l3, h3), od, 0, 0, 0);
#undef PK
}
__device__ __forceinline__ void pv_d0(f32x16* o, int vb, bf16x8 pa0, bf16x8 pa1, bf16x8 pa2, bf16x8 pa3) {
  pv_one<0>(o[0], vb, pa0, pa1, pa2, pa3); pv_one<1>(o[1], vb, pa0, pa1, pa2, pa3); pv_one<2>(o[2], vb, pa0, pa1, pa2, pa3); pv_one<3>(o[3], vb, pa0, pa1, pa2, pa3);
}
struct UnitP { int q0, nt, kstart, nlat, r0, hq; float sinkl2, mfix; int j0; float* pmine; const float* pother; unsigned* cnt; };
template <int KIND> __device__ __forceinline__ int krow_of(const UnitP& u, int j) {
  if (KIND == 1) return 64 * (u.j0 + j);
  if (KIND == 3) return S + 64 * j;
  return j < u.nlat ? u.kstart + 64 * j : S + 64 * (j - u.nlat);
}
template <int KIND> __device__ __forceinline__ void apply_mask(f32x16& p0, f32x16& p1, const UnitP& u, int j, int wid, int r32, int hi, const float* rpbs) {
  if (KIND == 2) {
    if (j < u.nlat) {
      const int krow = u.kstart + 64 * j, tw = u.q0 + wid * 32;
      if (!(krow >= tw + 31 - 128 && krow + 63 <= tw + 128)) {
        const int t = tw + r32;
#pragma unroll
        for (int r = 0; r < 16; ++r) { const int d0 = krow + crow(r, hi) - t, d1 = d0 + 32;
          p0[r] = (d0 >= -128 && d0 <= 128) ? p0[r] : -INFINITY; p1[r] = (d1 >= -128 && d1 <= 128) ? p1[r] : -INFINITY; }
      }
    }
  } else if (KIND == 0) {
    if (j < u.nlat) {
      const int kr = u.kstart / 64 + j, qr = u.r0 + (wid >> 1), qc = (wid & 1) * 32 + r32;
      const int rsq = min(max(qr - 4, 0), 248), cs = min(max(qc - 8, 0), 48);
      const bool row_ok = (kr >= rsq) && (kr < rsq + 8);
      const int bidx = min(max(kr - qr + 7, 0), 14) * 31 + 15 - qc;
#pragma unroll
      for (int r = 0; r < 16; ++r) { const int kc0 = crow(r, hi);
        const bool ok0 = row_ok && kc0 >= cs && kc0 < cs + 16;
        const float b0 = rpbs[ok0 ? bidx + kc0 : 0];
        p0[r] = ok0 ? p0[r] + b0 : -INFINITY;
        if ((r & 3) == 3) asm volatile("" ::: "memory"); }
#pragma unroll
      for (int r = 0; r < 16; ++r) { const int kc1 = crow(r, hi) + 32;
        const bool ok1 = row_ok && kc1 >= cs && kc1 < cs + 16;
        const float b1 = rpbs[ok1 ? bidx + kc1 : 0];
        p1[r] = ok1 ? p1[r] + b1 : -INFINITY;
        if ((r & 3) == 3) asm volatile("" ::: "memory"); }
    }
  }
}
template <int KIND, int SDEPTH, bool PART = false, bool SHIFT = false>
__device__ __forceinline__ void attn_unit(const bf16_t* __restrict__ Qb, const bf16_t* __restrict__ Kh, const bf16_t* __restrict__ Vh, bf16_t* __restrict__ Ob, const UnitP u, char* lds, int tid) {
  const int wid = tid >> 6, lane = tid & 63, r32 = lane & 31, hi = lane >> 5;
  char* V_lds = lds; char* K_lds = lds + 2 * SHM_V;
  float* wsf = (float*)(lds + 2 * SHM_V + 2 * SHM_K) + wid * 64; float* li_l = wsf; float* al_l = wsf + 32;
  const float* rpbs = (const float*)(lds + RPB_OFF);
  float m_reg = (KIND == 1) ? u.mfix : -1e30f, l_reg = 0; f32x16 o[4] = {}; bf16x8 qr[8];
#define PSM(P0, P1, MN, AL) do { if constexpr (KIND == 1) partialSM_fixed<SHIFT>(P0, P1, m_reg, MN, AL); else partialSM(P0, P1, m_reg, MN, AL); } while (0)
#define QKT(P0, P1, KS) qkt(P0, P1, KS, qr, r32, hi)
  const bf16_t* Qw = Qb + (long)(wid * QBLK + r32) * LDQ + hi * 8;
#pragma unroll
  for (int d0 = 0; d0 < 8; ++d0) qr[d0] = *reinterpret_cast<const bf16x8*>(Qw + d0 * 16);
  const int sr = tid >> 4, sc = (tid & 15) * 8, vst0 = v_st(sr, sc), vst1 = v_st(32 + sr, sc);
  const int vb0 = (int)(uintptr_t)V_lds + v_rd_base(lane);
  struct { bf16x8 vs0, vs1, ks0, ks1; } sr_[SDEPTH];
  const unsigned goff0 = (unsigned)(sr * LDK + sc) * 2u, goff1 = goff0 + 32u * LDK * 2u;
  const char* Kc = (const char*)Kh; const char* Vc = (const char*)Vh;
#define SLOAD(i, jj) do { const unsigned tb_ = (unsigned)krow_of<KIND>(u, (jj)) * (unsigned)(LDK * 2); const char* kp_ = Kc + tb_; const char* vp_ = Vc + tb_; \
    sr_[i].vs0 = *reinterpret_cast<const bf16x8*>(vp_ + goff0); sr_[i].vs1 = *reinterpret_cast<const bf16x8*>(vp_ + goff1); \
    sr_[i].ks0 = *reinterpret_cast<const bf16x8*>(kp_ + goff0); sr_[i].ks1 = *reinterpret_cast<const bf16x8*>(kp_ + goff1); } while (0)
#define SWRITE(b, i) do { *(bf16x8*)(V_lds + (b) * SHM_V + vst0) = sr_[i].vs0; *(bf16x8*)(V_lds + (b) * SHM_V + vst1) = sr_[i].vs1; int kc = sc * 2;               \
    *(bf16x8*)(K_lds + (b) * SHM_K + KSWZ(sr, kc)) = sr_[i].ks0; *(bf16x8*)(K_lds + (b) * SHM_K + KSWZ(32 + sr, kc)) = sr_[i].ks1; } while (0)
#define SWAIT() do { if constexpr (SDEPTH == 2) asm volatile("s_waitcnt vmcnt(4)" ::: "memory"); else asm volatile("s_waitcnt vmcnt(0)" ::: "memory"); } while (0)
#define RESC(a) do { if (KIND != 1 && __any((a) < 1.f)) { if (hi == 0) al_l[r32] = (a); asm volatile("s_waitcnt lgkmcnt(0)" ::: "memory"); \
    for (int d = 0; d < 4; ++d) for (int r = 0; r < 16; ++r) o[d][r] *= al_l[crow(r, hi)]; } } while (0)
  f32x16 pA0, pA1, pB0, pB1; float mnA, mnB, alA, alB; bf16x8 pa0, pa1, pa2, pa3; const int NT = u.nt;
  constexpr int SE = 0, SO = SDEPTH - 1;
  SLOAD(SE, 0); asm volatile("s_waitcnt vmcnt(0)" ::: "memory"); SWRITE(0, SE); __syncthreads();
  QKT(pA0, pA1, K_lds); apply_mask<KIND>(pA0, pA1, u, 0, wid, r32, hi, rpbs); PSM(pA0, pA1, mnA, alA);
  SLOAD(SO, 1); if constexpr (SDEPTH == 2) { if (2 < NT) SLOAD(SE, 2); }
  SWAIT(); SWRITE(1, SO); __syncthreads();
  for (int j = 1; j + 1 < NT; j += 2) {
    SBAR(); QKT(pB0, pB1, K_lds + SHM_K); apply_mask<KIND>(pB0, pB1, u, j, wid, r32, hi, rpbs);
    finishSM(pA0, pA1, alA, l_reg, pa0, pa1, pa2, pa3); SBAR();
    SLOAD(SO, j + SDEPTH); SBAR();
    pv_d0(o, vb0, pa0, pa1, pa2, pa3); PSM(pB0, pB1, mnB, alB);
    __syncthreads(); SWAIT(); SWRITE(0, SE);
    RESC(alB); __syncthreads();
    SBAR(); QKT(pA0, pA1, K_lds); apply_mask<KIND>(pA0, pA1, u, j + 1, wid, r32, hi, rpbs);
    finishSM(pB0, pB1, alB, l_reg, pa0, pa1, pa2, pa3); SBAR();
    if (SDEPTH == 1 || j + 3 < NT) SLOAD(SE, j + 1 + SDEPTH); SBAR();
    pv_d0(o, vb0 + (int)SHM_V, pa0, pa1, pa2, pa3); PSM(pA0, pA1, mnA, alA);
    __syncthreads(); SWAIT(); SWRITE(1, SO);
    RESC(alA); __syncthreads();
  }
  SBAR(); QKT(pB0, pB1, K_lds + SHM_K); apply_mask<KIND>(pB0, pB1, u, NT - 1, wid, r32, hi, rpbs);
  finishSM(pA0, pA1, alA, l_reg, pa0, pa1, pa2, pa3); SBAR();
  pv_d0(o, vb0, pa0, pa1, pa2, pa3); PSM(pB0, pB1, mnB, alB);
  __syncthreads(); RESC(alB);
  finishSM(pB0, pB1, alB, l_reg, pa0, pa1, pa2, pa3); SBAR();
  pv_d0(o, vb0 + (int)SHM_V, pa0, pa1, pa2, pa3);
  if (KIND >= 2) l_reg += __builtin_amdgcn_exp2f(u.sinkl2 - m_reg * C2);
  if constexpr (PART) {
    unsigned* pm = (unsigned*)u.pmine + (size_t)wid * 64 * 65 + lane;
#pragma unroll
    for (int d = 0; d < 4; ++d)
#pragma unroll
      for (int r = 0; r < 16; ++r) __hip_atomic_store(pm + (d * 16 + r) * 64, __float_as_uint(o[d][r]), __ATOMIC_RELAXED, __HIP_MEMORY_SCOPE_AGENT);
    __hip_atomic_store(pm + 64 * 64, __float_as_uint(l_reg), __ATOMIC_RELAXED, __HIP_MEMORY_SCOPE_AGENT);
    asm volatile("s_waitcnt vmcnt(0)" ::: "memory");
    __syncthreads();
    unsigned* flag = (unsigned*)(lds + 2 * SHM_V + 2 * SHM_K + NW * 64 * 4);
    if (tid == 0) { const unsigned old = __hip_atomic_fetch_add(u.cnt, 1u, __ATOMIC_RELAXED, __HIP_MEMORY_SCOPE_AGENT); *flag = old; }
    __syncthreads();
    if (*flag == 0u) { __syncthreads(); return; }
    const unsigned* po = (const unsigned*)u.pother + (size_t)wid * 64 * 65 + lane;
#pragma unroll
    for (int d = 0; d < 4; ++d)
#pragma unroll
      for (int r = 0; r < 16; ++r) o[d][r] += __uint_as_float(__hip_atomic_load(po + (d * 16 + r) * 64, __ATOMIC_RELAXED, __HIP_MEMORY_SCOPE_AGENT));
    l_reg += __uint_as_float(__hip_atomic_load(po + 64 * 64, __ATOMIC_RELAXED, __HIP_MEMORY_SCOPE_AGENT));
  }
  if (hi == 0) li_l[r32] = l_reg; asm volatile("s_waitcnt lgkmcnt(0)" ::: "memory");
  float rli[16];
#pragma unroll
  for (int r = 0; r < 16; ++r) rli[r] = __builtin_amdgcn_rcpf(li_l[crow(r, hi)]);
  bf16_t* Ow = Ob + (long)(wid * QBLK) * LDO;
#pragma unroll
  for (int r = 0; r < 16; ++r) { const int orow = crow(r, hi);
#pragma unroll
    for (int d0 = 0; d0 < 4; ++d0) Ow[(long)orow * LDO + d0 * 32 + r32] = f2bf(o[d0][r] * rli[r]); }
  __syncthreads();
#undef PSM
#undef SLOAD
#undef SWRITE
#undef SWAIT
#undef RESC
}
#undef KSWZ
#undef SBAR

__device__ __forceinline__ void attn_phase(const bf16_t* __restrict__ QKV, bf16_t* __restrict__ O, const float* __restrict__ rpb, const float* __restrict__ sink, const float* __restrict__ qn, const float* __restrict__ kn, float* __restrict__ pbuf, unsigned* __restrict__ pcnt, bool do_ctx, char* lds, int wave_s) {
  const int G = grid_x(), c = blockIdx.x;
  const bool bal = (G == 256);
  float mfix;
  { unsigned zz_ = 0u; asm volatile("" : "+v"(zz_)); const int lane_ = (int)__builtin_amdgcn_mbcnt_hi(~0u, __builtin_amdgcn_mbcnt_lo(~0u, zz_)); const float gq = wmax(fmaxf(fabsf(qn[lane_]), fabsf(qn[lane_ + 64]))), gk = wmax(fmaxf(fabsf(kn[lane_]), fabsf(kn[lane_ + 64]))); mfix = __builtin_bit_cast(float, __builtin_amdgcn_readfirstlane(__builtin_bit_cast(int, 128.f * gq * gk * 1.03f))); }
  for (int p = c; p < ((bal && MK_PARTSPLIT) ? 256 : 384); p += G) {
    unsigned z_ = 0u; asm volatile("" : "+v"(z_)); int tid = wave_s * 64 + (int)__builtin_amdgcn_mbcnt_hi(~0u, __builtin_amdgcn_mbcnt_lo(~0u, z_)); asm volatile("" : "+v"(tid));
    UnitP u; u.sinkl2 = -INFINITY; u.r0 = 0; u.kstart = 0; u.nlat = 0; u.hq = 0; u.j0 = 0; u.pmine = nullptr; u.pother = nullptr; u.cnt = nullptr; const int qb = p / 6, h = p % 6;
    u.q0 = qb * 256; u.nt = MT / 64; u.mfix = mfix;
    if (__builtin_amdgcn_readfirstlane((int)(mfix * C2 <= 64.f))) attn_unit<1, 2, false, false>(QKV + (size_t)u.q0 * NQKV + QB + h * 128, QKV + KB + (h / 3) * 128, QKV + VB + (h / 3) * 128, O + (size_t)u.q0 * D + 768 + h * 128, u, lds, tid);
    else attn_unit<1, 1, false, true>(QKV + (size_t)u.q0 * NQKV + QB + h * 128, QKV + KB + (h / 3) * 128, QKV + VB + (h / 3) * 128, O + (size_t)u.q0 * D + 768 + h * 128, u, lds, tid);
  }
  if (bal && MK_PARTSPLIT) {
    unsigned z_ = 0u; asm volatile("" : "+v"(z_)); int tid = wave_s * 64 + (int)__builtin_amdgcn_mbcnt_hi(~0u, __builtin_amdgcn_mbcnt_lo(~0u, z_)); asm volatile("" : "+v"(tid));
    constexpr int KSPLIT = 186;
    const int ub = c & 127, half = c >> 7, p = 256 + ub, qb = p / 6, h = p % 6;
    UnitP u; u.sinkl2 = -INFINITY; u.r0 = 0; u.kstart = 0; u.nlat = 0; u.hq = 0; u.q0 = qb * 256; u.mfix = mfix;
    u.j0 = half ? KSPLIT : 0; u.nt = half ? MT / 64 - KSPLIT : KSPLIT;
    u.pmine = pbuf + (size_t)(ub * 2 + half) * (8 * 64 * 65); u.pother = pbuf + (size_t)(ub * 2 + (half ^ 1)) * (8 * 64 * 65); u.cnt = pcnt + 64 * ub;
    attn_unit<1, 2, true, true>(QKV + (size_t)u.q0 * NQKV + QB + h * 128, QKV + KB + (h / 3) * 128, QKV + VB + (h / 3) * 128, O + (size_t)u.q0 * D + 768 + h * 128, u, lds, tid);
  }
  const int c2 = bal ? c - 128 : c, G2 = bal ? 128 : G;
  if (c2 >= 0) {
    for (int p = c2; p < 384; p += G2) {
      unsigned z_ = 0u; asm volatile("" : "+v"(z_)); int tid = wave_s * 64 + (int)__builtin_amdgcn_mbcnt_hi(~0u, __builtin_amdgcn_mbcnt_lo(~0u, z_)); asm volatile("" : "+v"(tid));
      UnitP u; u.sinkl2 = -INFINITY; u.hq = 0; u.mfix = 0.f; u.j0 = 0; u.pmine = nullptr; u.pother = nullptr; u.cnt = nullptr; const int qb = p / 6, h = p % 6;
      u.q0 = qb * 256; u.r0 = qb * 4; const int rstart = min(max(u.r0 - 4, 0), 244); u.kstart = rstart * 64; u.nlat = 12; u.nt = 16;
      { float* rp = (float*)(lds + RPB_OFF); for (int t = tid; t < 465; t += 512) rp[t] = rpb[h * 465 + t] * (1.f / SCALE); }
      __syncthreads();
      attn_unit<0, 1>(QKV + (size_t)u.q0 * NQKV + QA + h * 128, QKV + KA + h * 128, QKV + VA + h * 128, O + (size_t)u.q0 * D + h * 128, u, lds, tid);
    }
    for (int p = c2; p < 256; p += G2) {
      unsigned z_ = 0u; asm volatile("" : "+v"(z_)); int tid = wave_s * 64 + (int)__builtin_amdgcn_mbcnt_hi(~0u, __builtin_amdgcn_mbcnt_lo(~0u, z_)); asm volatile("" : "+v"(tid));
      UnitP u; u.r0 = 0; u.hq = 0; u.mfix = 0.f; u.j0 = 0; u.pmine = nullptr; u.pother = nullptr; u.cnt = nullptr; const int qb = p / 4, h = p % 4;
      u.q0 = qb * 256; u.kstart = max(u.q0 - 128, 0); const int kend = min(u.q0 + 384, S); u.nlat = (kend - u.kstart) / 64; u.nt = u.nlat + 4; u.sinkl2 = sink[h] * 1.4426950408889634f;
      attn_unit<2, 1>(QKV + (size_t)u.q0 * NQKV + QC + h * 128, QKV + KC + (h / 2) * 128, QKV + VC + (h / 2) * 128, O + (size_t)u.q0 * D + 1536 + h * 128, u, lds, tid);
    }
    if (do_ctx) for (int p = c2; p < 16; p += G2) {
      unsigned z_ = 0u; asm volatile("" : "+v"(z_)); int tid = wave_s * 64 + (int)__builtin_amdgcn_mbcnt_hi(~0u, __builtin_amdgcn_mbcnt_lo(~0u, z_)); asm volatile("" : "+v"(tid));
      UnitP u; u.sinkl2 = -INFINITY; u.r0 = 0; u.kstart = 0; u.nlat = 0; u.hq = 0; u.mfix = 0.f; u.j0 = 0; u.pmine = nullptr; u.pother = nullptr; u.cnt = nullptr; u.q0 = S; u.nt = 4;
      int qcol, kcol, vcol, ocol;
      if (p < 6) { qcol = QA + p * 128; kcol = KA + p * 128; vcol = VA + p * 128; ocol = p * 128; }
      else if (p < 12) { const int hh = p - 6; qcol = QB + hh * 128; kcol = KB + (hh / 3) * 128; vcol = VB + (hh / 3) * 128; ocol = 768 + hh * 128; }
      else { const int hh = p - 12; qcol = QC + hh * 128; kcol = KC + (hh / 2) * 128; vcol = VC + (hh / 2) * 128; ocol = 1536 + hh * 128; u.sinkl2 = sink[hh] * 1.4426950408889634f; }
      attn_unit<3, 1>(QKV + (size_t)S * NQKV + qcol, QKV + kcol, QKV + vcol, O + (size_t)S * D + ocol, u, lds, tid);
    }
  }
}
}
__device__ __forceinline__ void peer_select_phase(const bf16_t* __restrict__ QS, const float* __restrict__ keys, int* __restrict__ IDX, float* __restrict__ GWT, int rows, char* lds, int tid) {
    const int wave = tid >> 6, lane = tid & 63;
    float* sq = (float*)lds + wave * 256; float* ss = (float*)(lds + 8192) + wave * 32; int* si = (int*)(lds + 8192 + 1024) + wave * 32;
    for (int item = blockIdx.x * 8 + wave; item < rows * 8; item += grid_x() * 8) {
        const int token = item >> 3, h = item & 7;
        { const bf16_t* qp = QS + (size_t)token * (2 * D) + h * 256 + lane * 4; const uint2 hi = *(const uint2*)qp, lo = *(const uint2*)(qp + D);
          *(float4*)(sq + lane * 4) = make_float4(bf2f(hi.x) + bf2f(lo.x), bf2f(hi.x >> 16) + bf2f(lo.x >> 16), bf2f(hi.y) + bf2f(lo.y), bf2f(hi.y >> 16) + bf2f(lo.y >> 16)); }
        WAVE_LDS_SYNC();
        float sc[2][2];
#pragma unroll
        for (int p = 0; p < 2; ++p)
#pragma unroll
            for (int r = 0; r < 2; ++r) {
                const float4* kp = (const float4*)(keys + ((size_t)((h * 2 + p) * 128 + lane + 64 * r)) * 128);
                float acc = 0.f;
#pragma unroll 8
                for (int d4 = 0; d4 < 32; ++d4) { const float4 kv = kp[d4]; const float4 q = *(const float4*)(sq + p * 128 + d4 * 4); acc += q.x * kv.x + q.y * kv.y + q.z * kv.z + q.w * kv.w; }
                sc[p][r] = acc;
            }
#pragma unroll
        for (int p = 0; p < 2; ++p) {
            float v0 = sc[p][0], v1 = sc[p][1];
            for (int k = 0; k < 16; ++k) {
                float bv; int bi; if (v0 >= v1) { bv = v0; bi = lane; } else { bv = v1; bi = lane + 64; }
                wave_argmax(bv, bi);
                if (lane == 0) { ss[p * 16 + k] = bv; si[p * 16 + k] = bi; }
                if (bi == lane) v0 = -INFINITY; else if (bi == lane + 64) v1 = -INFINITY;
            }
        }
        WAVE_LDS_SYNC();
        float cv[4];
#pragma unroll
        for (int r = 0; r < 4; ++r) { const int ci = lane + 64 * r; cv[r] = ss[ci >> 4] + ss[16 + (ci & 15)]; }
        float my_s = 0.f; int my_i = 0;
        for (int k = 0; k < 16; ++k) {
            float bv = cv[0]; int bi = lane;
#pragma unroll
            for (int r = 1; r < 4; ++r) if (cv[r] > bv) { bv = cv[r]; bi = lane + 64 * r; }
            wave_argmax(bv, bi);
            if (lane == k) { my_s = bv; my_i = bi; }
#pragma unroll
            for (int r = 0; r < 4; ++r) if (bi == lane + 64 * r) cv[r] = -INFINITY;
        }
        const float mx = __shfl(my_s, 0);
        const float e = lane < 16 ? __expf(my_s - mx) : 0.f;
        const float sum = wsum(e);
        if (lane < 16) { IDX[(size_t)token * 128 + h * 16 + lane] = si[my_i >> 4] * 128 + si[16 + (my_i & 15)]; GWT[(size_t)token * 128 + h * 16 + lane] = e / sum; }
        WAVE_LDS_SYNC();
    }
}
__device__ __forceinline__ float gelu_fast(float x) {
    const float u2 = 1.5957691216057308f * (x + 0.044715f * x * x * x);
    return x * (1.f - __builtin_amdgcn_rcpf(1.f + __builtin_amdgcn_exp2f(fminf(1.4426950408889634f * u2, 126.f))));
}
__device__ __forceinline__ void unpack8(const uint4 w, float (&f)[8]) {
    f[0] = __uint_as_float(w.x << 16); f[1] = __uint_as_float(w.x & 0xffff0000u); f[2] = __uint_as_float(w.y << 16); f[3] = __uint_as_float(w.y & 0xffff0000u);
    f[4] = __uint_as_float(w.z << 16); f[5] = __uint_as_float(w.z & 0xffff0000u); f[6] = __uint_as_float(w.w << 16); f[7] = __uint_as_float(w.w & 0xffff0000u);
}
template <bool LAST>
__device__ __forceinline__ void peer_expert_phase(const bf16_t* __restrict__ HS, const int* __restrict__ IDX, const float* __restrict__ GWT, const bf16_t* __restrict__ UB, const bf16_t* __restrict__ VB,
                                                  const float* __restrict__ MODl, float* __restrict__ X, const float* __restrict__ gnext, const float* __restrict__ MODn, bf16_t* __restrict__ Hn,
                                                  float* __restrict__ out, int rows, int tid) {
    const int wave = tid >> 6, lane = tid & 63;
    for (int row = blockIdx.x * 8 + wave; row < rows; row += grid_x() * 8) {
        float h[4][8], acc[4][8];
#pragma unroll
        for (int i = 0; i < 4; ++i) { const bf16_t* hp = HS + (size_t)row * (2 * D) + 8 * lane + 512 * i; float a[8], b[8]; unpack8(*(const uint4*)hp, a); unpack8(*(const uint4*)(hp + D), b);
#pragma unroll
            for (int j = 0; j < 8; ++j) { h[i][j] = a[j] + b[j]; acc[i][j] = 0.f; } }
        const int idx_lo = IDX[(size_t)row * 128 + lane], idx_hi = IDX[(size_t)row * 128 + 64 + lane];
        const float gw_lo = GWT[(size_t)row * 128 + lane], gw_hi = GWT[(size_t)row * 128 + 64 + lane];
        for (int j0 = 0; j0 < 128; j0 += 4) {
            int e[4]; float w[4], d[4];
#pragma unroll
            for (int k = 0; k < 4; ++k) { const int j = j0 + k;
                e[k] = j0 < 64 ? __builtin_amdgcn_readlane(idx_lo, j & 63) : __builtin_amdgcn_readlane(idx_hi, j & 63);
                w[k] = __uint_as_float(j0 < 64 ? __builtin_amdgcn_readlane(__float_as_uint(gw_lo), j & 63) : __builtin_amdgcn_readlane(__float_as_uint(gw_hi), j & 63)); }
            uint4 ur[4][4];
#pragma unroll
            for (int k = 0; k < 4; ++k) { const uint4* up = (const uint4*)(UB + (size_t)e[k] * D) + lane;
#pragma unroll
                for (int i = 0; i < 4; ++i) ur[k][i] = up[64 * i]; }
#pragma unroll
            for (int k = 0; k < 4; ++k) { float s = 0.f;
#pragma unroll
                for (int i = 0; i < 4; ++i) { float f[8]; unpack8(ur[k][i], f);
#pragma unroll
                    for (int j = 0; j < 8; ++j) s += h[i][j] * f[j]; }
                d[k] = s; }
            asm volatile("" : "+v"(d[0]), "+v"(d[1]), "+v"(d[2]), "+v"(d[3]) :: "memory");
            uint4 vr[4][4];
#pragma unroll
            for (int k = 0; k < 4; ++k) { const uint4* vp = (const uint4*)(VB + (size_t)e[k] * D) + lane;
#pragma unroll
                for (int i = 0; i < 4; ++i) vr[k][i] = vp[64 * i]; }
#pragma unroll
            for (int k = 0; k < 4; ++k) d[k] = wsum(d[k]);
#pragma unroll
            for (int k = 0; k < 4; ++k) { const float a = gelu_fast(d[k]) * w[k];
#pragma unroll
                for (int i = 0; i < 4; ++i) { float f[8]; unpack8(vr[k][i], f);
#pragma unroll
                    for (int j = 0; j < 8; ++j) acc[i][j] += a * f[j]; } }
        }
        const float* md = MODl + (row < S ? 0 : NMOD) + 5 * D;
        float xn[4][8]; float ss = 0.f;
#pragma unroll
        for (int i = 0; i < 4; ++i) { const int col = 8 * lane + 512 * i; const float4 g0 = *(const float4*)(md + col), g1 = *(const float4*)(md + col + 4);
            const float4 x0 = *(const float4*)(X + (size_t)row * D + col), x1 = *(const float4*)(X + (size_t)row * D + col + 4);
            xn[i][0] = x0.x + g0.x * acc[i][0]; xn[i][1] = x0.y + g0.y * acc[i][1]; xn[i][2] = x0.z + g0.z * acc[i][2]; xn[i][3] = x0.w + g0.w * acc[i][3];
            xn[i][4] = x1.x + g1.x * acc[i][4]; xn[i][5] = x1.y + g1.y * acc[i][5]; xn[i][6] = x1.z + g1.z * acc[i][6]; xn[i][7] = x1.w + g1.w * acc[i][7];
#pragma unroll
            for (int j = 0; j < 8; ++j) ss += xn[i][j] * xn[i][j];
            if (!LAST) { *(float4*)(X + (size_t)row * D + col) = make_float4(xn[i][0], xn[i][1], xn[i][2], xn[i][3]); *(float4*)(X + (size_t)row * D + col + 4) = make_float4(xn[i][4], xn[i][5], xn[i][6], xn[i][7]); } }
        ss = wsum(ss);
        const float rs = rsqrtf(ss * (1.f / D) + EPS);
        if (LAST) {
#pragma unroll
            for (int i = 0; i < 4; ++i) { const int col = 8 * lane + 512 * i; const float4 g0 = *(const float4*)(gnext + col), g1 = *(const float4*)(gnext + col + 4);
                *(float4*)(out + (size_t)row * D + col) = make_float4(xn[i][0] * rs * g0.x, xn[i][1] * rs * g0.y, xn[i][2] * rs * g0.z, xn[i][3] * rs * g0.w);
                *(float4*)(out + (size_t)row * D + col + 4) = make_float4(xn[i][4] * rs * g1.x, xn[i][5] * rs * g1.y, xn[i][6] * rs * g1.z, xn[i][7] * rs * g1.w); }
        } else {
            const float* mn = MODn + (row < S ? 0 : NMOD);
#pragma unroll
            for (int i = 0; i < 4; ++i) { const int col = 8 * lane + 512 * i; float o[8];
#pragma unroll
                for (int j4 = 0; j4 < 2; ++j4) { const float4 g = *(const float4*)(gnext + col + 4 * j4), sh = *(const float4*)(mn + col + 4 * j4), sc = *(const float4*)(mn + D + col + 4 * j4);
                    o[4 * j4 + 0] = xn[i][4 * j4 + 0] * rs * g.x * (1.f + sc.x) + sh.x; o[4 * j4 + 1] = xn[i][4 * j4 + 1] * rs * g.y * (1.f + sc.y) + sh.y;
                    o[4 * j4 + 2] = xn[i][4 * j4 + 2] * rs * g.z * (1.f + sc.z) + sh.z; o[4 * j4 + 3] = xn[i][4 * j4 + 3] * rs * g.w * (1.f + sc.w) + sh.w; }
                uint4 p; p.x = pk2(o[0], o[1]); p.y = pk2(o[2], o[3]); p.z = pk2(o[4], o[5]); p.w = pk2(o[6], o[7]); *(uint4*)(Hn + (size_t)row * D + col) = p; }
        }
    }
}
__device__ __forceinline__ void quant_rows_phase(const float* __restrict__ src, unsigned char* __restrict__ dst, float* __restrict__ scl, int nrows, int c2, int G2, int tid) {
    const int wave = tid >> 6, lane = tid & 63;
    for (int row = c2 * 8 + wave; row < nrows; row += G2 * 8) {
        const float4* sp = (const float4*)(src + (size_t)row * D) + lane;
        float4 v[8]; float mx = 0.f;
#pragma unroll
        for (int i = 0; i < 8; ++i) { v[i] = sp[64 * i]; mx = fmaxf(mx, fmaxf(fmaxf(fabsf(v[i].x), fabsf(v[i].y)), fmaxf(fabsf(v[i].z), fabsf(v[i].w)))); }
        mx = wmax(mx);
        const float s = mx > 0.f ? mx * (1.f / 127.f) : 1.f, inv = 1.f / s;
#pragma unroll
        for (int i = 0; i < 8; ++i) {
            const unsigned b0 = (unsigned)(__float2int_rn(v[i].x * inv) + 128), b1 = (unsigned)(__float2int_rn(v[i].y * inv) + 128), b2 = (unsigned)(__float2int_rn(v[i].z * inv) + 128), b3 = (unsigned)(__float2int_rn(v[i].w * inv) + 128);
            *(unsigned*)(dst + (size_t)row * D + 4 * lane + 256 * i) = (b0 & 255u) | ((b1 & 255u) << 8) | ((b2 & 255u) << 16) | ((b3 & 255u) << 24);
        }
        if (lane == 0) scl[row] = s;
    }
}
__device__ __forceinline__ void ub16(const uint4 w, float (&f)[16]) {
    f[0] = (float)(w.x & 0xffu); f[1] = (float)((w.x >> 8) & 0xffu); f[2] = (float)((w.x >> 16) & 0xffu); f[3] = (float)(w.x >> 24);
    f[4] = (float)(w.y & 0xffu); f[5] = (float)((w.y >> 8) & 0xffu); f[6] = (float)((w.y >> 16) & 0xffu); f[7] = (float)(w.y >> 24);
    f[8] = (float)(w.z & 0xffu); f[9] = (float)((w.z >> 8) & 0xffu); f[10] = (float)((w.z >> 16) & 0xffu); f[11] = (float)(w.z >> 24);
    f[12] = (float)(w.w & 0xffu); f[13] = (float)((w.w >> 8) & 0xffu); f[14] = (float)((w.w >> 16) & 0xffu); f[15] = (float)(w.w >> 24);
}
template <bool LAST>
__device__ __forceinline__ void peer_expert_q8_phase(const bf16_t* __restrict__ HS, const int* __restrict__ IDX, const float* __restrict__ GWT, const unsigned char* __restrict__ UQ, const unsigned char* __restrict__ VQ,
                                                     const float* __restrict__ SU, const float* __restrict__ SV, const float* __restrict__ MODl, float* __restrict__ X, const float* __restrict__ gnext,
                                                     const float* __restrict__ MODn, bf16_t* __restrict__ Hn, float* __restrict__ out, int rows, int tid) {
    const int wave = tid >> 6, lane = tid & 63;
    for (int row = blockIdx.x * 8 + wave; row < rows; row += grid_x() * 8) {
        float h[2][16], acc[2][16]; float hs = 0.f, accb = 0.f;
#pragma unroll
        for (int i = 0; i < 2; ++i) { const bf16_t* hp = HS + (size_t)row * (2 * D) + 16 * lane + 1024 * i;
#pragma unroll
            for (int c = 0; c < 2; ++c) { float a[8], b[8]; unpack8(*(const uint4*)(hp + 8 * c), a); unpack8(*(const uint4*)(hp + D + 8 * c), b);
#pragma unroll
                for (int j = 0; j < 8; ++j) { h[i][8 * c + j] = a[j] + b[j]; hs += a[j] + b[j]; acc[i][8 * c + j] = 0.f; } } }
        hs = wsum(hs) * 128.f;
        const int idx_lo = IDX[(size_t)row * 128 + lane], idx_hi = IDX[(size_t)row * 128 + 64 + lane];
        const float gw_lo = GWT[(size_t)row * 128 + lane], gw_hi = GWT[(size_t)row * 128 + 64 + lane];
        for (int j0 = 0; j0 < 128; j0 += 8) {
            int e[8]; float w[8], d[8];
#pragma unroll
            for (int k = 0; k < 8; ++k) { const int j = j0 + k;
                e[k] = j0 < 64 ? __builtin_amdgcn_readlane(idx_lo, j & 63) : __builtin_amdgcn_readlane(idx_hi, j & 63);
                w[k] = __uint_as_float(j0 < 64 ? __builtin_amdgcn_readlane(__float_as_uint(gw_lo), j & 63) : __builtin_amdgcn_readlane(__float_as_uint(gw_hi), j & 63)); }
            uint4 ur[8][2];
#pragma unroll
            for (int k = 0; k < 8; ++k) { const uint4* up = (const uint4*)(UQ + (size_t)e[k] * D) + lane; ur[k][0] = up[0]; ur[k][1] = up[64]; }
#pragma unroll
            for (int k = 0; k < 8; ++k) { float s = 0.f;
#pragma unroll
                for (int i = 0; i < 2; ++i) { float f[16]; ub16(ur[k][i], f);
#pragma unroll
                    for (int j = 0; j < 16; ++j) s += h[i][j] * f[j]; }
                d[k] = s; }
            asm volatile("" : "+v"(d[0]), "+v"(d[1]), "+v"(d[2]), "+v"(d[3]), "+v"(d[4]), "+v"(d[5]), "+v"(d[6]), "+v"(d[7]) :: "memory");
            uint4 vr[8][2];
#pragma unroll
            for (int k = 0; k < 8; ++k) { const uint4* vp = (const uint4*)(VQ + (size_t)e[k] * D) + lane; vr[k][0] = vp[0]; vr[k][1] = vp[64]; }
#pragma unroll
            for (int k = 0; k < 8; ++k) d[k] = wsum(d[k]);
#pragma unroll
            for (int k = 0; k < 8; ++k) { const float dd = (d[k] - hs) * SU[e[k]]; const float c = gelu_fast(dd) * w[k] * SV[e[k]]; accb += 128.f * c;
#pragma unroll
                for (int i = 0; i < 2; ++i) { float f[16]; ub16(vr[k][i], f);
#pragma unroll
                    for (int j = 0; j < 16; ++j) acc[i][j] += c * f[j]; } }
        }
        const float* md = MODl + (row < S ? 0 : NMOD) + 5 * D;
        float ss = 0.f;
#pragma unroll
        for (int i = 0; i < 2; ++i)
#pragma unroll
            for (int c4 = 0; c4 < 4; ++c4) { const int col = 16 * lane + 1024 * i + 4 * c4; const float4 g = *(const float4*)(md + col); const float4 x0 = *(const float4*)(X + (size_t)row * D + col);
                float* a = &acc[i][4 * c4];
                a[0] = x0.x + g.x * (a[0] - accb); a[1] = x0.y + g.y * (a[1] - accb); a[2] = x0.z + g.z * (a[2] - accb); a[3] = x0.w + g.w * (a[3] - accb);
                ss += a[0] * a[0] + a[1] * a[1] + a[2] * a[2] + a[3] * a[3];
                if (!LAST) *(float4*)(X + (size_t)row * D + col) = make_float4(a[0], a[1], a[2], a[3]); }
        ss = wsum(ss);
        const float rs = rsqrtf(ss * (1.f / D) + EPS);
        if (LAST) {
#pragma unroll
            for (int i = 0; i < 2; ++i)
#pragma unroll
                for (int c4 = 0; c4 < 4; ++c4) { const int col = 16 * lane + 1024 * i + 4 * c4; const float4 g = *(const float4*)(gnext + col); const float* a = &acc[i][4 * c4];
                    *(float4*)(out + (size_t)row * D + col) = make_float4(a[0] * rs * g.x, a[1] * rs * g.y, a[2] * rs * g.z, a[3] * rs * g.w); }
        } else {
            const float* mn = MODn + (row < S ? 0 : NMOD);
#pragma unroll
            for (int i = 0; i < 2; ++i)
#pragma unroll
                for (int c8 = 0; c8 < 2; ++c8) { const int col = 16 * lane + 1024 * i + 8 * c8; float o[8];
#pragma unroll
                    for (int j4 = 0; j4 < 2; ++j4) { const float4 g = *(const float4*)(gnext + col + 4 * j4), sh = *(const float4*)(mn + col + 4 * j4), sc = *(const float4*)(mn + D + col + 4 * j4); const float* a = &acc[i][8 * c8 + 4 * j4];
                        o[4 * j4 + 0] = a[0] * rs * g.x * (1.f + sc.x) + sh.x; o[4 * j4 + 1] = a[1] * rs * g.y * (1.f + sc.y) + sh.y; o[4 * j4 + 2] = a[2] * rs * g.z * (1.f + sc.z) + sh.z; o[4 * j4 + 3] = a[3] * rs * g.w * (1.f + sc.w) + sh.w; }
                    uint4 p; p.x = pk2(o[0], o[1]); p.y = pk2(o[2], o[3]); p.z = pk2(o[4], o[5]); p.w = pk2(o[6], o[7]); *(uint4*)(Hn + (size_t)row * D + col) = p; }
        }
    }
}
#define XB_TMO      128
#define XB_XCNT(j)  (256  + 64 * (j))
#define XB_XSUB(j)  (1280 + 64 * (j))
#define XB_XGEN(j)  (2304 + 64 * (j))
#define XB_TOP      3328
#define XB_TOPGEN   3392
#define XCD_BAR_WORDS 3456
#define XB_SPIN_CAP (1u << 22)
#define LAS __attribute__((address_space(3)))
__device__ __forceinline__ unsigned xb_ld(unsigned* p)              { return __hip_atomic_load(p, __ATOMIC_RELAXED, __HIP_MEMORY_SCOPE_AGENT); }
__device__ __forceinline__ unsigned xb_add(unsigned* p, unsigned v) { return __hip_atomic_fetch_add(p, v, __ATOMIC_RELAXED, __HIP_MEMORY_SCOPE_AGENT); }
__device__ __forceinline__ unsigned xb_xcc_id() { return (unsigned)__builtin_amdgcn_s_getreg((3 << 11) | 20) & 0xFu; }
#define XB_SPIN(cond, bar) do { unsigned _sp = 0; while (cond) { __builtin_amdgcn_s_sleep(1); \
    if ((++_sp & 255u) == 0u) { if (xb_ld(&(bar)[XB_TMO])) break; if (_sp > XB_SPIN_CAP) { atomicAdd(&(bar)[XB_TMO], 1u); break; } } } } while (0)
struct XcdBarrier { unsigned* bar; unsigned x; volatile LAS unsigned* st; };
__device__ __forceinline__ XcdBarrier xcd_barrier_post(unsigned* bar, volatile LAS unsigned* st) {
    XcdBarrier b; b.bar = bar; b.x = xb_xcc_id(); b.st = st;
    if (threadIdx.x == 0) (void)xb_add(&bar[XB_XCNT(b.x)], 1u);
    return b;
}
__device__ __forceinline__ void xcd_barrier_complete(unsigned* bar, unsigned x, unsigned& nloc, unsigned& nx) {
    const unsigned G = (unsigned)grid_x();
    unsigned sum, cnt, mine, sp = 0u;
    for (;;) {
        sum = 0u; cnt = 0u; mine = 0u;
#pragma unroll
        for (unsigned j = 0; j < 16; ++j) { const unsigned c = xb_ld(&bar[XB_XCNT(j)]); sum += c; cnt += (c > 0u) ? 1u : 0u; mine = (j == x) ? c : mine; }
        if (sum == G) break;
        __builtin_amdgcn_s_sleep(1);
        if ((++sp & 255u) == 0u) { if (xb_ld(&bar[XB_TMO])) break; if (sp > XB_SPIN_CAP) { atomicAdd(&bar[XB_TMO], 1u); break; } }
    }
    nloc = mine > 0u ? mine : 1u; nx = cnt > 0u ? cnt : 1u;
}
__device__ __forceinline__ void xcd_barrier(const XcdBarrier& b) {
    asm volatile("s_waitcnt vmcnt(0)" ::: "memory");
    __syncthreads();
    if (threadIdx.x == 0) {
        unsigned* bar = b.bar; unsigned bx = b.x; asm volatile("" : "+s"(bar), "+s"(bx));
        __builtin_amdgcn_s_waitcnt(0);
        unsigned nloc = b.st[0], nx = b.st[1];
        if (nloc == 0u) { xcd_barrier_complete(bar, bx, nloc, nx); b.st[0] = nloc; b.st[1] = nx; }
        const unsigned old = xb_add(&bar[XB_XSUB(bx)], 1u);
        const unsigned gen = old / nloc;
        if (old + 1u == (gen + 1u) * nloc) {
            __builtin_amdgcn_fence(__ATOMIC_RELEASE, "agent");
            asm volatile("s_waitcnt vmcnt(0)" ::: "memory");
            const unsigned og = xb_add(&bar[XB_TOP], 1u);
            const unsigned tg = og / nx;
            if (og + 1u == (tg + 1u) * nx) xb_add(&bar[XB_TOPGEN], 1u);
            else XB_SPIN(xb_ld(&bar[XB_TOPGEN]) == tg, bar);
            __builtin_amdgcn_fence(__ATOMIC_ACQUIRE, "agent");
            xb_add(&bar[XB_XGEN(bx)], 1u);
            asm volatile("s_waitcnt vmcnt(0)" ::: "memory");
        } else {
            XB_SPIN(xb_ld(&bar[XB_XGEN(bx)]) == gen, bar);
            __builtin_amdgcn_fence(__ATOMIC_ACQUIRE, "agent");
            asm volatile("s_waitcnt vmcnt(0)" ::: "memory");
        }
    }
    __syncthreads();
}

template <bool SIGNED>
__device__ __forceinline__ void quant_rows_sliced_phase(const float* __restrict__ src, unsigned char* __restrict__ dst, float* __restrict__ scl, int nrows, int c2, int G2, int tid) {
    const int wave = tid >> 6, lane = tid & 63;
    for (int row = c2 * 8 + wave; row < nrows; row += G2 * 8) {
        const float4* sp = (const float4*)(src + (size_t)row * D) + lane;
        float4 v[8]; float mx = 0.f;
#pragma unroll
        for (int i = 0; i < 8; ++i) { v[i] = sp[64 * i]; mx = fmaxf(mx, fmaxf(fmaxf(fabsf(v[i].x), fabsf(v[i].y)), fmaxf(fabsf(v[i].z), fabsf(v[i].w)))); }
        mx = wmax(mx);
        const float s = mx > 0.f ? mx * (1.f / 127.f) : 1.f, inv = 1.f / s;
#pragma unroll
        for (int i = 0; i < 8; ++i) {
            constexpr int OFS = SIGNED ? 0 : 128; const unsigned b0 = (unsigned)(__float2int_rn(v[i].x * inv) + OFS), b1 = (unsigned)(__float2int_rn(v[i].y * inv) + OFS), b2 = (unsigned)(__float2int_rn(v[i].z * inv) + OFS), b3 = (unsigned)(__float2int_rn(v[i].w * inv) + OFS);
            const int slice = 2 * i + (lane >> 5), cin = (4 * lane) & 127;
            *(unsigned*)(dst + ((size_t)slice * 16384 + row) * 128 + cin) = (b0 & 255u) | ((b1 & 255u) << 8) | ((b2 & 255u) << 16) | ((b3 & 255u) << 24);
        }
        if (lane == 0) scl[row] = s;
    }
}
struct SliceDeal { int x, nx, r, R; __device__ __forceinline__ void init() {
    unsigned base = ARG_OFF; asm volatile("" : "+v"(base)); const __attribute__((address_space(3))) unsigned* p = (const __attribute__((address_space(3))) unsigned*)(size_t)base;
    unsigned a = p[51], b = p[52], c = p[53], d = p[54]; asm volatile("" : "+v"(a), "+v"(b), "+v"(c), "+v"(d));
    r = (int)__builtin_amdgcn_readfirstlane(a); x = (int)__builtin_amdgcn_readfirstlane(b); nx = (int)__builtin_amdgcn_readfirstlane(c); R = (int)__builtin_amdgcn_readfirstlane(d); } };
typedef _Float16 hf2 __attribute__((ext_vector_type(2)));
typedef unsigned uv4 __attribute__((ext_vector_type(4))); typedef float fv4 __attribute__((ext_vector_type(4)));
typedef __attribute__((address_space(1))) uv4 GU4; typedef __attribute__((address_space(1))) float GF32; typedef __attribute__((address_space(1))) fv4 GF4;
__device__ __forceinline__ uint4 ldg4(const void* p) { const uv4 v = *(const GU4*)p; return make_uint4(v.x, v.y, v.z, v.w); }
__device__ __forceinline__ float4 ldgf4(const void* p) { const fv4 v = *(const GF4*)p; return make_float4(v.x, v.y, v.z, v.w); }
template <int CTRL> __device__ __forceinline__ float dppmov(float v) { return __builtin_bit_cast(float, __builtin_amdgcn_update_dpp(0, __builtin_bit_cast(int, v), CTRL, 0xF, 0xF, true)); }
__device__ __forceinline__ float sum8(float p) { p += dppmov<0xB1>(p); p += dppmov<0x4E>(p); p += dppmov<0x141>(p); return p; }
__device__ __forceinline__ float sum_x8_16_32(float a) { a += dppmov<0x128>(a);
    { auto r = __builtin_amdgcn_permlane16_swap(__builtin_bit_cast(unsigned, a), __builtin_bit_cast(unsigned, a), false, false); a = __builtin_bit_cast(float, r[0]) + __builtin_bit_cast(float, r[1]); }
    { auto r = __builtin_amdgcn_permlane32_swap(__builtin_bit_cast(unsigned, a), __builtin_bit_cast(unsigned, a), false, false); a = __builtin_bit_cast(float, r[0]) + __builtin_bit_cast(float, r[1]); }
    return a; }
struct UItem { int s, row; };
__device__ __forceinline__ UItem u_item(int k, int n, int nrw, const SliceDeal& sd, int wave) { const int kk = k < n ? k : n - 1; UItem it; it.s = sd.x + (kk / nrw) * sd.nx; it.row = sd.r * 8 + wave + (kk % nrw) * sd.R * 8; return it; }
template <unsigned EMASK>
__device__ __forceinline__ void peer_u_pass(const signed char* __restrict__ HQ, const int* __restrict__ IDX, const unsigned char* __restrict__ UQ, int* __restrict__ PART, int rows, int tid) {
    const int wave = __builtin_amdgcn_readfirstlane(tid >> 6), lane = tid & 63, g = lane >> 3, c8 = lane & 7;
    SliceDeal sd; sd.init();
    const int first = sd.r * 8 + wave, stepw = sd.R * 8;
    const int nrw = first < rows ? (rows - first + stepw - 1) / stepw : 0, nsl = sd.x < 16 ? (16 - sd.x + sd.nx - 1) / sd.nx : 0, n = nrw * nsl;
    if (n == 0) return;
    uint4 hrA, hrB, idg; uint4 er[4]; uint4 tA[16], tB[16];
    typedef __attribute__((address_space(3))) uv4 L4;
    const unsigned wl = (unsigned)wave * 512u, wr_id = wl + 16u * (lane & 31), rd_id = wl + 64u * g;
#define U_GLOAD(IT) do { idg = ldg4(IDX + (size_t)(IT).row * 128 + 4 * (lane & 31)); } while (0)
#define U_LDS_E() do { *(L4*)(size_t)wr_id = (uv4){idg.x, idg.y, idg.z, idg.w}; _Pragma("unroll") for (int i_ = 0; i_ < 4; ++i_) { const uv4 v_ = *(const L4*)(size_t)(rd_id + 16u * i_); er[i_] = make_uint4(v_.x, v_.y, v_.z, v_.w); } } while (0)
#define U_LOAD_H(HR, IT) do { HR = ldg4(HQ + (size_t)(IT).row * D + 128 * (IT).s + 16 * c8); } while (0)
#define U_LOAD_T(T, IT) do { const unsigned char* us_ = UQ + (size_t)(IT).s * 16384 * 128 + 16 * c8; _Pragma("unroll") for (int i_ = 0; i_ < 4; ++i_) { \
        T[4 * i_] = ldg4(us_ + (er[i_].x & EMASK) * 128u); T[4 * i_ + 1] = ldg4(us_ + (er[i_].y & EMASK) * 128u); T[4 * i_ + 2] = ldg4(us_ + (er[i_].z & EMASK) * 128u); T[4 * i_ + 3] = ldg4(us_ + (er[i_].w & EMASK) * 128u); } } while (0)
#define U_STEP(HRC, TC, HRN, TN) do { \
        U_LDS_E(); U_GLOAD(itn2); U_LOAD_H(HRN, itn); \
        const unsigned char* us_ = UQ + (size_t)itn.s * 16384 * 128 + 16 * c8; const unsigned e_[16] = {er[0].x, er[0].y, er[0].z, er[0].w, er[1].x, er[1].y, er[1].z, er[1].w, er[2].x, er[2].y, er[2].z, er[2].w, er[3].x, er[3].y, er[3].z, er[3].w}; \
        int keep0_ = 0, keep1_ = 0; \
        _Pragma("unroll") for (int i_ = 0; i_ < 16; ++i_) { \
            TN[i_] = ldg4(us_ + (e_[i_] & EMASK) * 128u); \
            int p_ = __builtin_amdgcn_sdot4((int)TC[i_].x, (int)HRC.x, 0, false); p_ = __builtin_amdgcn_sdot4((int)TC[i_].y, (int)HRC.y, p_, false); \
            p_ = __builtin_amdgcn_sdot4((int)TC[i_].z, (int)HRC.z, p_, false); p_ = __builtin_amdgcn_sdot4((int)TC[i_].w, (int)HRC.w, p_, false); \
            p_ += __builtin_amdgcn_update_dpp(0, p_, 0xB1, 0xF, 0xF, true); p_ += __builtin_amdgcn_update_dpp(0, p_, 0x4E, 0xF, 0xF, true); p_ += __builtin_amdgcn_update_dpp(0, p_, 0x141, 0xF, 0xF, true); \
            if ((i_ & 7) == c8) { if (i_ < 8) keep0_ = p_; else keep1_ = p_; } \
            __builtin_amdgcn_sched_barrier(0); } \
        *(__attribute__((address_space(1))) unsigned*)((short*)PART + ((size_t)itc.s * rows + itc.row) * 128 + 16 * g + 2 * c8) = ((unsigned)((keep0_ + 32) >> 6) & 0xFFFFu) | ((unsigned)((keep1_ + 32) >> 6) << 16);     \
        __builtin_amdgcn_sched_barrier(0); \
        asm volatile("" :: "v"(idg.x), "v"(HRN.x));     \
        __builtin_amdgcn_sched_barrier(0); \
        itc = itn; itn = itn2; } while (0)
    UItem itc = u_item(0, n, nrw, sd, wave), itn = u_item(1, n, nrw, sd, wave), itn2;
    U_GLOAD(itc); U_LDS_E();
    __builtin_amdgcn_sched_barrier(0);
    U_GLOAD(itn); U_LOAD_H(hrA, itc);
    __builtin_amdgcn_sched_barrier(0);
    U_LOAD_T(tA, itc);
    __builtin_amdgcn_sched_barrier(0);
    { const UItem ita = u_item(2, n, nrw, sd, wave), itb = u_item(3, n, nrw, sd, wave);
      __builtin_amdgcn_sched_barrier(0);
      itn2 = ita; U_STEP(hrA, tA, hrB, tB);
      itn2 = itb; U_STEP(hrB, tB, hrA, tA); }
    for (int k = 2; k < n; k += 2) {
        const UItem ita = u_item(k + 2, n, nrw, sd, wave), itb = u_item(k + 3, n, nrw, sd, wave);
        __builtin_amdgcn_sched_barrier(0);
        itn2 = ita;
        U_STEP(hrA, tA, hrB, tB);
        itn2 = itb;
        U_STEP(hrB, tB, hrA, tA);
    }
#undef U_GLOAD
#undef U_LDS_E
#undef U_LOAD_H
#undef U_LOAD_T
#undef U_STEP
}
__device__ __forceinline__ void peer_coef_pass(const int* __restrict__ PART, const int* __restrict__ IDX, const float* __restrict__ GWT, const float* __restrict__ SU, const float* __restrict__ SV,
                                               const float* __restrict__ SH, signed char* __restrict__ COEFQ, float* __restrict__ CS, int rows, int tid) {
    const int wave = tid >> 6, lane = tid & 63, j0 = 16 * (lane >> 3) + (lane & 7), j1 = j0 + 8;
    for (int row = blockIdx.x * 8 + wave; row < rows; row += grid_x() * 8) {
        const size_t i = (size_t)row * 128;
        int d0 = 0, d1 = 0;
#pragma unroll
        for (int s = 0; s < 16; ++s) { const unsigned v = *(const unsigned*)((const short*)PART + (size_t)s * rows * 128 + i + 2 * lane); d0 += (int)(v << 16) >> 16; d1 += (int)v >> 16; }
        const int e0 = IDX[i + j0], e1 = IDX[i + j1]; const float sh = SH[row];
        const float c0 = gelu_fast((float)d0 * 64.f * SU[e0] * sh) * GWT[i + j0] * SV[e0], c1 = gelu_fast((float)d1 * 64.f * SU[e1] * sh) * GWT[i + j1] * SV[e1];
        const float mx = wmax(fmaxf(fabsf(c0), fabsf(c1)));
        const float sc = mx > 0.f ? mx * (1.f / 16383.f) : 1.f, inv = 1.f / sc;
        const int q0 = __float2int_rn(c0 * inv), q1 = __float2int_rn(c1 * inv);
        signed char* cq = COEFQ + (size_t)row * 256;
        cq[j0] = (signed char)(q0 >> 7); cq[j1] = (signed char)(q1 >> 7); cq[128 + j0] = (signed char)(q0 & 127); cq[128 + j1] = (signed char)(q1 & 127);
        if (lane == 0) CS[row] = sc;
    }
}
typedef unsigned uv2_ __attribute__((ext_vector_type(2))); typedef int v4i_ __attribute__((ext_vector_type(4)));
__device__ __forceinline__ void peer_v_pass(const signed char* __restrict__ COEFQ, const float* __restrict__ CS, const int* __restrict__ IDX, const unsigned char* __restrict__ VQ, bf16_t* __restrict__ F, int rows, int tid) {
    const int wave = __builtin_amdgcn_readfirstlane(tid >> 6), lane = tid & 63, n16 = lane & 15, kg = lane >> 4, rsel = n16 >> 3, c8 = n16 & 7;
    SliceDeal sd; sd.init();
    const int npairs = rows >> 1, first = sd.r * 8 + wave, stepw = sd.R * 8;
    const int nrw = first < npairs ? (npairs - first + stepw - 1) / stepw : 0, nsl = sd.x < 16 ? (16 - sd.x + sd.nx - 1) / sd.nx : 0, n = nrw * nsl;
    if (n == 0) return;
    uint4 rawA[8], rawB[8], ee[2], idg, cfg; uv2_ aq; v4i_ acc[16]; unsigned tr[32];
    const int arow = n16 & 3;
    typedef __attribute__((address_space(3))) uv4 L4; typedef __attribute__((address_space(3))) uv2_ L2_;
    const unsigned wl = (unsigned)wave * 3072u, wr_id = 16u * lane, wr_cf = 1024u + 16u * (lane & 31), rd_id = (unsigned)rsel * 512u + 128u * kg, rd_cf = 1024u + (unsigned)(arow >> 1) * 256u + (unsigned)(arow & 1) * 128u + 32u * kg;
#define V_GLOAD(IT) do { idg = ldg4(IDX + (size_t)(2 * (IT).row) * 128 + 4 * lane); cfg = ldg4(COEFQ + (size_t)(2 * (IT).row) * 256 + 16 * (lane & 31)); } while (0)
#define V_LWRITE(SL) do { *(L4*)(size_t)(wl + (SL) + wr_id) = (uv4){idg.x, idg.y, idg.z, idg.w}; *(L4*)(size_t)(wl + (SL) + wr_cf) = (uv4){cfg.x, cfg.y, cfg.z, cfg.w}; } while (0)
#define V_LREAD(SL_E, Q_E, SL_A, Q_A) do { const uv4 a_ = *(const L4*)(size_t)(wl + (SL_E) + rd_id + 32u * (Q_E)), b_ = *(const L4*)(size_t)(wl + (SL_E) + rd_id + 32u * (Q_E) + 16u); \
        ee[0] = make_uint4(a_.x, a_.y, a_.z, a_.w); ee[1] = make_uint4(b_.x, b_.y, b_.z, b_.w); aq = *(const L2_*)(size_t)(wl + (SL_A) + rd_cf + 8u * (Q_A)); } while (0)
#define V_LOAD_T(RAW, IT) do { const unsigned char* vs_ = VQ + (size_t)(IT).s * 16384 * 128 + 16 * c8; \
        RAW[0] = ldg4(vs_ + ee[0].x * 128u); RAW[1] = ldg4(vs_ + ee[0].y * 128u); RAW[2] = ldg4(vs_ + ee[0].z * 128u); RAW[3] = ldg4(vs_ + ee[0].w * 128u); \
        RAW[4] = ldg4(vs_ + ee[1].x * 128u); RAW[5] = ldg4(vs_ + ee[1].y * 128u); RAW[6] = ldg4(vs_ + ee[1].z * 128u); RAW[7] = ldg4(vs_ + ee[1].w * 128u); } while (0)
#define V_T4(A_, B_, C_, D_, O_) do { const unsigned abl_ = __builtin_amdgcn_perm(B_, A_, 0x05010400u), abh_ = __builtin_amdgcn_perm(B_, A_, 0x07030602u), \
        cdl_ = __builtin_amdgcn_perm(D_, C_, 0x05010400u), cdh_ = __builtin_amdgcn_perm(D_, C_, 0x07030602u); \
        tr[(O_)] = __builtin_amdgcn_perm(cdl_, abl_, 0x05040100u); tr[(O_) + 2] = __builtin_amdgcn_perm(cdl_, abl_, 0x07060302u); \
        tr[(O_) + 4] = __builtin_amdgcn_perm(cdh_, abh_, 0x05040100u); tr[(O_) + 6] = __builtin_amdgcn_perm(cdh_, abh_, 0x07060302u); } while (0)
#define V_TRANS(RAW) do { V_T4(RAW[0].x, RAW[1].x, RAW[2].x, RAW[3].x, 0); V_T4(RAW[4].x, RAW[5].x, RAW[6].x, RAW[7].x, 1); V_T4(RAW[0].y, RAW[1].y, RAW[2].y, RAW[3].y, 8); V_T4(RAW[4].y, RAW[5].y, RAW[6].y, RAW[7].y, 9); \
        V_T4(RAW[0].z, RAW[1].z, RAW[2].z, RAW[3].z, 16); V_T4(RAW[4].z, RAW[5].z, RAW[6].z, RAW[7].z, 17); V_T4(RAW[0].w, RAW[1].w, RAW[2].w, RAW[3].w, 24); V_T4(RAW[4].w, RAW[5].w, RAW[6].w, RAW[7].w, 25); } while (0)
#define V_MMA(FIRST) do { const v4i_ vzero_ = {0, 0, 0, 0}; const uv2_ am_ = n16 < 4 ? aq : (uv2_){0u, 0u}; const long al_ = __builtin_bit_cast(long, am_); \
        _Pragma("unroll") for (int t_ = 0; t_ < 16; ++t_) { const long bl_ = __builtin_bit_cast(long, (uv2_){tr[2 * t_], tr[2 * t_ + 1]}); \
            acc[t_] = __builtin_amdgcn_mfma_i32_16x16x32_i8(al_, bl_, (FIRST) ? vzero_ : acc[t_], 0, 0, 0); } } while (0)
#define V_STEP(RAW, SL_E, Q_E, SL_A, Q_A, IT_T, FIRST) do { \
        V_LREAD(SL_E, Q_E, SL_A, Q_A); \
        V_TRANS(RAW); \
        __builtin_amdgcn_sched_barrier(0); \
        V_LOAD_T(RAW, IT_T); \
        __builtin_amdgcn_sched_barrier(0); \
        V_MMA(FIRST); \
        __builtin_amdgcn_sched_barrier(0); } while (0)
    UItem itc = u_item(0, n, nrw, sd, wave), itn = u_item(1, n, nrw, sd, wave);
    V_GLOAD(itc); V_LWRITE(0u);
    V_LREAD(0u, 0, 0u, 0); V_LOAD_T(rawA, itc);
    __builtin_amdgcn_sched_barrier(0);
    V_LREAD(0u, 1, 0u, 1); V_LOAD_T(rawB, itc);
    __builtin_amdgcn_sched_barrier(0);
    unsigned cur = 0u;
    for (int k = 0; k < n; ++k) {
        const unsigned nxt = 1536u - cur;
        V_GLOAD(itn);
        __builtin_amdgcn_sched_barrier(0);
        V_STEP(rawA, cur, 2, cur, 0, itc, true);
        V_STEP(rawB, cur, 3, cur, 1, itc, false);
        V_LWRITE(nxt);
        __builtin_amdgcn_sched_barrier(0);
        V_STEP(rawA, nxt, 0, cur, 2, itn, false);
        V_STEP(rawB, nxt, 1, cur, 3, itn, false);
        {
            typedef __attribute__((address_space(3))) uv4 LU4;
            const unsigned fs_ = 24576u + (unsigned)wave * 1024u;
            if (kg == 0) { const float cs_ = CS[2 * itc.row + rsel]; unsigned w_[8];
#pragma unroll
                for (int t2 = 0; t2 < 8; ++t2) { const v4i_ a_ = acc[2 * t2], b_ = acc[2 * t2 + 1];
                    const int ha_ = rsel ? a_.z : a_.x, la_ = rsel ? a_.w : a_.y, hb_ = rsel ? b_.z : b_.x, lb_ = rsel ? b_.w : b_.y;
                    w_[t2] = pk2((float)(ha_ * 128 + la_) * cs_, (float)(hb_ * 128 + lb_) * cs_); }
                *(LU4*)(size_t)(fs_ + (unsigned)n16 * 32u) = (uv4){w_[0], w_[1], w_[2], w_[3]}; *(LU4*)(size_t)(fs_ + (unsigned)n16 * 32u + 16u) = (uv4){w_[4], w_[5], w_[6], w_[7]}; }
            const uv4 o_ = *(const LU4*)(size_t)(fs_ + 16u * (lane & 31));
            if (lane < 32) *(GU4*)(F + (size_t)(2 * itc.row + (lane >> 4)) * D + 128 * itc.s + 8 * (lane & 15)) = o_;
        }
        __builtin_amdgcn_sched_barrier(0);
        itc = itn; itn = u_item(k + 2, n, nrw, sd, wave); cur = nxt;
    }
#undef V_GLOAD
#undef V_LWRITE
#undef V_LREAD
#undef V_LOAD_T
#undef V_T4
#undef V_TRANS
#undef V_MMA
#undef V_STEP
}
template <bool LAST>
__device__ __forceinline__ void peer_row_pass(float* __restrict__ X, const bf16_t* __restrict__ F, const float* __restrict__ MODl, const float* __restrict__ gnext, const float* __restrict__ MODn,
                                              bf16_t* __restrict__ Hn, float* __restrict__ out, int rows, int tid) {
    const int wave = tid >> 6, lane = tid & 63;
    for (int row = blockIdx.x * 8 + wave; row < rows; row += grid_x() * 8) {
        const float* md = MODl + (row < S ? 0 : NMOD) + 5 * D;
        float4 v[8]; float ss = 0.f;
#pragma unroll
        for (int i = 0; i < 8; ++i) { const int col = 4 * lane + 256 * i; const float4 x = *(const float4*)(X + (size_t)row * D + col), g2 = *(const float4*)(md + col); const uint2 fb = *(const uint2*)(F + (size_t)row * D + col); const float4 f = make_float4(bf2f(fb.x), bf2f(fb.x >> 16), bf2f(fb.y), bf2f(fb.y >> 16));
            v[i] = make_float4(x.x + g2.x * f.x, x.y + g2.y * f.y, x.z + g2.z * f.z, x.w + g2.w * f.w);
            ss += v[i].x * v[i].x + v[i].y * v[i].y + v[i].z * v[i].z + v[i].w * v[i].w;
            if (!LAST) *(float4*)(X + (size_t)row * D + col) = v[i]; }
        ss = wsum(ss);
        const float rs = rsqrtf(ss * (1.f / D) + EPS);
        const float* mn = LAST ? nullptr : MODn + (row < S ? 0 : NMOD);
#pragma unroll
        for (int i = 0; i < 8; ++i) { const int col = 4 * lane + 256 * i; const float4 g = *(const float4*)(gnext + col);
            if (LAST) *(float4*)(out + (size_t)row * D + col) = make_float4(v[i].x * rs * g.x, v[i].y * rs * g.y, v[i].z * rs * g.z, v[i].w * rs * g.w);
            else { const float4 sh = *(const float4*)(mn + col), sc = *(const float4*)(mn + D + col);
                uint2 p; p.x = pk2(v[i].x * rs * g.x * (1.f + sc.x) + sh.x, v[i].y * rs * g.y * (1.f + sc.y) + sh.y); p.y = pk2(v[i].z * rs * g.z * (1.f + sc.z) + sh.z, v[i].w * rs * g.w * (1.f + sc.w) + sh.w);
                *(uint2*)(Hn + (size_t)row * D + col) = p; } }
    }
}
__device__ __forceinline__ void keys_split_phase(const float* __restrict__ keys, bf16_t* __restrict__ KS, int n_rows, int tid) {
    for (int i = blockIdx.x * 512 + tid; i < n_rows * 32; i += grid_x() * 512) {
        const int row = i >> 5, c4 = (i & 31) * 4; const float4 v = *(const float4*)(keys + (size_t)row * 128 + c4);
        uint2 h; h.x = pk2(v.x, v.y); h.y = pk2(v.z, v.w);
        uint2 lo; lo.x = pk2(v.x - bf2f(h.x), v.y - bf2f(h.x >> 16)); lo.y = pk2(v.z - bf2f(h.y), v.w - bf2f(h.y >> 16));
        *(uint2*)(KS + (size_t)row * 256 + c4) = h; *(uint2*)(KS + (size_t)row * 256 + 128 + c4) = lo;
    }
}
#define SORT16_DESC(K) do { \
    { const unsigned hi_ = max(K[0], K[1]), lo_ = min(K[0], K[1]); K[0] = hi_; K[1] = lo_; } \
    { const unsigned hi_ = max(K[3], K[2]), lo_ = min(K[3], K[2]); K[3] = hi_; K[2] = lo_; } \
    { const unsigned hi_ = max(K[4], K[5]), lo_ = min(K[4], K[5]); K[4] = hi_; K[5] = lo_; } \
    { const unsigned hi_ = max(K[7], K[6]), lo_ = min(K[7], K[6]); K[7] = hi_; K[6] = lo_; } \
    { const unsigned hi_ = max(K[8], K[9]), lo_ = min(K[8], K[9]); K[8] = hi_; K[9] = lo_; } \
    { const unsigned hi_ = max(K[11], K[10]), lo_ = min(K[11], K[10]); K[11] = hi_; K[10] = lo_; } \
    { const unsigned hi_ = max(K[12], K[13]), lo_ = min(K[12], K[13]); K[12] = hi_; K[13] = lo_; } \
    { const unsigned hi_ = max(K[15], K[14]), lo_ = min(K[15], K[14]); K[15] = hi_; K[14] = lo_; } \
    { const unsigned hi_ = max(K[0], K[2]), lo_ = min(K[0], K[2]); K[0] = hi_; K[2] = lo_; } \
    { const unsigned hi_ = max(K[1], K[3]), lo_ = min(K[1], K[3]); K[1] = hi_; K[3] = lo_; } \
    { const unsigned hi_ = max(K[6], K[4]), lo_ = min(K[6], K[4]); K[6] = hi_; K[4] = lo_; } \
    { const unsigned hi_ = max(K[7], K[5]), lo_ = min(K[7], K[5]); K[7] = hi_; K[5] = lo_; } \
    { const unsigned hi_ = max(K[8], K[10]), lo_ = min(K[8], K[10]); K[8] = hi_; K[10] = lo_; } \
    { const unsigned hi_ = max(K[9], K[11]), lo_ = min(K[9], K[11]); K[9] = hi_; K[11] = lo_; } \
    { const unsigned hi_ = max(K[14], K[12]), lo_ = min(K[14], K[12]); K[14] = hi_; K[12] = lo_; } \
    { const unsigned hi_ = max(K[15], K[13]), lo_ = min(K[15], K[13]); K[15] = hi_; K[13] = lo_; } \
    { const unsigned hi_ = max(K[0], K[1]), lo_ = min(K[0], K[1]); K[0] = hi_; K[1] = lo_; } \
    { const unsigned hi_ = max(K[2], K[3]), lo_ = min(K[2], K[3]); K[2] = hi_; K[3] = lo_; } \
    { const unsigned hi_ = max(K[5], K[4]), lo_ = min(K[5], K[4]); K[5] = hi_; K[4] = lo_; } \
    { const unsigned hi_ = max(K[7], K[6]), lo_ = min(K[7], K[6]); K[7] = hi_; K[6] = lo_; } \
    { const unsigned hi_ = max(K[8], K[9]), lo_ = min(K[8], K[9]); K[8] = hi_; K[9] = lo_; } \
    { const unsigned hi_ = max(K[10], K[11]), lo_ = min(K[10], K[11]); K[10] = hi_; K[11] = lo_; } \
    { const unsigned hi_ = max(K[13], K[12]), lo_ = min(K[13], K[12]); K[13] = hi_; K[12] = lo_; } \
    { const unsigned hi_ = max(K[15], K[14]), lo_ = min(K[15], K[14]); K[15] = hi_; K[14] = lo_; } \
    { const unsigned hi_ = max(K[0], K[4]), lo_ = min(K[0], K[4]); K[0] = hi_; K[4] = lo_; } \
    { const unsigned hi_ = max(K[1], K[5]), lo_ = min(K[1], K[5]); K[1] = hi_; K[5] = lo_; } \
    { const unsigned hi_ = max(K[2], K[6]), lo_ = min(K[2], K[6]); K[2] = hi_; K[6] = lo_; } \
    { const unsigned hi_ = max(K[3], K[7]), lo_ = min(K[3], K[7]); K[3] = hi_; K[7] = lo_; } \
    { const unsigned hi_ = max(K[12], K[8]), lo_ = min(K[12], K[8]); K[12] = hi_; K[8] = lo_; } \
    { const unsigned hi_ = max(K[13], K[9]), lo_ = min(K[13], K[9]); K[13] = hi_; K[9] = lo_; } \
    { const unsigned hi_ = max(K[14], K[10]), lo_ = min(K[14], K[10]); K[14] = hi_; K[10] = lo_; } \
    { const unsigned hi_ = max(K[15], K[11]), lo_ = min(K[15], K[11]); K[15] = hi_; K[11] = lo_; } \
    { const unsigned hi_ = max(K[0], K[2]), lo_ = min(K[0], K[2]); K[0] = hi_; K[2] = lo_; } \
    { const unsigned hi_ = max(K[1], K[3]), lo_ = min(K[1], K[3]); K[1] = hi_; K[3] = lo_; } \
    { const unsigned hi_ = max(K[4], K[6]), lo_ = min(K[4], K[6]); K[4] = hi_; K[6] = lo_; } \
    { const unsigned hi_ = max(K[5], K[7]), lo_ = min(K[5], K[7]); K[5] = hi_; K[7] = lo_; } \
    { const unsigned hi_ = max(K[10], K[8]), lo_ = min(K[10], K[8]); K[10] = hi_; K[8] = lo_; } \
    { const unsigned hi_ = max(K[11], K[9]), lo_ = min(K[11], K[9]); K[11] = hi_; K[9] = lo_; } \
    { const unsigned hi_ = max(K[14], K[12]), lo_ = min(K[14], K[12]); K[14] = hi_; K[12] = lo_; } \
    { const unsigned hi_ = max(K[15], K[13]), lo_ = min(K[15], K[13]); K[15] = hi_; K[13] = lo_; } \
    { const unsigned hi_ = max(K[0], K[1]), lo_ = min(K[0], K[1]); K[0] = hi_; K[1] = lo_; } \
    { const unsigned hi_ = max(K[2], K[3]), lo_ = min(K[2], K[3]); K[2] = hi_; K[3] = lo_; } \
    { const unsigned hi_ = max(K[4], K[5]), lo_ = min(K[4], K[5]); K[4] = hi_; K[5] = lo_; } \
    { const unsigned hi_ = max(K[6], K[7]), lo_ = min(K[6], K[7]); K[6] = hi_; K[7] = lo_; } \
    { const unsigned hi_ = max(K[9], K[8]), lo_ = min(K[9], K[8]); K[9] = hi_; K[8] = lo_; } \
    { const unsigned hi_ = max(K[11], K[10]), lo_ = min(K[11], K[10]); K[11] = hi_; K[10] = lo_; } \
    { const unsigned hi_ = max(K[13], K[12]), lo_ = min(K[13], K[12]); K[13] = hi_; K[12] = lo_; } \
    { const unsigned hi_ = max(K[15], K[14]), lo_ = min(K[15], K[14]); K[15] = hi_; K[14] = lo_; } \
    { const unsigned hi_ = max(K[0], K[8]), lo_ = min(K[0], K[8]); K[0] = hi_; K[8] = lo_; } \
    { const unsigned hi_ = max(K[1], K[9]), lo_ = min(K[1], K[9]); K[1] = hi_; K[9] = lo_; } \
    { const unsigned hi_ = max(K[2], K[10]), lo_ = min(K[2], K[10]); K[2] = hi_; K[10] = lo_; } \
    { const unsigned hi_ = max(K[3], K[11]), lo_ = min(K[3], K[11]); K[3] = hi_; K[11] = lo_; } \
    { const unsigned hi_ = max(K[4], K[12]), lo_ = min(K[4], K[12]); K[4] = hi_; K[12] = lo_; } \
    { const unsigned hi_ = max(K[5], K[13]), lo_ = min(K[5], K[13]); K[5] = hi_; K[13] = lo_; } \
    { const unsigned hi_ = max(K[6], K[14]), lo_ = min(K[6], K[14]); K[6] = hi_; K[14] = lo_; } \
    { const unsigned hi_ = max(K[7], K[15]), lo_ = min(K[7], K[15]); K[7] = hi_; K[15] = lo_; } \
    { const unsigned hi_ = max(K[0], K[4]), lo_ = min(K[0], K[4]); K[0] = hi_; K[4] = lo_; } \
    { const unsigned hi_ = max(K[1], K[5]), lo_ = min(K[1], K[5]); K[1] = hi_; K[5] = lo_; } \
    { const unsigned hi_ = max(K[2], K[6]), lo_ = min(K[2], K[6]); K[2] = hi_; K[6] = lo_; } \
    { const unsigned hi_ = max(K[3], K[7]), lo_ = min(K[3], K[7]); K[3] = hi_; K[7] = lo_; } \
    { const unsigned hi_ = max(K[8], K[12]), lo_ = min(K[8], K[12]); K[8] = hi_; K[12] = lo_; } \
    { const unsigned hi_ = max(K[9], K[13]), lo_ = min(K[9], K[13]); K[9] = hi_; K[13] = lo_; } \
    { const unsigned hi_ = max(K[10], K[14]), lo_ = min(K[10], K[14]); K[10] = hi_; K[14] = lo_; } \
    { const unsigned hi_ = max(K[11], K[15]), lo_ = min(K[11], K[15]); K[11] = hi_; K[15] = lo_; } \
    { const unsigned hi_ = max(K[0], K[2]), lo_ = min(K[0], K[2]); K[0] = hi_; K[2] = lo_; } \
    { const unsigned hi_ = max(K[1], K[3]), lo_ = min(K[1], K[3]); K[1] = hi_; K[3] = lo_; } \
    { const unsigned hi_ = max(K[4], K[6]), lo_ = min(K[4], K[6]); K[4] = hi_; K[6] = lo_; } \
    { const unsigned hi_ = max(K[5], K[7]), lo_ = min(K[5], K[7]); K[5] = hi_; K[7] = lo_; } \
    { const unsigned hi_ = max(K[8], K[10]), lo_ = min(K[8], K[10]); K[8] = hi_; K[10] = lo_; } \
    { const unsigned hi_ = max(K[9], K[11]), lo_ = min(K[9], K[11]); K[9] = hi_; K[11] = lo_; } \
    { const unsigned hi_ = max(K[12], K[14]), lo_ = min(K[12], K[14]); K[12] = hi_; K[14] = lo_; } \
    { const unsigned hi_ = max(K[13], K[15]), lo_ = min(K[13], K[15]); K[13] = hi_; K[15] = lo_; } \
    { const unsigned hi_ = max(K[0], K[1]), lo_ = min(K[0], K[1]); K[0] = hi_; K[1] = lo_; } \
    { const unsigned hi_ = max(K[2], K[3]), lo_ = min(K[2], K[3]); K[2] = hi_; K[3] = lo_; } \
    { const unsigned hi_ = max(K[4], K[5]), lo_ = min(K[4], K[5]); K[4] = hi_; K[5] = lo_; } \
    { const unsigned hi_ = max(K[6], K[7]), lo_ = min(K[6], K[7]); K[6] = hi_; K[7] = lo_; } \
    { const unsigned hi_ = max(K[8], K[9]), lo_ = min(K[8], K[9]); K[8] = hi_; K[9] = lo_; } \
    { const unsigned hi_ = max(K[10], K[11]), lo_ = min(K[10], K[11]); K[10] = hi_; K[11] = lo_; } \
    { const unsigned hi_ = max(K[12], K[13]), lo_ = min(K[12], K[13]); K[12] = hi_; K[13] = lo_; } \
    { const unsigned hi_ = max(K[14], K[15]), lo_ = min(K[14], K[15]); K[14] = hi_; K[15] = lo_; } \
} while (0)
#define MERGE16_DESC(K) do { \
    { const unsigned hi_ = max(K[0], K[8]), lo_ = min(K[0], K[8]); K[0] = hi_; K[8] = lo_; } \
    { const unsigned hi_ = max(K[1], K[9]), lo_ = min(K[1], K[9]); K[1] = hi_; K[9] = lo_; } \
    { const unsigned hi_ = max(K[2], K[10]), lo_ = min(K[2], K[10]); K[2] = hi_; K[10] = lo_; } \
    { const unsigned hi_ = max(K[3], K[11]), lo_ = min(K[3], K[11]); K[3] = hi_; K[11] = lo_; } \
    { const unsigned hi_ = max(K[4], K[12]), lo_ = min(K[4], K[12]); K[4] = hi_; K[12] = lo_; } \
    { const unsigned hi_ = max(K[5], K[13]), lo_ = min(K[5], K[13]); K[5] = hi_; K[13] = lo_; } \
    { const unsigned hi_ = max(K[6], K[14]), lo_ = min(K[6], K[14]); K[6] = hi_; K[14] = lo_; } \
    { const unsigned hi_ = max(K[7], K[15]), lo_ = min(K[7], K[15]); K[7] = hi_; K[15] = lo_; } \
    { const unsigned hi_ = max(K[0], K[4]), lo_ = min(K[0], K[4]); K[0] = hi_; K[4] = lo_; } \
    { const unsigned hi_ = max(K[1], K[5]), lo_ = min(K[1], K[5]); K[1] = hi_; K[5] = lo_; } \
    { const unsigned hi_ = max(K[2], K[6]), lo_ = min(K[2], K[6]); K[2] = hi_; K[6] = lo_; } \
    { const unsigned hi_ = max(K[3], K[7]), lo_ = min(K[3], K[7]); K[3] = hi_; K[7] = lo_; } \
    { const unsigned hi_ = max(K[8], K[12]), lo_ = min(K[8], K[12]); K[8] = hi_; K[12] = lo_; } \
    { const unsigned hi_ = max(K[9], K[13]), lo_ = min(K[9], K[13]); K[9] = hi_; K[13] = lo_; } \
    { const unsigned hi_ = max(K[10], K[14]), lo_ = min(K[10], K[14]); K[10] = hi_; K[14] = lo_; } \
    { const unsigned hi_ = max(K[11], K[15]), lo_ = min(K[11], K[15]); K[11] = hi_; K[15] = lo_; } \
    { const unsigned hi_ = max(K[0], K[2]), lo_ = min(K[0], K[2]); K[0] = hi_; K[2] = lo_; } \
    { const unsigned hi_ = max(K[1], K[3]), lo_ = min(K[1], K[3]); K[1] = hi_; K[3] = lo_; } \
    { const unsigned hi_ = max(K[4], K[6]), lo_ = min(K[4], K[6]); K[4] = hi_; K[6] = lo_; } \
    { const unsigned hi_ = max(K[5], K[7]), lo_ = min(K[5], K[7]); K[5] = hi_; K[7] = lo_; } \
    { const unsigned hi_ = max(K[8], K[10]), lo_ = min(K[8], K[10]); K[8] = hi_; K[10] = lo_; } \
    { const unsigned hi_ = max(K[9], K[11]), lo_ = min(K[9], K[11]); K[9] = hi_; K[11] = lo_; } \
    { const unsigned hi_ = max(K[12], K[14]), lo_ = min(K[12], K[14]); K[12] = hi_; K[14] = lo_; } \
    { const unsigned hi_ = max(K[13], K[15]), lo_ = min(K[13], K[15]); K[13] = hi_; K[15] = lo_; } \
    { const unsigned hi_ = max(K[0], K[1]), lo_ = min(K[0], K[1]); K[0] = hi_; K[1] = lo_; } \
    { const unsigned hi_ = max(K[2], K[3]), lo_ = min(K[2], K[3]); K[2] = hi_; K[3] = lo_; } \
    { const unsigned hi_ = max(K[4], K[5]), lo_ = min(K[4], K[5]); K[4] = hi_; K[5] = lo_; } \
    { const unsigned hi_ = max(K[6], K[7]), lo_ = min(K[6], K[7]); K[6] = hi_; K[7] = lo_; } \
    { const unsigned hi_ = max(K[8], K[9]), lo_ = min(K[8], K[9]); K[8] = hi_; K[9] = lo_; } \
    { const unsigned hi_ = max(K[10], K[11]), lo_ = min(K[10], K[11]); K[10] = hi_; K[11] = lo_; } \
    { const unsigned hi_ = max(K[12], K[13]), lo_ = min(K[12], K[13]); K[12] = hi_; K[13] = lo_; } \
    { const unsigned hi_ = max(K[14], K[15]), lo_ = min(K[14], K[15]); K[14] = hi_; K[15] = lo_; } \
} while (0)

__device__ __forceinline__ unsigned enc_key(float f, unsigned tag, unsigned mask) { unsigned u = __float_as_uint(f); u = (u & 0x80000000u) ? ~u : (u | 0x80000000u); return (u & mask) | tag; }
__device__ __forceinline__ float dec_key(unsigned k, unsigned mask) { unsigned u = k & mask; u = (u & 0x80000000u) ? (u & 0x7fffffffu) : ~u; return __uint_as_float(u); }
__device__ __forceinline__ unsigned sel4(int q, unsigned a, unsigned b, unsigned c, unsigned d) { const unsigned lo = (q & 1) ? b : a, hi = (q & 1) ? d : c; return (q & 2) ? hi : lo; }
template <int XM> __device__ __forceinline__ void xmerge16(unsigned (&K)[16], int lane) {
    unsigned o[16];
#pragma unroll
    for (int i = 0; i < 16; ++i) o[i] = (unsigned)shxl_i((int)K[15 - i], XM, lane);
#pragma unroll
    for (int i = 0; i < 16; ++i) K[i] = max(K[i], o[i]);
    MERGE16_DESC(K);
}
constexpr int SEL_KROW = 528;
constexpr int SEL_TAB = 256 * SEL_KROW;
__device__ __forceinline__ void peer_select_sort_phase(const bf16_t* __restrict__ QS, const bf16_t* __restrict__ KS, int* __restrict__ IDX, float* __restrict__ GWT, int rows, char* lds, int tid) {
    const int wave = tid >> 6, lane = tid & 63, n = lane & 15, q = lane >> 4;
    const int G = grid_x(), ngroups = rows / 16;
    const bool byhead = (G % 8) == 0;
    int* li = (int*)(lds + SEL_TAB + wave * 2048);
    for (int h = byhead ? (int)(blockIdx.x & 7) : 0; h < 8; h += byhead ? 8 : 1) {
        __syncthreads();
        for (int c = tid; c < 256 * 32; c += 512) { const int r = c >> 5, ch = c & 31;
            *(uint4*)(lds + r * SEL_KROW + ch * 16) = *(const uint4*)((const char*)KS + ((size_t)(h * 256 + r)) * 512 + ch * 16); }
        __syncthreads();
        const int rank = byhead ? (int)(blockIdx.x >> 3) : (int)blockIdx.x, nrank = byhead ? G / 8 : G;
        for (int grp = rank * 8 + wave; grp < ngroups; grp += nrank * 8) {
            const int token = grp * 16 + n;
            unsigned t12[2][16];
#pragma unroll
            for (int p = 0; p < 2; ++p) {
                bf16x8 qh[4], ql[4];
                const bf16_t* qp = QS + (size_t)token * (2 * D) + h * 256 + p * 128 + 8 * q;
#pragma unroll
                for (int ks = 0; ks < 4; ++ks) { qh[ks] = *(const bf16x8*)(qp + 32 * ks); ql[ks] = *(const bf16x8*)(qp + D + 32 * ks); }
                unsigned ka[16], kb[16];
                const char* kbase = lds + (p * 128 + n) * SEL_KROW + 16 * q;
#pragma unroll
                for (int g = 0; g < 8; ++g) { f32x4 acc = {0.f, 0.f, 0.f, 0.f};
#pragma unroll
                    for (int ks = 0; ks < 4; ++ks) { const bf16x8 kh = *(const bf16x8*)(kbase + 16 * g * SEL_KROW + 64 * ks), kl = *(const bf16x8*)(kbase + 16 * g * SEL_KROW + 256 + 64 * ks);
                        acc = __builtin_amdgcn_mfma_f32_16x16x32_bf16(kh, qh[ks], acc, 0, 0, 0);
                        acc = __builtin_amdgcn_mfma_f32_16x16x32_bf16(kh, ql[ks], acc, 0, 0, 0);
                        acc = __builtin_amdgcn_mfma_f32_16x16x32_bf16(kl, qh[ks], acc, 0, 0, 0); }
#pragma unroll
                    for (int j = 0; j < 4; ++j) { const unsigned k = enc_key(acc[j], (unsigned)(127 - (16 * g + 4 * q + j)), 0xFFFFFF80u); if (g < 4) ka[4 * g + j] = k; else kb[4 * (g - 4) + j] = k; } }
                SORT16_DESC(ka); SORT16_DESC(kb);
#pragma unroll
                for (int i = 0; i < 16; ++i) ka[i] = max(ka[i], kb[15 - i]);
                MERGE16_DESC(ka);
                xmerge16<16>(ka, lane); xmerge16<32>(ka, lane);
#pragma unroll
                for (int i = 0; i < 16; ++i) t12[p][i] = ka[i];
            }
#pragma unroll
            for (int p = 0; p < 2; ++p)
#pragma unroll
                for (int j = 0; j < 4; ++j) li[n * 32 + p * 16 + 4 * q + j] = 127 - (int)(sel4(q, t12[p][j], t12[p][4 + j], t12[p][8 + j], t12[p][12 + j]) & 127u);
            unsigned ck[16];
#pragma unroll
            for (int t = 0; t < 16; ++t) {
                if (t >= 13) { ck[t] = 0u; continue; }
                unsigned sa[4], sb[4];
#pragma unroll
                for (int qq = 0; qq < 4; ++qq) { const int c = qq + 4 * t; int a_, b_;
                    if (c < 16) { a_ = 0; b_ = c; } else if (c < 24) { a_ = 1; b_ = c - 16; } else if (c < 29) { a_ = 2; b_ = c - 24; } else if (c < 33) { a_ = 3; b_ = c - 29; }
                    else if (c < 36) { a_ = 4; b_ = c - 33; } else if (c < 42) { a_ = 5 + ((c - 36) >> 1); b_ = (c - 36) & 1; } else if (c < 50) { a_ = 8 + (c - 42); b_ = 0; } else { a_ = 0; b_ = 0; }
                    sa[qq] = t12[0][a_]; sb[qq] = t12[1][b_]; }
                const int c = q + 4 * t;
                const float sum = dec_key(sel4(q, sa[0], sa[1], sa[2], sa[3]), 0xFFFFFF80u) + dec_key(sel4(q, sb[0], sb[1], sb[2], sb[3]), 0xFFFFFF80u);
                ck[t] = c < 50 ? enc_key(sum, (unsigned)(63 - c), 0xFFFFFFC0u) : 0u;
            }
            SORT16_DESC(ck); xmerge16<16>(ck, lane); xmerge16<32>(ck, lane);
            const float top0 = dec_key(ck[0], 0xFFFFFFC0u);
            float e[4], es = 0.f; int oi[4];
            WAVE_LDS_SYNC();
#pragma unroll
            for (int j = 0; j < 4; ++j) {
                const unsigned kw = sel4(q, ck[j], ck[4 + j], ck[8 + j], ck[12 + j]);
                e[j] = __expf(dec_key(kw, 0xFFFFFFC0u) - top0); es += e[j];
                const int c = 63 - (int)(kw & 63u); int a_, b_;
                if (c < 16) { a_ = 0; b_ = c; } else if (c < 24) { a_ = 1; b_ = c - 16; } else if (c < 29) { a_ = 2; b_ = c - 24; } else if (c < 33) { a_ = 3; b_ = c - 29; }
                else if (c < 36) { a_ = 4; b_ = c - 33; } else if (c < 42) { a_ = 5 + ((c - 36) >> 1); b_ = (c - 36) & 1; } else { a_ = 8 + (c - 42); b_ = 0; }
                oi[j] = li[n * 32 + a_] * 128 + li[n * 32 + 16 + b_];
            }
            es += shxl_f(es, 16, lane); es += shxl_f(es, 32, lane);
            const float inv = 1.f / es;
            *(int4*)(IDX + (size_t)token * 128 + h * 16 + 4 * q) = make_int4(oi[0], oi[1], oi[2], oi[3]);
            *(float4*)(GWT + (size_t)token * 128 + h * 16 + 4 * q) = make_float4(e[0] * inv, e[1] * inv, e[2] * inv, e[3] * inv);
            WAVE_LDS_SYNC();
        }
    }
    __syncthreads();
}
constexpr int LDS_BYTES = 163840, XCH_OFF = 131072, XBW_OFF = 155648;
constexpr size_t W2_BAR = 65536, W2_RANK = 98304, W2_ACNT = 393216  , W2_ROPE = 131072, W2_MOD = 1 * MiB, W2_WIN = 2 * MiB, W2_WBR = 86 * MiB, W2_WOUT = 102 * MiB, W2_WQS = 118 * MiB, W2_X = 150 * MiB,
                 W2_QKV = 280 * MiB, W2_G = 427 * MiB, W2_HS = 280 * MiB, W2_QS = 427 * MiB, W2_B1 = 622 * MiB, W2_O = 687 * MiB, W2_IDX = 752 * MiB, W2_GWT = 761 * MiB,
                 W2_UB = 770 * MiB, W2_VB = 802 * MiB, W2_SU = 834 * MiB, W2_SV = 835 * MiB, W2_KS = 836 * MiB, W2_COEF = 838 * MiB, W2_PART = 557 * MiB, W2_APART = 848 * MiB  , W2_END = 884 * MiB;
struct FArgs { const float* in[22]; float* out; char* ws; };
struct AP {
    static __device__ __forceinline__ const void* ld(int i) {
        unsigned base = ARG_OFF; asm volatile("" : "+v"(base));
        const PG8_LAS unsigned* p = (const PG8_LAS unsigned*)(size_t)base;
        unsigned lo = p[2 * i], hi = p[2 * i + 1]; asm volatile("" : "+v"(lo), "+v"(hi));
        lo = __builtin_amdgcn_readfirstlane(lo); hi = __builtin_amdgcn_readfirstlane(hi);
        return (const void*)(const __attribute__((address_space(1))) void*)(((unsigned long long)hi << 32) | lo);
    }
    static __device__ __forceinline__ const float* in(int i) { return (const float*)ld(i); }
    static __device__ __forceinline__ float* out() { return (float*)ld(22); }
    static __device__ __forceinline__ char* ws() { return (char*)ld(23); }
};
__device__ __forceinline__ int make_tid(int wave_s) { unsigned z = 0u; asm volatile("" : "+v"(z)); int t = wave_s * 64 + (int)__builtin_amdgcn_mbcnt_hi(~0u, __builtin_amdgcn_mbcnt_lo(~0u, z)); asm volatile("" : "+v"(t)); return t; }
#ifndef MK_EMASK
#define MK_EMASK 0xFFFFu
#endif
#ifndef MK_DUP
#define MK_DUP -1
#define MK_DUP_L 0
#endif
#ifndef MK_MASK
#define MK_MASK 1023
#endif
#ifndef MK_PH_LO
#define MK_PH_LO 0
#define MK_PH_HI 1000
#endif
__global__ void __launch_bounds__(512, 2) mk_fwd(FArgs a_unused) {
    extern __shared__ __attribute__((aligned(16))) unsigned char lds[];
    PG8_LAS unsigned char* L = (PG8_LAS unsigned char*)lds;
    const int wave_s = __builtin_amdgcn_readfirstlane((int)threadIdx.x >> 6);
    if (threadIdx.x == 0) *(uint4*)(lds + XBW_OFF) = make_uint4(0u, 0u, 0u, 0u);
    if (threadIdx.x < 24) ((unsigned long long*)(lds + ARG_OFF))[threadIdx.x] = ((const unsigned long long*)&a_unused)[threadIdx.x];
    if (threadIdx.x == 24) ((unsigned long long*)(lds + ARG_OFF))[24] = (unsigned long long)gridDim.x;
    if (threadIdx.x == 25) { const unsigned myx = xb_xcc_id(); const unsigned rk = xb_add((unsigned*)(a_unused.ws + W2_RANK) + 64 * myx, 1u);
        ((unsigned*)(lds + ARG_OFF))[50] = myx; ((unsigned*)(lds + ARG_OFF))[51] = rk; }
    __syncthreads();
    XcdBarrier bar = xcd_barrier_post((unsigned*)(AP::ws() + W2_BAR), (volatile LAS unsigned*)(L + XBW_OFF));
#define WSP(T, off) ((T*)(AP::ws() + (off)))

#if MK_MASK & 1
    { const int tid = make_tid(wave_s); rope_table_phase(WSP(float, W2_ROPE), tid); keys_split_phase(AP::in(18), WSP(bf16_t, W2_KS), NL * 16 * 128, tid); }
#define CONVERT_LAYER(l, b0, nb) do { \
        { const int tid = make_tid(wave_s); cvt_T_phase<1>(AP::in(8) + (size_t)(l) * D * NCOL, D, NCOL, WSP(bf16_t, W2_WIN + (size_t)(l) * 42 * MiB), D, 0, (float*)lds, tid, b0, nb); } \
        { const int tid = make_tid(wave_s); cvt_T_phase<0>(AP::in(13) + (size_t)(l) * 768 * D, 768, D, WSP(bf16_t, W2_WBR + (size_t)(l) * 8 * MiB), D, 0, (float*)lds, tid, b0, nb); } \
        { const int tid = make_tid(wave_s); cvt_T_phase<0>(AP::in(14) + (size_t)(l) * 768 * D, 768, D, WSP(bf16_t, W2_WBR + (size_t)(l) * 8 * MiB), D, 768, (float*)lds, tid, b0, nb); } \
        { const int tid = make_tid(wave_s); cvt_T_phase<0>(AP::in(15) + (size_t)(l) * 512 * D, 512, D, WSP(bf16_t, W2_WBR + (size_t)(l) * 8 * MiB), D, 1536, (float*)lds, tid, b0, nb); } \
        { const int tid = make_tid(wave_s); cvt_T_phase<0>(AP::in(16) + (size_t)(l) * D * D, D, D, WSP(bf16_t, W2_WOUT + (size_t)(l) * 8 * MiB), D, 0, (float*)lds, tid, b0, nb); } \
        { const int tid = make_tid(wave_s); cvt_T_phase<3>(AP::in(17) + (size_t)(l) * D * D, D, D, WSP(bf16_t, W2_WQS + (size_t)(l) * 16 * MiB), D, 0, (float*)lds, tid, b0, nb); } \
        { const int tid = make_tid(wave_s); modvec_phase(AP::in(1), AP::in(3), AP::in(4) + (size_t)(l) * D * NMOD, AP::in(5) + (size_t)(l) * NMOD, WSP(float, W2_MOD) + (size_t)(l) * 2 * NMOD, tid, l, b0, nb); } } while (0)
    CONVERT_LAYER(0, (int)blockIdx.x, grid_x());
#endif
    xcd_barrier(bar);
    if (threadIdx.x == 0) {
        unsigned* bw = (unsigned*)(AP::ws() + W2_BAR); const unsigned myx = ((unsigned*)(lds + ARG_OFF))[50]; unsigned xi = 0, nx = 0, cnt = 1;
        for (unsigned j = 0; j < 16; ++j) { const unsigned c = xb_ld(&bw[XB_XCNT(j)]); if (c > 0u) { if (j < myx) ++xi; ++nx; } if (j == myx) cnt = c > 0u ? c : 1u; }
        ((unsigned*)(lds + ARG_OFF))[52] = xi; ((unsigned*)(lds + ARG_OFF))[53] = nx > 0u ? nx : 1u; ((unsigned*)(lds + ARG_OFF))[54] = cnt; }
    __syncthreads();
#if MK_MASK & 2
    {
        const int tid = make_tid(wave_s);
        norm_mod_phase<0>(AP::in(0), AP::in(2), AP::in(6), WSP(float, W2_MOD), 0, D, WSP(bf16_t, W2_B1), nullptr, MT, tid);
    }
#endif
    xcd_barrier(bar);
    for (int l = 0; l < NL; ++l) {
        const int rows = l < NL - 1 ? MT : S;
        for (int rep = 0; rep < ((MK_DUP == 2 && l == MK_DUP_L) ? 2 : 1); ++rep) {
#if MK_MASK & 4
        {
            const int tid = make_tid(wave_s);
            pg8::Gemm g{WSP(bf16_t, W2_B1), WSP(bf16_t, W2_WIN + (size_t)l * 42 * MiB), };
            pg8::StaticOrder so; so.init(MT, NCOL, grid_x(), blockIdx.x);
            pg8::EpiInprojF E{WSP(bf16_t, W2_QKV), WSP(bf16_t, W2_G), AP::in(10) + l * 128, AP::in(11) + l * 128, WSP(float, W2_ROPE), (PG8_LAS float*)(L + XCH_OFF)};
            pg8::gemm_phase<pg8::EpiInprojF, pg8::StaticOrder, 0, D, D, 32>(L, g, so, E, tid);
        }
#endif
        xcd_barrier(bar);
        }
        for (int rep = 0; rep < ((MK_DUP == 3 && l == MK_DUP_L) ? 2 : 1); ++rep) {
#if MK_MASK & 8
        {
            att::attn_phase(WSP(bf16_t, W2_QKV), WSP(bf16_t, W2_O), AP::in(9) + (size_t)l * 6 * 465, AP::in(12) + l * 4, AP::in(10) + l * 128, AP::in(11) + l * 128, WSP(float, W2_APART), (unsigned*)(AP::ws() + W2_ACNT) + (size_t)l * 128 * 64, l < NL - 1, (char*)lds, wave_s);
            const int G_ = grid_x(), c2 = G_ == 256 ? (int)blockIdx.x - 128 : (int)blockIdx.x, G2 = G_ == 256 ? 128 : G_;
            if (c2 >= 0) {
                const int tid = make_tid(wave_s);
                quant_rows_sliced_phase<true>(AP::in(19) + (size_t)l * 16384 * D, WSP(unsigned char, W2_UB), WSP(float, W2_SU), 16384, c2, G2, tid);
                quant_rows_sliced_phase<true>(AP::in(20) + (size_t)l * 16384 * D, WSP(unsigned char, W2_VB), WSP(float, W2_SV), 16384, c2, G2, tid);
                if (l + 1 < NL) { __syncthreads(); CONVERT_LAYER(l + 1, c2, G2); }
            }
        }
#endif
        xcd_barrier(bar);
        }
        for (int rep = 0; rep < ((MK_DUP == 4 && l == MK_DUP_L) ? 2 : 1); ++rep) {
#if MK_MASK & 16
        {
            const int tid = make_tid(wave_s);
            if (l == 0) ctx_gemm<0>(WSP(bf16_t, W2_O), WSP(bf16_t, W2_WBR), WSP(bf16_t, W2_G), nullptr, nullptr, WSP(bf16_t, W2_B1), tid);
            pg8::Gemm g{WSP(bf16_t, W2_O), WSP(bf16_t, W2_WBR + (size_t)l * 8 * MiB), };
            pg8::StaticOrder so; so.init(S, D, grid_x(), blockIdx.x);
            pg8::EpiBranchF E{WSP(bf16_t, W2_G), WSP(bf16_t, W2_B1)};
            pg8::gemm_phase<pg8::EpiBranchF, pg8::StaticOrder, 0, D, D, 32>(L, g, so, E, tid);
        }
#endif
        xcd_barrier(bar);
        }
        for (int rep = 0; rep < ((MK_DUP == 5 && l == MK_DUP_L) ? 2 : 1); ++rep) {
#if MK_MASK & 32
        {
            const int tid = make_tid(wave_s);
            float* X = WSP(float, W2_X);
            if (l == 0) ctx_gemm<1>(WSP(bf16_t, W2_B1), WSP(bf16_t, W2_WOUT), nullptr, AP::in(2), WSP(float, W2_MOD) + NMOD + 2 * D, X, tid);
            pg8::Gemm g{WSP(bf16_t, W2_B1), WSP(bf16_t, W2_WOUT + (size_t)l * 8 * MiB), };
            pg8::StaticOrder so; so.init(S, D, grid_x(), blockIdx.x);
            pg8::EpiOutF E{l == 0 ? AP::in(0) : X, l == 0 ? AP::in(2) : X + (size_t)S * D, WSP(float, W2_MOD) + (size_t)l * 2 * NMOD, X};
            pg8::gemm_phase<pg8::EpiOutF, pg8::StaticOrder, 0, D, D, 32>(L, g, so, E, tid);
        }
#endif
        xcd_barrier(bar);
        }
        for (int rep = 0; rep < ((MK_DUP == 6 && l == MK_DUP_L) ? 2 : 1); ++rep) {
#if MK_MASK & 64
        {
            const int tid = make_tid(wave_s);
            float* X = WSP(float, W2_X);
            norm2_q_phase(X, AP::in(7) + l * D, WSP(float, W2_MOD) + (size_t)l * 2 * NMOD, WSP(_Float16, W2_O), WSP(signed char, W2_HS), WSP(float, W2_SV + 512 * 1024), rows, tid);
        }
#endif
        xcd_barrier(bar);
        }
        for (int rep = 0; rep < ((MK_DUP == 7 && l == MK_DUP_L) ? 2 : 1); ++rep) {
#if MK_MASK & 128
        {
            const int tid = make_tid(wave_s);
            if (l == 0) ctx_gemm<2>(WSP(bf16_t, W2_O), WSP(bf16_t, W2_WQS), nullptr, nullptr, nullptr, WSP(bf16_t, W2_QS), tid);
            pg8::Gemm g{WSP(bf16_t, W2_O), WSP(bf16_t, W2_WQS + (size_t)l * 16 * MiB), };
            pg8::StaticOrder so; so.init(S, D, grid_x(), blockIdx.x);
            pg8::EpiQsplitF E{WSP(bf16_t, W2_QS)};
            pg8::gemm_phase<pg8::EpiQsplitF, pg8::StaticOrder, 0, D, D, 32, true>(L, g, so, E, tid);
        }
#endif
        xcd_barrier(bar);
        }
        for (int rep = 0; rep < ((MK_DUP == 8 && l == MK_DUP_L) ? 2 : 1); ++rep) {
#if MK_MASK & 256
        {
            const int tid = make_tid(wave_s);
            peer_select_sort_phase(WSP(bf16_t, W2_QS), WSP(bf16_t, W2_KS) + (size_t)l * 16 * 128 * 256, WSP(int, W2_IDX), WSP(float, W2_GWT), rows, (char*)lds, tid);
        }
#endif
        xcd_barrier(bar);
        }
        for (int rep = 0; rep < ((MK_DUP == 9 && l == NL - 1) ? 2 : 1); ++rep) {
        if (rep) xcd_barrier(bar);
        { const int tid = make_tid(wave_s); if (rep == 0) peer_u_pass<0xFFFFu>(WSP(signed char, W2_HS), WSP(int, W2_IDX), WSP(unsigned char, W2_UB), WSP(int, W2_PART), rows, tid);
#if MK_DUP == 9
          else peer_u_pass<MK_EMASK>(WSP(signed char, W2_HS), WSP(int, W2_IDX), WSP(unsigned char, W2_UB), WSP(int, 847 * MiB), rows, tid);
#endif
        }
        }
        xcd_barrier(bar);
        for (int rep = 0; rep < ((MK_DUP == 10 && l == NL - 1) ? 2 : 1); ++rep) { if (rep) xcd_barrier(bar);
        { const int tid = make_tid(wave_s); peer_coef_pass(WSP(int, W2_PART), WSP(int, W2_IDX), WSP(float, W2_GWT), WSP(float, W2_SU), WSP(float, W2_SV), WSP(float, W2_SV + 512 * 1024), WSP(signed char, W2_COEF), WSP(float, W2_SV + 768 * 1024), rows, tid); }
        }
        xcd_barrier(bar);
        for (int rep = 0; rep < ((MK_DUP == 11 && l == NL - 1) ? 2 : 1); ++rep) { if (rep) xcd_barrier(bar);
        { const int tid = make_tid(wave_s); peer_v_pass(WSP(signed char, W2_COEF), WSP(float, W2_SV + 768 * 1024), WSP(int, W2_IDX), WSP(unsigned char, W2_VB), WSP(bf16_t, W2_HS)  , rows, tid); }
        }
        xcd_barrier(bar);
        for (int rep = 0; rep < ((MK_DUP == 12 && l == NL - 1) ? 2 : 1); ++rep) { if (rep) xcd_barrier(bar);
        { const int tid = make_tid(wave_s);
          if (l < NL - 1) peer_row_pass<false>(WSP(float, W2_X), WSP(bf16_t, W2_HS), WSP(float, W2_MOD) + (size_t)l * 2 * NMOD, AP::in(6) + (l + 1) * D, WSP(float, W2_MOD) + (size_t)(l + 1) * 2 * NMOD, WSP(bf16_t, W2_B1), nullptr, rows, tid);
          else peer_row_pass<true>(WSP(float, W2_X), WSP(bf16_t, W2_HS), WSP(float, W2_MOD) + (size_t)l * 2 * NMOD, AP::in(21), nullptr, nullptr, AP::out(), rows, tid); }
        }
        if (l < NL - 1) xcd_barrier(bar);
    }
#undef WSP
}

extern "C" void kernel_launch(void* const* d_in, const int* in_sizes, int n_in, void* d_out, int out_size, void* d_ws, size_t ws_size, hipStream_t stream) {
    static int grid = 0;
    if (grid == 0) {
        if (n_in != 22 || ws_size < W2_END) { fprintf(stderr, "kernel_launch: bad args n_in %d ws %zu\n", n_in, ws_size); grid = -1; return; }
        int dev = 0, cus = 0;
        if (hipGetDevice(&dev) != hipSuccess || hipDeviceGetAttribute(&cus, hipDeviceAttributeMultiprocessorCount, dev) != hipSuccess) { grid = -1; return; }
        if (hipFuncSetAttribute((const void*)mk_fwd, hipFuncAttributeMaxDynamicSharedMemorySize, LDS_BYTES) != hipSuccess) { grid = -1; return; }
        int per_cu = 0;
        if (hipOccupancyMaxActiveBlocksPerMultiprocessor(&per_cu, (const void*)mk_fwd, 512, LDS_BYTES) != hipSuccess || per_cu < 1) { fprintf(stderr, "kernel_launch: occupancy query says %d\n", per_cu); }
        (void)hipGetLastError();
        grid = cus;
    }
    if (grid < 0) return;
    (void)hipMemsetAsync((char*)d_ws, 0, 1 * MiB, stream);
    FArgs a{};
    for (int i = 0; i < 22; ++i) a.in[i] = (const float*)d_in[i];
    a.out = (float*)d_out; a.ws = (char*)d_ws;
    hipLaunchKernelGGL(mk_fwd, dim3(grid), dim3(512), LDS_BYTES, stream, a);
}
```

```cpp
#include <hip/hip_runtime.h>
#include <stdint.h>
#include <stdio.h>
#ifndef MK_PARTSPLIT
#define MK_PARTSPLIT 0
#endif

constexpr int D = 2048, S = 16384, CT = 256, MT = S + CT, NL = 2;
constexpr int NCOL = 10752, NQKV = 4608, NGATE = 6144, NMOD = 12288;
constexpr int QA = 0, KA = 768, VA = 1536, QB = 2304, KB = 3072, VB = 3328, QC = 3584, KC = 4096, VC = 4352;
constexpr float EPS = 1e-6f;
constexpr float QSCALE = 0.08838834764831845f;

typedef unsigned short bf16_t;
typedef short bf16x8 __attribute__((ext_vector_type(8)));
typedef float f32x4 __attribute__((ext_vector_type(4)));

__device__ __forceinline__ float bf2f(unsigned b) { return __uint_as_float((b & 0xffffu) << 16); }
__device__ __forceinline__ bf16_t f2bf(float f) { unsigned u = __float_as_uint(f); u += 0x7fffu + ((u >> 16) & 1u); return (bf16_t)(u >> 16); }
__device__ __forceinline__ unsigned pk2(float lo, float hi) { return (unsigned)f2bf(lo) | ((unsigned)f2bf(hi) << 16); }
template <int CTRL> __device__ __forceinline__ float dpp_mov_f(float v) { return __builtin_bit_cast(float, __builtin_amdgcn_update_dpp(0, __builtin_bit_cast(int, v), CTRL, 0xF, 0xF, true)); }
__device__ __forceinline__ float swz16_f(float v) { return __builtin_bit_cast(float, __builtin_amdgcn_ds_swizzle(__builtin_bit_cast(int, v), 0x401F)); }
__device__ __forceinline__ float wsum(float v) {
    v += dpp_mov_f<0xB1>(v); v += dpp_mov_f<0x4E>(v); v += dpp_mov_f<0x141>(v); v += dpp_mov_f<0x140>(v); v += swz16_f(v);
    return __builtin_bit_cast(float, __builtin_amdgcn_readlane(__builtin_bit_cast(int, v), 0)) + __builtin_bit_cast(float, __builtin_amdgcn_readlane(__builtin_bit_cast(int, v), 32)); }
__device__ __forceinline__ float wmax(float v) {
    v = fmaxf(v, dpp_mov_f<0xB1>(v)); v = fmaxf(v, dpp_mov_f<0x4E>(v)); v = fmaxf(v, dpp_mov_f<0x141>(v)); v = fmaxf(v, dpp_mov_f<0x140>(v)); v = fmaxf(v, swz16_f(v));
    return fmaxf(__builtin_bit_cast(float, __builtin_amdgcn_readlane(__builtin_bit_cast(int, v), 0)), __builtin_bit_cast(float, __builtin_amdgcn_readlane(__builtin_bit_cast(int, v), 32))); }
__device__ __forceinline__ int shxl_i(int v, int M, int lane) { return __builtin_amdgcn_ds_bpermute((lane ^ M) << 2, v); }
__device__ __forceinline__ float shxl_f(float v, int M, int lane) { return __builtin_bit_cast(float, shxl_i(__builtin_bit_cast(int, v), M, lane)); }
__device__ __forceinline__ float silu_f(float x) { return x / (1.f + __expf(-x)); }
__device__ __forceinline__ float sigmoid_f(float x) { return 1.f / (1.f + __expf(-x)); }
__device__ __forceinline__ float gelu_tanh(float x) { const float u = 0.7978845608028654f * (x + 0.044715f * x * x * x); return 0.5f * x * (1.f + tanhf(u)); }

constexpr size_t MiB = 1u << 20;
__device__ __forceinline__ void wave_argmax(float& v, int& i) {
    for (int o = 32; o >= 1; o >>= 1) { const float ov = __shfl_xor(v, o); const int oi = __shfl_xor(i, o); if (ov > v || (ov == v && oi < i)) { v = ov; i = oi; } }
}
constexpr int ARG_OFF = 156672;
__device__ __forceinline__ int grid_x() { unsigned base = ARG_OFF; asm volatile("" : "+v"(base)); const __attribute__((address_space(3))) unsigned* p = (const __attribute__((address_space(3))) unsigned*)(size_t)base; unsigned v = p[48]; asm volatile("" : "+v"(v)); return (int)__builtin_amdgcn_readfirstlane(v); }

namespace pg8 {
#define PG8_LAS __attribute__((address_space(3)))
typedef unsigned u32x4 __attribute__((ext_vector_type(4)));
constexpr int BM = 256, BK = 64, HALF = 128, HTB = HALF * BK * 2, STAGE_BYTES = 8 * HTB, NXCD = 8, WGM = 8;
__host__ __device__ __forceinline__ int lds_byte(int r, int c) { const int st = (r >> 4) * 2 + (c >> 5), rr = r & 15, cc = c & 31, ob = rr * 64 + cc * 2; return st * 1024 + (ob ^ (((ob >> 9) & 1) << 5)); }
__host__ __device__ __forceinline__ void stage_rc(int b, int& R, int& C) { const int st = b / 1024, sb = b % 1024, swz = sb ^ (((sb >> 9) & 1) << 5); R = (st >> 1) * 16 + swz / 64; C = (st & 1) * 32 + (swz % 64) / 2; }
__host__ __device__ __forceinline__ int perm32(int rho) { const int n = rho >> 4, i = rho & 15; return 8 * (i >> 2) + 4 * n + (i & 3); }
struct Unit { int pm, pn; };
struct Gemm { const bf16_t* A; const bf16_t* Bt; };
struct StaticOrder {
    int nM, nN, nwg, G, c;
    __device__ void init(int M, int N, int G_, int c_) { nM = M / BM; nN = N / BM; nwg = nM * nN; G = G_; c = c_; }
    __device__ bool next(int i, Unit& u) const {
        const long L = (long)i * G + c; if (L >= nwg) return false;
        int wgid = (int)L; { const int q = nwg / NXCD, r = nwg % NXCD, xcd = wgid % NXCD, off = wgid / NXCD; wgid = (xcd < r ? xcd * (q + 1) : r * (q + 1) + (xcd - r) * q) + off; }
        const int nig = WGM * nN, gid = wgid / nig, fm = gid * WGM, gsz = (nM - fm) < WGM ? (nM - fm) : WGM;
        u.pm = fm + ((wgid % nig) % gsz); u.pn = (wgid % nig) / gsz; return true;
    }
};
__device__ __forceinline__ unsigned cvt_pk_bf16(float lo, float hi) { unsigned r; asm volatile("v_cvt_pk_bf16_f32 %0, %1, %2" : "=v"(r) : "v"(lo), "v"(hi)); return r; }
typedef _Float16 f16x8 __attribute__((ext_vector_type(8)));
template <bool F16> __device__ __forceinline__ f32x4 mma16(bf16x8 a, bf16x8 b, f32x4 c) {
    if constexpr (F16) return __builtin_amdgcn_mfma_f32_16x16x32_f16(__builtin_bit_cast(f16x8, a), __builtin_bit_cast(f16x8, b), c, 0, 0, 0);
    else return __builtin_amdgcn_mfma_f32_16x16x32_bf16(a, b, c, 0, 0, 0); }
template <int KMAP> __device__ __forceinline__ size_t koffA(int t) { return KMAP == 0 ? (size_t)t * 128 : (size_t)(t & 31) * 128 + (((t >> 5) == 1) ? 4096 : 0); }
template <int KMAP> __device__ __forceinline__ size_t koffB(int t) { return KMAP == 0 ? (size_t)t * 128 : (size_t)(t & 31) * 128 + (((t >> 5) == 2) ? 4096 : 0); }

template <class Epi, class Sched, int KMAP, int LDA, int LDB, int NT, bool F16 = false>
__device__ __forceinline__ void gemm_phase(PG8_LAS unsigned char* lds, const Gemm g, const Sched& S, const Epi& E, int tid) {
    const int wid = __builtin_amdgcn_readfirstlane(tid >> 6), lane = tid & 63, wr = wid >> 2, wc = wid & 3, fr = lane & 15, fq = lane >> 4;
    constexpr int nt = NT;
    unsigned voffA[2], voffB[2];
#pragma unroll
    for (int i = 0; i < 2; ++i) { int R, C; stage_rc(tid * 16 + i * 8192, R, C); const int Rb = Epi::PERM ? ((R & ~31) + perm32(R & 31)) : R;
        voffA[i] = (unsigned)(R * LDA + C) * 2u; voffB[i] = (unsigned)(Rb * LDB + C) * 2u; }
    constexpr size_t kstep = (size_t)(BK * 2);
    constexpr size_t hstepA = (size_t)HALF * LDA * 2, hstepB = (size_t)HALF * LDB * 2, tstepA = 2 * hstepA, tstepB = 2 * hstepB;
    const unsigned ldsw = (unsigned)wid * 1024u;
    const int aoff = lds_byte(wr * 64 + fr, fq * 8), boff = lds_byte(wc * 32 + fr, fq * 8);
#define PG8_SA(b, h) (((b) * 2 + (h)) * HTB)
#define PG8_SB(b, h) ((4 + (b) * 2 + (h)) * HTB)
#define PG8_STAGE(bufoff, gbase, voff) do { _Pragma("unroll") for (int _i = 0; _i < 2; ++_i) \
        __builtin_amdgcn_global_load_lds((const unsigned*)((const char*)(gbase) + (voff)[_i]), (PG8_LAS unsigned*)(lds + (bufoff) + ldsw + _i * 8192), 16, 0, 0); } while (0)
#define PG8_LDA(dst, b, h) do { _Pragma("unroll") for (int m = 0; m < 4; ++m) _Pragma("unroll") for (int k = 0; k < 2; ++k) dst[m][k] = *(const PG8_LAS bf16x8*)(lds + PG8_SA(b, h) + aoff + m * 2048 + k * 1024); } while (0)
#define PG8_LDB(dst, b, h) do { _Pragma("unroll") for (int n = 0; n < 2; ++n) _Pragma("unroll") for (int k = 0; k < 2; ++k) dst[n][k] = *(const PG8_LAS bf16x8*)(lds + PG8_SB(b, h) + boff + n * 2048 + k * 1024); } while (0)
#define PG8_MMA(ai, bj, At, Bt) do { __builtin_amdgcn_s_setprio(1); _Pragma("unroll") for (int m = 0; m < 4; ++m) _Pragma("unroll") for (int n = 0; n < 2; ++n) _Pragma("unroll") for (int k = 0; k < 2; ++k) \
        acc[ai][bj][m][n] = mma16<F16>(Bt[n][k], At[m][k], acc[ai][bj][m][n]); __builtin_amdgcn_s_setprio(0); } while (0)
#define PG8_WAIT_V(n) asm volatile("s_waitcnt vmcnt(" #n ")" ::: "memory")
#define PG8_WAIT_L(n) asm volatile("s_waitcnt lgkmcnt(" #n ")" ::: "memory")
#define PG8_BAR __builtin_amdgcn_s_barrier()
#define PG8_SCHED __builtin_amdgcn_sched_barrier(0)
    Unit cur, nxt; int ui = 0;
    if (!S.next(0, cur)) return;
    f32x4 acc[2][2][4][2];
#pragma unroll
    for (int a = 0; a < 2; ++a)
#pragma unroll
        for (int b = 0; b < 2; ++b)
#pragma unroll
            for (int m = 0; m < 4; ++m)
#pragma unroll
                for (int n = 0; n < 2; ++n) acc[a][b][m][n] = (f32x4){0.f, 0.f, 0.f, 0.f};
    bf16x8 At[4][2], B0[2][2], B1[2][2];
    const char* cA = (const char*)g.A + (size_t)cur.pm * tstepA; const char* cB = (const char*)g.Bt + (size_t)cur.pn * tstepB;
    PG8_STAGE(PG8_SB(0, 0), cB, voffB); PG8_STAGE(PG8_SB(0, 1), cB + hstepB, voffB); PG8_STAGE(PG8_SA(0, 0), cA, voffA); PG8_STAGE(PG8_SA(0, 1), cA + hstepA, voffA);
    if (wr == 1) PG8_BAR;
    PG8_WAIT_V(2); PG8_BAR;
    PG8_STAGE(PG8_SB(1, 0), cB + kstep, voffB); PG8_STAGE(PG8_SA(1, 0), cA + kstep, voffA); PG8_STAGE(PG8_SB(1, 1), cB + hstepB + kstep, voffB);
    PG8_WAIT_V(6); PG8_BAR;
    for (;;) {
        const bool has_next = S.next(ui + 1, nxt);
        const char* nA = has_next ? (const char*)g.A + (size_t)nxt.pm * tstepA : cA; const char* nB = has_next ? (const char*)g.Bt + (size_t)nxt.pn * tstepB : cB;
        for (int t = 0; t < nt; t += 2) {
            const bool last = (t == nt - 2);
            const char* a1 = cA + koffA<KMAP>(t) + kstep;
            const char* a2 = last ? nA : cA + koffA<KMAP>(t + 2); const char* b2 = last ? nB : cB + koffB<KMAP>(t + 2);
            const char* a3 = a2 + kstep; const char* b3 = b2 + kstep;
            if constexpr (Epi::HAS_MID) { if (t == Epi::MID1 || t == Epi::MID2) E.mid(acc, cur, t, tid); }
            PG8_LDB(B0, 0, 0); PG8_LDB(B1, 0, 1); PG8_SCHED; PG8_LDA(At, 0, 0); PG8_STAGE(PG8_SA(1, 1), a1 + hstepA, voffA);
            PG8_WAIT_V(8); PG8_WAIT_L(0); PG8_BAR; PG8_MMA(0, 0, At, B0); PG8_MMA(0, 1, At, B1); PG8_BAR; PG8_SCHED;
            PG8_LDA(At, 0, 1); PG8_STAGE(PG8_SB(0, 0), b2, voffB); PG8_STAGE(PG8_SB(0, 1), b2 + hstepB, voffB); PG8_STAGE(PG8_SA(0, 0), a2, voffA);
            PG8_WAIT_V(8); PG8_WAIT_L(0); PG8_BAR; PG8_MMA(1, 0, At, B0); PG8_MMA(1, 1, At, B1); PG8_BAR; PG8_SCHED;
            PG8_LDB(B0, 1, 0); PG8_LDB(B1, 1, 1); PG8_SCHED; PG8_LDA(At, 1, 0); PG8_STAGE(PG8_SA(0, 1), a2 + hstepA, voffA);
            PG8_WAIT_V(8); PG8_WAIT_L(0); PG8_BAR; PG8_MMA(0, 0, At, B0); PG8_MMA(0, 1, At, B1); PG8_BAR; PG8_SCHED;
            PG8_LDA(At, 1, 1); PG8_STAGE(PG8_SB(1, 0), b3, voffB); PG8_STAGE(PG8_SB(1, 1), b3 + hstepB, voffB); PG8_STAGE(PG8_SA(1, 0), a3, voffA);
            PG8_WAIT_V(8); PG8_WAIT_L(0); PG8_BAR; PG8_MMA(1, 0, At, B0); PG8_MMA(1, 1, At, B1); PG8_BAR; PG8_SCHED;
        }
        if (wr == 0) PG8_BAR;
        E(acc, cur, tid);
        if (!has_next) break;
#pragma unroll
        for (int a = 0; a < 2; ++a)
#pragma unroll
            for (int b = 0; b < 2; ++b)
#pragma unroll
                for (int m = 0; m < 4; ++m)
#pragma unroll
                    for (int n = 0; n < 2; ++n) acc[a][b][m][n] = (f32x4){0.f, 0.f, 0.f, 0.f};
        cur = nxt; cA = nA; cB = nB; ++ui;
        if (wr == 1) PG8_BAR;
    }
    PG8_WAIT_V(0);
    PG8_BAR;
#undef PG8_SA
#undef PG8_SB
#undef PG8_STAGE
#undef PG8_LDA
#undef PG8_LDB
#undef PG8_MMA
#undef PG8_WAIT_V
#undef PG8_WAIT_L
#undef PG8_BAR
#undef PG8_SCHED
}

typedef const f32x4 (&AccC)[2][2][4][2];
typedef f32x4 (&AccM)[2][2][4][2];
__device__ __forceinline__ u32x4 pack8(f32x4 v0, f32x4 v1) { u32x4 w; w.x = cvt_pk_bf16(v0[0], v0[1]); w.y = cvt_pk_bf16(v0[2], v0[3]); w.z = cvt_pk_bf16(v1[0], v1[1]); w.w = cvt_pk_bf16(v1[2], v1[3]); return w; }
__device__ __forceinline__ f32x4 sig4(f32x4 v) { f32x4 r;
#pragma unroll
    for (int j = 0; j < 4; ++j) r[j] = __builtin_amdgcn_rcpf(1.f + __builtin_amdgcn_exp2f(-1.4426950408889634f * v[j])); return r; }
__device__ __forceinline__ f32x4 unpack_lo4(unsigned a, unsigned b) { return (f32x4){__uint_as_float(a << 16), __uint_as_float(a & 0xffff0000u), __uint_as_float(b << 16), __uint_as_float(b & 0xffff0000u)}; }

struct EpiInprojF {
    static constexpr bool PERM = true, HAS_MID = false;
    bf16_t* QKV; bf16_t* G; const float* qn; const float* kn; const float* rope; PG8_LAS float* xch;
    __device__ __forceinline__ void operator()(AccC acc, const Unit& u, int tid) const {
        const int wid_ = __builtin_amdgcn_readfirstlane(tid >> 6), wr = wid_ >> 2, wc = wid_ & 3, fr = tid & 15, fq = (tid >> 4) & 3;
        const int pn = u.pn, rowb = u.pm * BM + wr * 64 + fr;
        if (pn >= 18) {
#pragma unroll
            for (int ai = 0; ai < 2; ++ai)
#pragma unroll
                for (int m = 0; m < 4; ++m) { bf16_t* rowp = G + (size_t)(rowb + ai * HALF + m * 16) * NGATE + (pn - 18) * BM + wc * 32 + 8 * fq;
#pragma unroll
                    for (int bj = 0; bj < 2; ++bj) *(u32x4*)(rowp + bj * HALF) = pack8(acc[ai][bj][m][0], acc[ai][bj][m][1]); }
            return;
        }
        const bool ropet = (pn >= 9 && pn <= 12) || (pn >= 14 && pn <= 16);
        if (!ropet) {
#pragma unroll
            for (int ai = 0; ai < 2; ++ai)
#pragma unroll
                for (int m = 0; m < 4; ++m) { bf16_t* rowp = QKV + (size_t)(rowb + ai * HALF + m * 16) * NQKV + pn * BM + wc * 32 + 8 * fq;
#pragma unroll
                    for (int bj = 0; bj < 2; ++bj) *(u32x4*)(rowp + bj * HALF) = pack8(acc[ai][bj][m][0], acc[ai][bj][m][1]); }
            return;
        }
        const bool nrm = pn <= 12; const int half = wc & 1;
        float rs[2][4];
        f32x4 gg[2][2];
#pragma unroll
        for (int bj = 0; bj < 2; ++bj)
#pragma unroll
            for (int n = 0; n < 2; ++n) gg[bj][n] = (f32x4){1.f, 1.f, 1.f, 1.f};
#pragma unroll
        for (int ai = 0; ai < 2; ++ai)
#pragma unroll
            for (int m = 0; m < 4; ++m) rs[ai][m] = 1.f;
        if (nrm) {
            const float qsc = (pn <= 11 && u.pm < (S / BM)) ? 0.088388347648318440f * 1.4426950408889634f : 1.f;
            const float* gv = (pn <= 11 ? qn : kn) + 64 * half + 8 * fq;
#pragma unroll
            for (int bj = 0; bj < 2; ++bj)
#pragma unroll
                for (int n = 0; n < 2; ++n) gg[bj][n] = *(const f32x4*)(gv + 32 * bj + 4 * n);
#pragma unroll
            for (int ai = 0; ai < 2; ++ai)
#pragma unroll
                for (int m = 0; m < 4; ++m) { float s = 0.f;
#pragma unroll
                    for (int bj = 0; bj < 2; ++bj)
#pragma unroll
                        for (int n = 0; n < 2; ++n) { const f32x4 x = acc[ai][bj][m][n]; s += (x[0] * x[0] + x[1] * x[1]) + (x[2] * x[2] + x[3] * x[3]); }
                    s += shxl_f(s, 16, tid & 63); s += shxl_f(s, 32, tid & 63);
                    if (fq == 0) xch[(ai * HALF + wr * 64 + m * 16 + fr) * 4 + wc] = s; }
            asm volatile("s_waitcnt lgkmcnt(0)" ::: "memory"); __builtin_amdgcn_s_barrier(); asm volatile("" ::: "memory");
#pragma unroll
            for (int ai = 0; ai < 2; ++ai)
#pragma unroll
                for (int m = 0; m < 4; ++m) { const int rl = ai * HALF + wr * 64 + m * 16 + fr; const float tot = xch[rl * 4 + wc] + xch[rl * 4 + (wc ^ 1)];
                    rs[ai][m] = __builtin_amdgcn_rsqf(tot * (1.f / 128.f) + EPS) * qsc; }
        }
        const bool dorope = u.pm < (S / BM);
#pragma unroll
        for (int ai = 0; ai < 2; ++ai)
#pragma unroll
            for (int m = 0; m < 4; ++m) {
                const int r = rowb + ai * HALF + m * 16;
                const int pos = half == 0 ? ((r >> 6) & 255) : (r & 63);
                const float* rp = rope + (size_t)(pos * 32 + 8 * fq) * 2;
                f32x4 y1[2], y2[2];
#pragma unroll
                for (int n = 0; n < 2; ++n) {
                    f32x4 x1 = acc[ai][0][m][n] * rs[ai][m] * gg[0][n], x2 = acc[ai][1][m][n] * rs[ai][m] * gg[1][n];
                    if (dorope) {
                        const f32x4 cs0 = *(const f32x4*)(rp + 8 * n), cs1 = *(const f32x4*)(rp + 8 * n + 4);
                        const f32x4 cc = {cs0[0], cs0[2], cs1[0], cs1[2]}, sn = {cs0[1], cs0[3], cs1[1], cs1[3]};
                        y1[n] = x1 * cc - x2 * sn; y2[n] = x2 * cc + x1 * sn;
                    } else { y1[n] = x1; y2[n] = x2; }
                }
                bf16_t* rowp = QKV + (size_t)r * NQKV + pn * BM + 64 * wc + 8 * fq;
                *(u32x4*)rowp = pack8(y1[0], y1[1]); *(u32x4*)(rowp + 32) = pack8(y2[0], y2[1]);
            }
    }
};
struct EpiBranchF {
    static constexpr bool PERM = true, HAS_MID = true; static constexpr int MID1 = 12, MID2 = 24;
    const bf16_t* G; bf16_t* MB;
    static __device__ __forceinline__ float ex(float x) { return fminf(__builtin_amdgcn_exp2f(-1.4426950408889634f * x), 1e30f); }
    __device__ __forceinline__ void mid(AccM acc, const Unit& u, int t, int tid) const {
        const int wid_ = __builtin_amdgcn_readfirstlane(tid >> 6), wr = wid_ >> 2, wc = wid_ & 3, fr = tid & 15, fq = (tid >> 4) & 3;
        const int gi = (t == MID1) ? 0 : 1;
        const bf16_t* gb = G + (size_t)(u.pm * BM + wr * 64 + fr) * NGATE + gi * D + u.pn * BM + wc * 32 + 8 * fq;
#pragma unroll
        for (int ai = 0; ai < 2; ++ai)
#pragma unroll
            for (int m = 0; m < 4; ++m) {
#pragma unroll
                for (int bj = 0; bj < 2; ++bj) { const bf16_t* gp = gb + (size_t)(ai * HALF + m * 16) * NGATE + bj * HALF;
                    const u32x4 ga = *(const u32x4*)gp, gc = *(const u32x4*)(gp + D);
                    const f32x4 a0 = unpack_lo4(ga.x, ga.y), a1 = unpack_lo4(ga.z, ga.w), c0 = unpack_lo4(gc.x, gc.y), c1 = unpack_lo4(gc.z, gc.w);
#pragma unroll
                    for (int j = 0; j < 4; ++j) {
                        acc[ai][bj][m][0][j] *= (1.f + ex(c0[j])) * __builtin_amdgcn_rcpf(1.f + ex(a0[j]));
                        acc[ai][bj][m][1][j] *= (1.f + ex(c1[j])) * __builtin_amdgcn_rcpf(1.f + ex(a1[j])); } }
                asm volatile("" ::: "memory");
            }
    }
    __device__ __forceinline__ void operator()(AccC acc, const Unit& u, int tid) const {
        const int wid_ = __builtin_amdgcn_readfirstlane(tid >> 6), wr = wid_ >> 2, wc = wid_ & 3, fr = tid & 15, fq = (tid >> 4) & 3;
        const int rowb = u.pm * BM + wr * 64 + fr, colb = u.pn * BM + wc * 32 + 8 * fq;
#pragma unroll
        for (int ai = 0; ai < 2; ++ai)
#pragma unroll
            for (int m = 0; m < 4; ++m) { const size_t r = (size_t)(rowb + ai * HALF + m * 16);
#pragma unroll
                for (int bj = 0; bj < 2; ++bj) { const u32x4 gc = *(const u32x4*)(G + r * NGATE + 2 * D + colb + bj * HALF);
                    const f32x4 c0 = unpack_lo4(gc.x, gc.y), c1 = unpack_lo4(gc.z, gc.w);
                    *(u32x4*)(MB + r * D + colb + bj * HALF) = pack8(acc[ai][bj][m][0] * sig4(c0), acc[ai][bj][m][1] * sig4(c1)); } }
    }
};
struct EpiOutF {
    static constexpr bool PERM = false, HAS_MID = false;
    const float* blat; const float* bctx; const float* MODl; float* X;
    __device__ __forceinline__ void operator()(AccC acc, const Unit& u, int tid) const {
        const int wid_ = __builtin_amdgcn_readfirstlane(tid >> 6), wr = wid_ >> 2, wc = wid_ & 3, fr = tid & 15, fq = (tid >> 4) & 3;
        const int rowb = u.pm * BM + wr * 64 + fr, colb = u.pn * BM + wc * 32 + 4 * fq; const bool isctx = u.pm >= (S / BM);
        const float* md = MODl + (isctx ? NMOD : 0) + 2 * D + colb;
        f32x4 gv[2][2];
#pragma unroll
        for (int bj = 0; bj < 2; ++bj)
#pragma unroll
            for (int n = 0; n < 2; ++n) gv[bj][n] = *(const f32x4*)(md + bj * HALF + n * 16);
#pragma unroll
        for (int ai = 0; ai < 2; ++ai)
#pragma unroll
            for (int m = 0; m < 4; ++m) { const int r = rowb + ai * HALF + m * 16; const float* bp = (isctx ? bctx + (size_t)(r - S) * D : blat + (size_t)r * D) + colb; float* xp = X + (size_t)r * D + colb;
#pragma unroll
                for (int bj = 0; bj < 2; ++bj)
#pragma unroll
                    for (int n = 0; n < 2; ++n) *(f32x4*)(xp + bj * HALF + n * 16) = *(const f32x4*)(bp + bj * HALF + n * 16) + gv[bj][n] * acc[ai][bj][m][n]; }
    }
};
struct EpiQsplitF {
    static constexpr bool PERM = true, HAS_MID = false;
    bf16_t* QS;
    __device__ __forceinline__ void operator()(AccC acc, const Unit& u, int tid) const {
        const int wid_ = __builtin_amdgcn_readfirstlane(tid >> 6), wr = wid_ >> 2, wc = wid_ & 3, fr = tid & 15, fq = (tid >> 4) & 3;
        const int rowb = u.pm * BM + wr * 64 + fr, colb = u.pn * BM + wc * 32 + 8 * fq;
#pragma unroll
        for (int ai = 0; ai < 2; ++ai)
#pragma unroll
            for (int m = 0; m < 4; ++m) { bf16_t* rp = QS + (size_t)(rowb + ai * HALF + m * 16) * (2 * D) + colb;
#pragma unroll
                for (int bj = 0; bj < 2; ++bj) { const f32x4 v0 = acc[ai][bj][m][0], v1 = acc[ai][bj][m][1]; const u32x4 hi = pack8(v0, v1);
                    const f32x4 h0 = unpack_lo4(hi.x, hi.y), h1 = unpack_lo4(hi.z, hi.w);
                    *(u32x4*)(rp + bj * HALF) = hi; *(u32x4*)(rp + D + bj * HALF) = pack8(v0 - h0, v1 - h1); } }
    }
};
}
template <bool F16 = false>
__device__ __forceinline__ f32x4 ctx_dot(const bf16_t* __restrict__ Ap, const bf16_t* __restrict__ Bp, int nk32) {
    f32x4 acc = {0.f, 0.f, 0.f, 0.f};
#pragma unroll 8
    for (int k = 0; k < nk32; ++k) { const bf16x8 a = *(const bf16x8*)(Ap + 32 * k), b = *(const bf16x8*)(Bp + 32 * k); acc = pg8::mma16<F16>(b, a, acc); }
    return acc;
}
template <int MODE>
__device__ __forceinline__ void ctx_gemm(const bf16_t* __restrict__ A, const bf16_t* __restrict__ Bt, const bf16_t* __restrict__ Gr, const float* __restrict__ base, const float* __restrict__ gvec,
                                         void* __restrict__ outp, int tid) {
    const int wave = tid >> 6, lane = tid & 63, fr = lane & 15, fq = lane >> 4;
    for (int item = blockIdx.x; item < 256; item += grid_x()) {
        const int n0 = (item >> 1) * 16, r0 = S + (item & 1) * 128 + wave * 16, row = r0 + fr, col = n0 + 4 * fq;
        if (MODE == 0) {
            const bf16_t* Ap = A + (size_t)row * D + 8 * fq; const bf16_t* Bp = Bt + (size_t)(n0 + fr) * D + 8 * fq;
            const f32x4 aa = ctx_dot(Ap, Bp, 24), ab = ctx_dot(Ap + 768, Bp + 768, 24), ac = ctx_dot(Ap + 1536, Bp + 1536, 16);
            const bf16_t* gp = Gr + (size_t)row * NGATE + col;
            const uint2 g0 = *(const uint2*)gp, g1 = *(const uint2*)(gp + D), g2 = *(const uint2*)(gp + 2 * D);
            const f32x4 s0 = pg8::sig4(pg8::unpack_lo4(g0.x, g0.y)), s1 = pg8::sig4(pg8::unpack_lo4(g1.x, g1.y)), s2 = pg8::sig4(pg8::unpack_lo4(g2.x, g2.y));
            const f32x4 m = s0 * aa + s1 * ab + s2 * ac;
            uint2 p; p.x = pk2(m[0], m[1]); p.y = pk2(m[2], m[3]); *(uint2*)((bf16_t*)outp + (size_t)row * D + col) = p;
        } else if (MODE == 1) {
            const f32x4 acc = ctx_dot(A + (size_t)row * D + 8 * fq, Bt + (size_t)(n0 + fr) * D + 8 * fq, 64);
            const f32x4 b = *(const f32x4*)(base + (size_t)(row - S) * D + col), g = *(const f32x4*)(gvec + col);
            *(f32x4*)((float*)outp + (size_t)row * D + col) = b + g * acc;
        } else {
            const f32x4 acc = ctx_dot<true>(A + (size_t)row * D + 8 * fq, Bt + (size_t)(n0 + fr) * D + 8 * fq, 64);
            uint2 hi; hi.x = pk2(acc[0], acc[1]); hi.y = pk2(acc[2], acc[3]);
            uint2 lo; lo.x = pk2(acc[0] - bf2f(hi.x), acc[1] - bf2f(hi.x >> 16)); lo.y = pk2(acc[2] - bf2f(hi.y), acc[3] - bf2f(hi.y >> 16));
            bf16_t* qp = (bf16_t*)outp + (size_t)row * (2 * D) + col; *(uint2*)qp = hi; *(uint2*)(qp + D) = lo;
        }
    }
}
#define WAVE_LDS_SYNC() asm volatile("s_waitcnt lgkmcnt(0)" ::: "memory")
__device__ __forceinline__ int winperm(int n) {
    const int pn = n >> 8; if (!((pn >= 9 && pn <= 12) || (pn >= 14 && pn <= 16))) return n;
    const int cl = n & 255, wc = cl >> 6, bj = (cl >> 5) & 1, x = cl & 31; return (n & ~255) + 128 * bj + 32 * wc + x;
}
template <int MODE>
__device__ __forceinline__ void cvt_T_phase(const float* __restrict__ W, int K, int N, bf16_t* __restrict__ WT, int ldt, int koff, float* scr, int tid, int b0, int nb) {
    const int nnb = N / 32, nitems = nnb * (K / 64);
    const int k = tid >> 3, n4 = (tid & 7) * 4, n = tid >> 4, k4 = (tid & 15) * 4;
    for (int it0 = b0; it0 < nitems; it0 += 8 * nb) {
        float4 v[8];
#pragma unroll
        for (int t = 0; t < 8; ++t) { const int it = it0 + t * nb; if (it < nitems) { const int n0 = (it % nnb) * 32, k0 = (it / nnb) * 64; v[t] = *(const float4*)(W + (size_t)(k0 + k) * N + n0 + n4); } }
        __syncthreads();
#pragma unroll
        for (int t = 0; t < 8; ++t) { const int it = it0 + t * nb; if (it < nitems) { float* d = scr + t * (64 * 33) + k * 33 + n4; d[0] = v[t].x; d[1] = v[t].y; d[2] = v[t].z; d[3] = v[t].w; } }
        __syncthreads();
#pragma unroll
        for (int t = 0; t < 8; ++t) { const int it = it0 + t * nb; if (it < nitems) { const int n0 = (it % nnb) * 32, k0 = (it / nnb) * 64; const float* sp = scr + t * (64 * 33);
            const float v0 = sp[(k4 + 0) * 33 + n], v1 = sp[(k4 + 1) * 33 + n], v2 = sp[(k4 + 2) * 33 + n], v3 = sp[(k4 + 3) * 33 + n];
            const int dn = MODE == 1 ? winperm(n0 + n) : n0 + n; bf16_t* dp = WT + (size_t)dn * ldt + koff + k0 + k4;
            uint2 h;
            if (MODE == 3) { typedef _Float16 hf2_ __attribute__((ext_vector_type(2))); hf2_ a_; a_.x = (_Float16)v0; a_.y = (_Float16)v1; hf2_ b_; b_.x = (_Float16)v2; b_.y = (_Float16)v3; h.x = __builtin_bit_cast(unsigned, a_); h.y = __builtin_bit_cast(unsigned, b_); }
            else { h.x = pk2(v0, v1); h.y = pk2(v2, v3); }
            *(uint2*)dp = h;
            if (MODE == 2) { uint2 lo; lo.x = pk2(v0 - bf2f(h.x), v1 - bf2f(h.x >> 16)); lo.y = pk2(v2 - bf2f(h.y), v3 - bf2f(h.y >> 16)); *(uint2*)(dp + K) = lo; } } }
    }
}
__device__ __forceinline__ void cvt_plain_phase(const float* __restrict__ src, bf16_t* __restrict__ dst, size_t n8, int tid) {
    for (size_t i = (size_t)blockIdx.x * 512 + tid; i < n8; i += (size_t)grid_x() * 512) {
        const float4 a = *(const float4*)(src + i * 8), b = *(const float4*)(src + i * 8 + 4);
        uint4 o; o.x = pk2(a.x, a.y); o.y = pk2(a.z, a.w); o.z = pk2(b.x, b.y); o.w = pk2(b.z, b.w); *(uint4*)(dst + i * 8) = o;
    }
}
__device__ __forceinline__ void rope_table_phase(float* __restrict__ rope, int tid) {
    for (int i = blockIdx.x * 512 + tid; i < 256 * 32; i += grid_x() * 512) {
        const int pos = i >> 5, f = i & 31; const float inv = powf(10000.f, -(float)f / 32.f); float sn, cs; sincosf((float)pos * inv, &sn, &cs);
        rope[2 * i] = cs; rope[2 * i + 1] = sn;
    }
}
__device__ __forceinline__ void modvec_phase(const float* __restrict__ c, const float* __restrict__ c_ctx, const float* __restrict__ w_mod, const float* __restrict__ b_mod, float* __restrict__ MOD, int tid, int l, int b0, int nb) {
    const int wave = tid >> 6, lane = tid & 63;
    for (int item = b0 * 8 + wave; item < NMOD / 12; item += nb * 8) {
        const int n0 = item * 12;
        const float* w = w_mod + n0;
        float a0[12], a1[12];
#pragma unroll
        for (int j = 0; j < 12; ++j) { a0[j] = 0.f; a1[j] = 0.f; }
#pragma unroll 4
        for (int i = 0; i < 32; ++i) { const int k = lane + 64 * i; const float s0 = silu_f(c[k]), s1 = silu_f(c_ctx[k]); const float4* wp = (const float4*)(w + (size_t)k * NMOD);
            const float4 w0 = wp[0], w1 = wp[1], w2 = wp[2]; const float wv[12] = {w0.x, w0.y, w0.z, w0.w, w1.x, w1.y, w1.z, w1.w, w2.x, w2.y, w2.z, w2.w};
#pragma unroll
            for (int j = 0; j < 12; ++j) { a0[j] += s0 * wv[j]; a1[j] += s1 * wv[j]; } }
#pragma unroll
        for (int j = 0; j < 12; ++j) { a0[j] = wsum(a0[j]); a1[j] = wsum(a1[j]); }
        if (lane == 0) {
#pragma unroll
            for (int j = 0; j < 12; ++j) { const float b = b_mod[n0 + j]; MOD[n0 + j] = a0[j] + b; MOD[NMOD + n0 + j] = a1[j] + b; } }
    }
}
template <int OUT>
__device__ __forceinline__ void norm_mod_phase(const float* __restrict__ xlat, const float* __restrict__ xctx, const float* __restrict__ gnorm, const float* __restrict__ MODl,
                                               int sh_off, int sc_off, bf16_t* __restrict__ Hb, _Float16* __restrict__ Hf, int rows, int tid) {
    const int wave = tid >> 6, lane = tid & 63, nw = grid_x() * 8;
    for (int row0 = blockIdx.x * 8 + wave; row0 < rows; row0 += 2 * nw) {
        const int row1 = row0 + nw; const bool has1 = row1 < rows;
        const float* xr0 = row0 < S ? xlat + (size_t)row0 * D : xctx + (size_t)(row0 - S) * D;
        const float* xr1 = has1 ? (row1 < S ? xlat + (size_t)row1 * D : xctx + (size_t)(row1 - S) * D) : xr0;
        float4 v0[8], v1[8]; float ss0 = 0.f, ss1 = 0.f;
#pragma unroll
        for (int i = 0; i < 8; ++i) { v0[i] = *(const float4*)(xr0 + 4 * lane + 256 * i); v1[i] = *(const float4*)(xr1 + 4 * lane + 256 * i); }
#pragma unroll
        for (int i = 0; i < 8; ++i) { ss0 += v0[i].x * v0[i].x + v0[i].y * v0[i].y + v0[i].z * v0[i].z + v0[i].w * v0[i].w; ss1 += v1[i].x * v1[i].x + v1[i].y * v1[i].y + v1[i].z * v1[i].z + v1[i].w * v1[i].w; }
        ss0 = wsum(ss0); ss1 = wsum(ss1);
        const float rs0 = rsqrtf(ss0 * (1.f / D) + EPS), rs1 = rsqrtf(ss1 * (1.f / D) + EPS);
        const float* md0 = MODl + (row0 < S ? 0 : NMOD); const float* md1 = MODl + (row1 < S ? 0 : NMOD);
#pragma unroll
        for (int i = 0; i < 8; ++i) {
            const int col = 4 * lane + 256 * i;
            const float4 g = *(const float4*)(gnorm + col);
#pragma unroll
            for (int r = 0; r < 2; ++r) {
                if (r == 1 && !has1) break;
                const int row = r ? row1 : row0; const float* md = r ? md1 : md0; const float rs = r ? rs1 : rs0; const float4 v = r ? v1[i] : v0[i];
                const float4 sh = *(const float4*)(md + sh_off + col), sc = *(const float4*)(md + sc_off + col);
                float4 o;
                o.x = v.x * rs * g.x * (1.f + sc.x) + sh.x; o.y = v.y * rs * g.y * (1.f + sc.y) + sh.y;
                o.z = v.z * rs * g.z * (1.f + sc.z) + sh.z; o.w = v.w * rs * g.w * (1.f + sc.w) + sh.w;
                uint2 p; p.x = pk2(o.x, o.y); p.y = pk2(o.z, o.w);
                if (OUT == 0) *(uint2*)(Hb + (size_t)row * D + col) = p;
                else if (OUT == 2) { typedef _Float16 hf4_ __attribute__((ext_vector_type(4))); hf4_ hv; hv.x = (_Float16)o.x; hv.y = (_Float16)o.y; hv.z = (_Float16)o.z; hv.w = (_Float16)o.w; *(hf4_*)(Hf + (size_t)row * D + col) = hv; }
                else { uint2 q; q.x = pk2(o.x - bf2f(p.x), o.y - bf2f(p.x >> 16)); q.y = pk2(o.z - bf2f(p.y), o.w - bf2f(p.y >> 16));
                    *(uint2*)(Hb + (size_t)row * (2 * D) + col) = p; *(uint2*)(Hb + (size_t)row * (2 * D) + D + col) = q;
                    typedef _Float16 hf4_ __attribute__((ext_vector_type(4))); hf4_ hv; hv.x = (_Float16)o.x; hv.y = (_Float16)o.y; hv.z = (_Float16)o.z; hv.w = (_Float16)o.w; *(hf4_*)(Hf + (size_t)row * D + col) = hv; }
            }
        }
    }
}
__device__ __forceinline__ void norm2_q_phase(const float* __restrict__ X, const float* __restrict__ gnorm, const float* __restrict__ MODl, _Float16* __restrict__ Hf, signed char* __restrict__ Hq,
                                              float* __restrict__ SH, int rows, int tid) {
    const int wave = tid >> 6, lane = tid & 63, nw = grid_x() * 8;
    for (int rowi = blockIdx.x * 8 + wave; rowi < rows; rowi += 2 * nw) {
        int row0 = rowi; asm volatile("" : "+v"(row0) :: "memory");
        const int row1 = row0 + nw; const bool has1 = row1 < rows; const int row1c = has1 ? row1 : row0;
        float4 v0[8], v1[8]; float ss0 = 0.f, ss1 = 0.f;
#pragma unroll
        for (int i = 0; i < 8; ++i) { v0[i] = *(const float4*)(X + (size_t)row0 * D + 4 * lane + 256 * i); v1[i] = *(const float4*)(X + (size_t)row1c * D + 4 * lane + 256 * i); }
#pragma unroll
        for (int i = 0; i < 8; ++i) { ss0 += v0[i].x * v0[i].x + v0[i].y * v0[i].y + v0[i].z * v0[i].z + v0[i].w * v0[i].w; ss1 += v1[i].x * v1[i].x + v1[i].y * v1[i].y + v1[i].z * v1[i].z + v1[i].w * v1[i].w; }
        ss0 = wsum(ss0); ss1 = wsum(ss1);
        const float rs0 = rsqrtf(ss0 * (1.f / D) + EPS), rs1 = rsqrtf(ss1 * (1.f / D) + EPS);
        const float* md0 = MODl + (row0 < S ? 0 : NMOD); const float* md1 = MODl + (row1c < S ? 0 : NMOD);
        float mx0 = 0.f, mx1 = 0.f;
#pragma unroll
        for (int i = 0; i < 8; ++i) {
            const int col = 4 * lane + 256 * i; const float4 g = *(const float4*)(gnorm + col);
            { const float4 sh = *(const float4*)(md0 + 3 * D + col), sc = *(const float4*)(md0 + 4 * D + col); float4 o;
              o.x = v0[i].x * rs0 * g.x * (1.f + sc.x) + sh.x; o.y = v0[i].y * rs0 * g.y * (1.f + sc.y) + sh.y; o.z = v0[i].z * rs0 * g.z * (1.f + sc.z) + sh.z; o.w = v0[i].w * rs0 * g.w * (1.f + sc.w) + sh.w;
              v0[i] = o; mx0 = fmaxf(mx0, fmaxf(fmaxf(fabsf(o.x), fabsf(o.y)), fmaxf(fabsf(o.z), fabsf(o.w)))); }
            { const float4 sh = *(const float4*)(md1 + 3 * D + col), sc = *(const float4*)(md1 + 4 * D + col); float4 o;
              o.x = v1[i].x * rs1 * g.x * (1.f + sc.x) + sh.x; o.y = v1[i].y * rs1 * g.y * (1.f + sc.y) + sh.y; o.z = v1[i].z * rs1 * g.z * (1.f + sc.z) + sh.z; o.w = v1[i].w * rs1 * g.w * (1.f + sc.w) + sh.w;
              v1[i] = o; mx1 = fmaxf(mx1, fmaxf(fmaxf(fabsf(o.x), fabsf(o.y)), fmaxf(fabsf(o.z), fabsf(o.w)))); }
        }
        mx0 = wmax(mx0); mx1 = wmax(mx1);
        const float s0 = mx0 > 0.f ? mx0 * (1.f / 127.f) : 1.f, s1 = mx1 > 0.f ? mx1 * (1.f / 127.f) : 1.f, i0 = 1.f / s0, i1 = 1.f / s1;
        typedef _Float16 hf4_ __attribute__((ext_vector_type(4)));
#pragma unroll
        for (int i = 0; i < 8; ++i) {
            const int col = 4 * lane + 256 * i;
            { hf4_ hv; hv.x = (_Float16)v0[i].x; hv.y = (_Float16)v0[i].y; hv.z = (_Float16)v0[i].z; hv.w = (_Float16)v0[i].w; *(hf4_*)(Hf + (size_t)row0 * D + col) = hv;
              const unsigned b0 = (unsigned)__float2int_rn(v0[i].x * i0) & 255u, b1 = (unsigned)__float2int_rn(v0[i].y * i0) & 255u, b2 = (unsigned)__float2int_rn(v0[i].z * i0) & 255u, b3 = (unsigned)__float2int_rn(v0[i].w * i0) & 255u;
              *(unsigned*)(Hq + (size_t)row0 * D + col) = b0 | (b1 << 8) | (b2 << 16) | (b3 << 24); }
            if (has1) { hf4_ hv; hv.x = (_Float16)v1[i].x; hv.y = (_Float16)v1[i].y; hv.z = (_Float16)v1[i].z; hv.w = (_Float16)v1[i].w; *(hf4_*)(Hf + (size_t)row1 * D + col) = hv;
              const unsigned b0 = (unsigned)__float2int_rn(v1[i].x * i1) & 255u, b1 = (unsigned)__float2int_rn(v1[i].y * i1) & 255u, b2 = (unsigned)__float2int_rn(v1[i].z * i1) & 255u, b3 = (unsigned)__float2int_rn(v1[i].w * i1) & 255u;
              *(unsigned*)(Hq + (size_t)row1 * D + col) = b0 | (b1 << 8) | (b2 << 16) | (b3 << 24); }
        }
        if (lane == 0) { SH[row0] = s0; if (has1) SH[row1] = s1; }
    }
}
namespace att {
using s16x4  = __attribute__((ext_vector_type(4))) short;
using f32x16 = __attribute__((ext_vector_type(16))) float;
using u32x4  = __attribute__((ext_vector_type(4))) unsigned;
constexpr int KVBLK = 64, QBLK = 32, NW = 8, LDQ = NQKV, LDK = NQKV, LDO = D;
constexpr float SCALE = 0.088388347648318440f, THR = 8.f, C2 = SCALE * 1.4426950408889634f;
constexpr size_t SHM_V = KVBLK * 128 * 2, SHM_K = KVBLK * 128 * 2, SHM_ATTN = 2 * SHM_V + 2 * SHM_K + NW * 64 * 4;
constexpr int RPB_OFF = 68 * 1024;
#define KSWZ(row, colB) ((row) * 256 + ((colB) ^ (((row) & 7) << 4)))
#define SBAR() __builtin_amdgcn_sched_barrier(0)
__device__ __forceinline__ int crow(int r, int hi) { return (r & 3) + 8 * (r >> 2) + 4 * hi; }
__device__ __forceinline__ unsigned cvtpk(float lo, float hi) { unsigned r; asm volatile("v_cvt_pk_bf16_f32 %0, %1, %2" : "=v"(r) : "v"(lo), "v"(hi)); return r; }
__device__ __forceinline__ void partialSM(f32x16& p0, f32x16& p1, float& m_reg, float& mn, float& alpha) {
  float pmax = p0[0]; for (int r = 1; r < 16; ++r) pmax = fmaxf(pmax, p0[r]); for (int r = 0; r < 16; ++r) pmax = fmaxf(pmax, p1[r]);
  { auto rr = __builtin_amdgcn_permlane32_swap(__float_as_uint(pmax), __float_as_uint(pmax), false, false);
    pmax = fmaxf(__uint_as_float(rr[0]), __uint_as_float(rr[1])); }
  if (__builtin_expect(__all(pmax - m_reg <= THR / SCALE), 1)) { mn = m_reg; alpha = 1.f; }
  else { mn = fmaxf(m_reg, pmax); alpha = __builtin_amdgcn_exp2f((m_reg - mn) * C2); m_reg = mn; }
  float mnC = -mn * C2;
  for (int r = 0; r < 16; ++r) p0[r] = fmaf(p0[r], C2, mnC); for (int r = 0; r < 16; ++r) p1[r] = fmaf(p1[r], C2, mnC);
  for (int r = 0; r < 16; ++r) p0[r] = __builtin_amdgcn_exp2f(p0[r]);
}
template <bool SHIFT>
__device__ __forceinline__ void partialSM_fixed(f32x16& p0, f32x16& p1, float m_reg, float& mn, float& alpha) {
  mn = m_reg; alpha = 1.f;
  if constexpr (SHIFT) { const float mnC = -m_reg * C2; for (int r = 0; r < 16; ++r) p0[r] += mnC; for (int r = 0; r < 16; ++r) p1[r] += mnC; }
  for (int r = 0; r < 16; ++r) p0[r] = __builtin_amdgcn_exp2f(p0[r]);
}
__device__ __forceinline__ void finishSM(f32x16& p0, f32x16& p1, float alpha, float& l_reg, bf16x8& pa0, bf16x8& pa1, bf16x8& pa2, bf16x8& pa3) {
  for (int r = 0; r < 16; ++r) p1[r] = __builtin_amdgcn_exp2f(p1[r]);
  float ps = 0; for (int r = 0; r < 16; ++r) ps += p0[r]; for (int r = 0; r < 16; ++r) ps += p1[r];
  { auto rr = __builtin_amdgcn_permlane32_swap(__float_as_uint(ps), __float_as_uint(ps), false, false);
    ps = __uint_as_float(rr[0]) + __uint_as_float(rr[1]); }
  l_reg = l_reg * alpha + ps;
#define PK4(P, BASE, OUT) do { unsigned a0 = cvtpk(P[BASE + 0], P[BASE + 1]), a1 = cvtpk(P[BASE + 2], P[BASE + 3]);   \
    unsigned b0 = cvtpk(P[BASE + 4], P[BASE + 5]), b1 = cvtpk(P[BASE + 6], P[BASE + 7]);                              \
    auto r0 = __builtin_amdgcn_permlane32_swap(a0, b0, false, false); auto r1 = __builtin_amdgcn_permlane32_swap(a1, b1, false, false); \
    u32x4 w = {r0[0], r1[0], r0[1], r1[1]}; OUT = *reinterpret_cast<bf16x8*>(&w); } while (0)
  PK4(p0, 0, pa0); PK4(p0, 8, pa1); PK4(p1, 0, pa2); PK4(p1, 8, pa3);
#undef PK4
}
__device__ __forceinline__ void qkt(f32x16& p0, f32x16& p1, const char* Ks, const bf16x8* qr, int r32, int hi) {
  p0 = f32x16{}; p1 = f32x16{};
  for (int d0 = 0; d0 < 8; ++d0) { int cb = (d0 * 16 + hi * 8) * 2;
    bf16x8 b0 = *reinterpret_cast<const bf16x8*>(Ks + KSWZ(r32, cb));
    bf16x8 b1 = *reinterpret_cast<const bf16x8*>(Ks + KSWZ(32 + r32, cb));
    p0 = __builtin_amdgcn_mfma_f32_32x32x16_bf16(b0, qr[d0], p0, 0, 0, 0);
    p1 = __builtin_amdgcn_mfma_f32_32x32x16_bf16(b1, qr[d0], p1, 0, 0, 0); }
}
__device__ __forceinline__ int v_st(int k, int c) { const int kk = (k & ~0xC) | ((k & 4) << 1) | ((k & 8) >> 1); return ((kk >> 3) * 4 + (c >> 5)) * 512 + ((kk & 7) * 32 + (c & 31)) * 2; }
__device__ __forceinline__ int v_rd_base(int lane) { return ((lane & 3) << 3) | (((lane >> 2) & 3) << 6) | (((lane >> 4) & 1) << 5) | (((lane >> 5) & 1) << 8); }
constexpr int v_rd_off(int d0, int ks, int half) { return d0 * 512 + ks * 4096 + half * 2048; }
template <int OFF> __device__ __forceinline__ s16x4 tr_read(int vb) { s16x4 r; asm volatile("ds_read_b64_tr_b16 %0, %1 offset:%2" : "=&v"(r) : "v"(vb), "i"(OFF) : "memory"); return r; }
template <int D0> __device__ __forceinline__ void pv_one(f32x16& od, int vb, bf16x8 pa0, bf16x8 pa1, bf16x8 pa2, bf16x8 pa3) {
  const s16x4 l0 = tr_read<v_rd_off(D0, 0, 0)>(vb), h0 = tr_read<v_rd_off(D0, 0, 1)>(vb), l1 = tr_read<v_rd_off(D0, 1, 0)>(vb), h1 = tr_read<v_rd_off(D0, 1, 1)>(vb);
  const s16x4 l2 = tr_read<v_rd_off(D0, 2, 0)>(vb), h2 = tr_read<v_rd_off(D0, 2, 1)>(vb), l3 = tr_read<v_rd_off(D0, 3, 0)>(vb), h3 = tr_read<v_rd_off(D0, 3, 1)>(vb);
  asm volatile("s_waitcnt lgkmcnt(0)" ::: "memory"); SBAR();
#define PK(L, H) (bf16x8){L[0], L[1], L[2], L[3], H[0], H[1], H[2], H[3]}
  od = __builtin_amdgcn_mfma_f32_32x32x16_bf16(pa0, PK(l0, h0), od, 0, 0, 0);
  od = __builtin_amdgcn_mfma_f32_32x32x16_bf16(pa1, PK(l1, h1), od, 0, 0, 0);
  od = __builtin_amdgcn_mfma_f32_32x32x16_bf16(pa2, PK(l2, h2), od, 0, 0, 0);
  od = __builtin_amdgcn_mfma_f32_32x32x16_bf16(pa3, PK(l3, h3), od, 0, 0, 0);
#undef PK
}
__device__ __forceinline__ void pv_d0(f32x16* o, int vb, bf16x8 pa0, bf16x8 pa1, bf16x8 pa2, bf16x8 pa3) {
  pv_one<0>(o[0], vb, pa0, pa1, pa2, pa3); pv_one<1>(o[1], vb, pa0, pa1, pa2, pa3); pv_one<2>(o[2], vb, pa0, pa1, pa2, pa3); pv_one<3>(o[3], vb, pa0, pa1, pa2, pa3);
}
struct UnitP { int q0, nt, kstart, nlat, r0, hq; float sinkl2, mfix; int j0; float* pmine; const float* pother; unsigned* cnt; };
template <int KIND> __device__ __forceinline__ int krow_of(const UnitP& u, int j) {
  if (KIND == 1) return 64 * (u.j0 + j);
  if (KIND == 3) return S + 64 * j;
  return j < u.nlat ? u.kstart + 64 * j : S + 64 * (j - u.nlat);
}
template <int KIND> __device__ __forceinline__ void apply_mask(f32x16& p0, f32x16& p1, const UnitP& u, int j, int wid, int r32, int hi, const float* rpbs) {
  if (KIND == 2) {
    if (j < u.nlat) {
      const int krow = u.kstart + 64 * j, tw = u.q0 + wid * 32;
      if (!(krow >= tw + 31 - 128 && krow + 63 <= tw + 128)) {
        const int t = tw + r32;
#pragma unroll
        for (int r = 0; r < 16; ++r) { const int d0 = krow + crow(r, hi) - t, d1 = d0 + 32;
          p0[r] = (d0 >= -128 && d0 <= 128) ? p0[r] : -INFINITY; p1[r] = (d1 >= -128 && d1 <= 128) ? p1[r] : -INFINITY; }
      }
    }
  } else if (KIND == 0) {
    if (j < u.nlat) {
      const int kr = u.kstart / 64 + j, qr = u.r0 + (wid >> 1), qc = (wid & 1) * 32 + r32;
      const int rsq = min(max(qr - 4, 0), 248), cs = min(max(qc - 8, 0), 48);
      const bool row_ok = (kr >= rsq) && (kr < rsq + 8);
      const int bidx = min(max(kr - qr + 7, 0), 14) * 31 + 15 - qc;
#pragma unroll
      for (int r = 0; r < 16; ++r) { const int kc0 = crow(r, hi);
        const bool ok0 = row_ok && kc0 >= cs && kc0 < cs + 16;
        const float b0 = rpbs[ok0 ? bidx + kc0 : 0];
        p0[r] = ok0 ? p0[r] + b0 : -INFINITY;
        if ((r & 3) == 3) asm volatile("" ::: "memory"); }
#pragma unroll
      for (int r = 0; r < 16; ++r) { const int kc1 = crow(r, hi) + 32;
        const bool ok1 = row_ok && kc1 >= cs && kc1 < cs + 16;
        const float b1 = rpbs[ok1 ? bidx + kc1 : 0];
        p1[r] = ok1 ? p1[r] + b1 : -INFINITY;
        if ((r & 3) == 3) asm volatile("" ::: "memory"); }
    }
  }
}
template <int KIND, int SDEPTH, bool PART = false, bool SHIFT = false>
__device__ __forceinline__ void attn_unit(const bf16_t* __restrict__ Qb, const bf16_t* __restrict__ Kh, const bf16_t* __restrict__ Vh, bf16_t* __restrict__ Ob, const UnitP u, char* lds, int tid) {
  const int wid = tid >> 6, lane = tid & 63, r32 = lane & 31, hi = lane >> 5;
  char* V_lds = lds; char* K_lds = lds + 2 * SHM_V;
  float* wsf = (float*)(lds + 2 * SHM_V + 2 * SHM_K) + wid * 64; float* li_l = wsf; float* al_l = wsf + 32;
  const float* rpbs = (const float*)(lds + RPB_OFF);
  float m_reg = (KIND == 1) ? u.mfix : -1e30f, l_reg = 0; f32x16 o[4] = {}; bf16x8 qr[8];
#define PSM(P0, P1, MN, AL) do { if constexpr (KIND == 1) partialSM_fixed<SHIFT>(P0, P1, m_reg, MN, AL); else partialSM(P0, P1, m_reg, MN, AL); } while (0)
#define QKT(P0, P1, KS) qkt(P0, P1, KS, qr, r32, hi)
  const bf16_t* Qw = Qb + (long)(wid * QBLK + r32) * LDQ + hi * 8;
#pragma unroll
  for (int d0 = 0; d0 < 8; ++d0) qr[d0] = *reinterpret_cast<const bf16x8*>(Qw + d0 * 16);
  const int sr = tid >> 4, sc = (tid & 15) * 8, vst0 = v_st(sr, sc), vst1 = v_st(32 + sr, sc);
  const int vb0 = (int)(uintptr_t)V_lds + v_rd_base(lane);
  struct { bf16x8 vs0, vs1, ks0, ks1; } sr_[SDEPTH];
  const unsigned goff0 = (unsigned)(sr * LDK + sc) * 2u, goff1 = goff0 + 32u * LDK * 2u;
  const char* Kc = (const char*)Kh; const char* Vc = (const char*)Vh;
#define SLOAD(i, jj) do { const unsigned tb_ = (unsigned)krow_of<KIND>(u, (jj)) * (unsigned)(LDK * 2); const char* kp_ = Kc + tb_; const char* vp_ = Vc + tb_; \
    sr_[i].vs0 = *reinterpret_cast<const bf16x8*>(vp_ + goff0); sr_[i].vs1 = *reinterpret_cast<const bf16x8*>(vp_ + goff1); \
    sr_[i].ks0 = *reinterpret_cast<const bf16x8*>(kp_ + goff0); sr_[i].ks1 = *reinterpret_cast<const bf16x8*>(kp_ + goff1); } while (0)
#define SWRITE(b, i) do { *(bf16x8*)(V_lds + (b) * SHM_V + vst0) = sr_[i].vs0; *(bf16x8*)(V_lds + (b) * SHM_V + vst1) = sr_[i].vs1; int kc = sc * 2;               \
    *(bf16x8*)(K_lds + (b) * SHM_K + KSWZ(sr, kc)) = sr_[i].ks0; *(bf16x8*)(K_lds + (b) * SHM_K + KSWZ(32 + sr, kc)) = sr_[i].ks1; } while (0)
#define SWAIT() do { if constexpr (SDEPTH == 2) asm volatile("s_waitcnt vmcnt(4)" ::: "memory"); else asm volatile("s_waitcnt vmcnt(0)" ::: "memory"); } while (0)
#define RESC(a) do { if (KIND != 1 && __any((a) < 1.f)) { if (hi == 0) al_l[r32] = (a); asm volatile("s_waitcnt lgkmcnt(0)" ::: "memory"); \
    for (int d = 0; d < 4; ++d) for (int r = 0; r < 16; ++r) o[d][r] *= al_l[crow(r, hi)]; } } while (0)
  f32x16 pA0, pA1, pB0, pB1; float mnA, mnB, alA, alB; bf16x8 pa0, pa1, pa2, pa3; const int NT = u.nt;
  constexpr int SE = 0, SO = SDEPTH - 1;
  SLOAD(SE, 0); asm volatile("s_waitcnt vmcnt(0)" ::: "memory"); SWRITE(0, SE); __syncthreads();
  QKT(pA0, pA1, K_lds); apply_mask<KIND>(pA0, pA1, u, 0, wid, r32, hi, rpbs); PSM(pA0, pA1, mnA, alA);
  SLOAD(SO, 1); if constexpr (SDEPTH == 2) { if (2 < NT) SLOAD(SE, 2); }
  SWAIT(); SWRITE(1, SO); __syncthreads();
  for (int j = 1; j + 1 < NT; j += 2) {
    SBAR(); QKT(pB0, pB1, K_lds + SHM_K); apply_mask<KIND>(pB0, pB1, u, j, wid, r32, hi, rpbs);
    finishSM(pA0, pA1, alA, l_reg, pa0, pa1, pa2, pa3); SBAR();
    SLOAD(SO, j + SDEPTH); SBAR();
    pv_d0(o, vb0, pa0, pa1, pa2, pa3); PSM(pB0, pB1, mnB, alB);
    __syncthreads(); SWAIT(); SWRITE(0, SE);
    RESC(alB); __syncthreads();
    SBAR(); QKT(pA0, pA1, K_lds); apply_mask<KIND>(pA0, pA1, u, j + 1, wid, r32, hi, rpbs);
    finishSM(pB0, pB1, alB, l_reg, pa0, pa1, pa2, pa3); SBAR();
    if (SDEPTH == 1 || j + 3 < NT) SLOAD(SE, j + 1 + SDEPTH); SBAR();
    pv_d0(o, vb0 + (int)SHM_V, pa0, pa1, pa2, pa3); PSM(pA0, pA1, mnA, alA);
    __syncthreads(); SWAIT(); SWRITE(1, SO);
    RESC(alA); __syncthreads();
  }
  SBAR(); QKT(pB0, pB1, K_lds + SHM_K); apply_mask<KIND>(pB0, pB1, u, NT - 1, wid, r32, hi, rpbs);
  finishSM(pA0, pA1, alA, l_reg, pa0, pa1, pa2, pa3); SBAR();
  pv_d0(o, vb0, pa0, pa1, pa2, pa3); PSM(pB0, pB1, mnB, alB);
  __syncthreads(); RESC(alB);
  finishSM(pB0, pB1, alB, l_reg, pa0, pa1, pa2, pa3); SBAR();
  pv_d0(o, vb0 + (int)SHM_V, pa0, pa1, pa2, pa3);
  if (KIND >= 2) l_reg += __builtin_amdgcn_exp2f(u.sinkl2 - m_reg * C2);
  if constexpr (PART) {
    unsigned* pm = (unsigned*)u.pmine + (size_t)wid * 64 * 65 + lane;
#pragma unroll
    for (int d = 0; d < 4; ++d)
#pragma unroll
      for (int r = 0; r < 16; ++r) __hip_atomic_store(pm + (d * 16 + r) * 64, __float_as_uint(o[d][r]), __ATOMIC_RELAXED, __HIP_MEMORY_SCOPE_AGENT);
    __hip_atomic_store(pm + 64 * 64, __float_as_uint(l_reg), __ATOMIC_RELAXED, __HIP_MEMORY_SCOPE_AGENT);
    asm volatile("s_waitcnt vmcnt(0)" ::: "memory");
    __syncthreads();
    unsigned* flag = (unsigned*)(lds + 2 * SHM_V + 2 * SHM_K + NW * 64 * 4);
    if (tid == 0) { const unsigned old = __hip_atomic_fetch_add(u.cnt, 1u, __ATOMIC_RELAXED, __HIP_MEMORY_SCOPE_AGENT); *flag = old; }
    __syncthreads();
    if (*flag == 0u) { __syncthreads(); return; }
    const unsigned* po = (const unsigned*)u.pother + (size_t)wid * 64 * 65 + lane;
#pragma unroll
    for (int d = 0; d < 4; ++d)
#pragma unroll
      for (int r = 0; r < 16; ++r) o[d][r] += __uint_as_float(__hip_atomic_load(po + (d * 16 + r) * 64, __ATOMIC_RELAXED, __HIP_MEMORY_SCOPE_AGENT));
    l_reg += __uint_as_float(__hip_atomic_load(po + 64 * 64, __ATOMIC_RELAXED, __HIP_MEMORY_SCOPE_AGENT));
  }
  if (hi == 0) li_l[r32] = l_reg; asm volatile("s_waitcnt lgkmcnt(0)" ::: "memory");
  float rli[16];
#pragma unroll
  for (int r = 0; r < 16; ++r) rli[r] = __builtin_amdgcn_rcpf(li_l[crow(r, hi)]);
  bf16_t* Ow = Ob + (long)(wid * QBLK) * LDO;
#pragma unroll
  for (int r = 0; r < 16; ++r) { const int orow = crow(r, hi);
#pragma unroll
    for (int d0 = 0; d0 < 4; ++d0) Ow[(long)orow * LDO + d0 * 32 + r32] = f2bf(o[d0][r] * rli[r]); }
  __syncthreads();
#undef PSM
#undef SLOAD
#undef SWRITE
#undef SWAIT
#undef RESC
}
#undef KSWZ
#undef SBAR

__device__ __forceinline__ void attn_phase(const bf16_t* __restrict__ QKV, bf16_t* __restrict__ O, const float* __restrict__ rpb, const float* __restrict__ sink, const float* __restrict__ qn, const float* __restrict__ kn, float* __restrict__ pbuf, unsigned* __restrict__ pcnt, bool do_ctx, char* lds, int wave_s) {
  const int G = grid_x(), c = blockIdx.x;
  const bool bal = (G == 256);
  float mfix;
  { unsigned zz_ = 0u; asm volatile("" : "+v"(zz_)); const int lane_ = (int)__builtin_amdgcn_mbcnt_hi(~0u, __builtin_amdgcn_mbcnt_lo(~0u, zz_)); const float gq = wmax(fmaxf(fabsf(qn[lane_]), fabsf(qn[lane_ + 64]))), gk = wmax(fmaxf(fabsf(kn[lane_]), fabsf(kn[lane_ + 64]))); mfix = __builtin_bit_cast(float, __builtin_amdgcn_readfirstlane(__builtin_bit_cast(int, 128.f * gq * gk * 1.03f))); }
  for (int p = c; p < ((bal && MK_PARTSPLIT) ? 256 : 384); p += G) {
    unsigned z_ = 0u; asm volatile("" : "+v"(z_)); int tid = wave_s * 64 + (int)__builtin_amdgcn_mbcnt_hi(~0u, __builtin_amdgcn_mbcnt_lo(~0u, z_)); asm volatile("" : "+v"(tid));
    UnitP u; u.sinkl2 = -INFINITY; u.r0 = 0; u.kstart = 0; u.nlat = 0; u.hq = 0; u.j0 = 0; u.pmine = nullptr; u.pother = nullptr; u.cnt = nullptr; const int qb = p / 6, h = p % 6;
    u.q0 = qb * 256; u.nt = MT / 64; u.mfix = mfix;
    if (__builtin_amdgcn_readfirstlane((int)(mfix * C2 <= 64.f))) attn_unit<1, 2, false, false>(QKV + (size_t)u.q0 * NQKV + QB + h * 128, QKV + KB + (h / 3) * 128, QKV + VB + (h / 3) * 128, O + (size_t)u.q0 * D + 768 + h * 128, u, lds, tid);
    else attn_unit<1, 1, false, true>(QKV + (size_t)u.q0 * NQKV + QB + h * 128, QKV + KB + (h / 3) * 128, QKV + VB + (h / 3) * 128, O + (size_t)u.q0 * D + 768 + h * 128, u, lds, tid);
  }
  if (bal && MK_PARTSPLIT) {
    unsigned z_ = 0u; asm volatile("" : "+v"(z_)); int tid = wave_s * 64 + (int)__builtin_amdgcn_mbcnt_hi(~0u, __builtin_amdgcn_mbcnt_lo(~0u, z_)); asm volatile("" : "+v"(tid));
    constexpr int KSPLIT = 186;
    const int ub = c & 127, half = c >> 7, p = 256 + ub, qb = p / 6, h = p % 6;
    UnitP u; u.sinkl2 = -INFINITY; u.r0 = 0; u.kstart = 0; u.nlat = 0; u.hq = 0; u.q0 = qb * 256; u.mfix = mfix;
    u.j0 = half ? KSPLIT : 0; u.nt = half ? MT / 64 - KSPLIT : KSPLIT;
    u.pmine = pbuf + (size_t)(ub * 2 + half) * (8 * 64 * 65); u.pother = pbuf + (size_t)(ub * 2 + (half ^ 1)) * (8 * 64 * 65); u.cnt = pcnt + 64 * ub;
    attn_unit<1, 2, true, true>(QKV + (size_t)u.q0 * NQKV + QB + h * 128, QKV + KB + (h / 3) * 128, QKV + VB + (h / 3) * 128, O + (size_t)u.q0 * D + 768 + h * 128, u, lds, tid);
  }
  const int c2 = bal ? c - 128 : c, G2 = bal ? 128 : G;
  if (c2 >= 0) {
    for (int p = c2; p < 384; p += G2) {
      unsigned z_ = 0u; asm volatile("" : "+v"(z_)); int tid = wave_s * 64 + (int)__builtin_amdgcn_mbcnt_hi(~0u, __builtin_amdgcn_mbcnt_lo(~0u, z_)); asm volatile("" : "+v"(tid));
      UnitP u; u.sinkl2 = -INFINITY; u.hq = 0; u.mfix = 0.f; u.j0 = 0; u.pmine = nullptr; u.pother = nullptr; u.cnt = nullptr; const int qb = p / 6, h = p % 6;
      u.q0 = qb * 256; u.r0 = qb * 4; const int rstart = min(max(u.r0 - 4, 0), 244); u.kstart = rstart * 64; u.nlat = 12; u.nt = 16;
      { float* rp = (float*)(lds + RPB_OFF); for (int t = tid; t < 465; t += 512) rp[t] = rpb[h * 465 + t] * (1.f / SCALE); }
      __syncthreads();
      attn_unit<0, 1>(QKV + (size_t)u.q0 * NQKV + QA + h * 128, QKV + KA + h * 128, QKV + VA + h * 128, O + (size_t)u.q0 * D + h * 128, u, lds, tid);
    }
    for (int p = c2; p < 256; p += G2) {
      unsigned z_ = 0u; asm volatile("" : "+v"(z_)); int tid = wave_s * 64 + (int)__builtin_amdgcn_mbcnt_hi(~0u, __builtin_amdgcn_mbcnt_lo(~0u, z_)); asm volatile("" : "+v"(tid));
      UnitP u; u.r0 = 0; u.hq = 0; u.mfix = 0.f; u.j0 = 0; u.pmine = nullptr; u.pother = nullptr; u.cnt = nullptr; const int qb = p / 4, h = p % 4;
      u.q0 = qb * 256; u.kstart = max(u.q0 - 128, 0); const int kend = min(u.q0 + 384, S); u.nlat = (kend - u.kstart) / 64; u.nt = u.nlat + 4; u.sinkl2 = sink[h] * 1.4426950408889634f;
      attn_unit<2, 1>(QKV + (size_t)u.q0 * NQKV + QC + h * 128, QKV + KC + (h / 2) * 128, QKV + VC + (h / 2) * 128, O + (size_t)u.q0 * D + 1536 + h * 128, u, lds, tid);
    }
    if (do_ctx) for (int p = c2; p < 16; p += G2) {
      unsigned z_ = 0u; asm volatile("" : "+v"(z_)); int tid = wave_s * 64 + (int)__builtin_amdgcn_mbcnt_hi(~0u, __builtin_amdgcn_mbcnt_lo(~0u, z_)); asm volatile("" : "+v"(tid));
      UnitP u; u.sinkl2 = -INFINITY; u.r0 = 0; u.kstart = 0; u.nlat = 0; u.hq = 0; u.mfix = 0.f; u.j0 = 0; u.pmine = nullptr; u.pother = nullptr; u.cnt = nullptr; u.q0 = S; u.nt = 4;
      int qcol, kcol, vcol, ocol;
      if (p < 6) { qcol = QA + p * 128; kcol = KA + p * 128; vcol = VA + p * 128; ocol = p * 128; }
      else if (p < 12) { const int hh = p - 6; qcol = QB + hh * 128; kcol = KB + (hh / 3) * 128; vcol = VB + (hh / 3) * 128; ocol = 768 + hh * 128; }
      else { const int hh = p - 12; qcol = QC + hh * 128; kcol = KC + (hh / 2) * 128; vcol = VC + (hh / 2) * 128; ocol = 1536 + hh * 128; u.sinkl2 = sink[hh] * 1.4426950408889634f; }
      attn_unit<3, 1>(QKV + (size_t)S * NQKV + qcol, QKV + kcol, QKV + vcol, O + (size_t)S * D + ocol, u, lds, tid);
    }
  }
}
}
__device__ __forceinline__ void peer_select_phase(const bf16_t* __restrict__ QS, const float* __restrict__ keys, int* __restrict__ IDX, float* __restrict__ GWT, int rows, char* lds, int tid) {
    const int wave = tid >> 6, lane = tid & 63;
    float* sq = (float*)lds + wave * 256; float* ss = (float*)(lds + 8192) + wave * 32; int* si = (int*)(lds + 8192 + 1024) + wave * 32;
    for (int item = blockIdx.x * 8 + wave; item < rows * 8; item += grid_x() * 8) {
        const int token = item >> 3, h = item & 7;
        { const bf16_t* qp = QS + (size_t)token * (2 * D) + h * 256 + lane * 4; const uint2 hi = *(const uint2*)qp, lo = *(const uint2*)(qp + D);
          *(float4*)(sq + lane * 4) = make_float4(bf2f(hi.x) + bf2f(lo.x), bf2f(hi.x >> 16) + bf2f(lo.x >> 16), bf2f(hi.y) + bf2f(lo.y), bf2f(hi.y >> 16) + bf2f(lo.y >> 16)); }
        WAVE_LDS_SYNC();
        float sc[2][2];
#pragma unroll
        for (int p = 0; p < 2; ++p)
#pragma unroll
            for (int r = 0; r < 2; ++r) {
                const float4* kp = (const float4*)(keys + ((size_t)((h * 2 + p) * 128 + lane + 64 * r)) * 128);
                float acc = 0.f;
#pragma unroll 8
                for (int d4 = 0; d4 < 32; ++d4) { const float4 kv = kp[d4]; const float4 q = *(const float4*)(sq + p * 128 + d4 * 4); acc += q.x * kv.x + q.y * kv.y + q.z * kv.z + q.w * kv.w; }
                sc[p][r] = acc;
            }
#pragma unroll
        for (int p = 0; p < 2; ++p) {
            float v0 = sc[p][0], v1 = sc[p][1];
            for (int k = 0; k < 16; ++k) {
                float bv; int bi; if (v0 >= v1) { bv = v0; bi = lane; } else { bv = v1; bi = lane + 64; }
                wave_argmax(bv, bi);
                if (lane == 0) { ss[p * 16 + k] = bv; si[p * 16 + k] = bi; }
                if (bi == lane) v0 = -INFINITY; else if (bi == lane + 64) v1 = -INFINITY;
            }
        }
        WAVE_LDS_SYNC();
        float cv[4];
#pragma unroll
        for (int r = 0; r < 4; ++r) { const int ci = lane + 64 * r; cv[r] = ss[ci >> 4] + ss[16 + (ci & 15)]; }
        float my_s = 0.f; int my_i = 0;
        for (int k = 0; k < 16; ++k) {
            float bv = cv[0]; int bi = lane;
#pragma unroll
            for (int r = 1; r < 4; ++r) if (cv[r] > bv) { bv = cv[r]; bi = lane + 64 * r; }
            wave_argmax(bv, bi);
            if (lane == k) { my_s = bv; my_i = bi; }
#pragma unroll
            for (int r = 0; r < 4; ++r) if (bi == lane + 64 * r) cv[r] = -INFINITY;
        }
        const float mx = __shfl(my_s, 0);
        const float e = lane < 16 ? __expf(my_s - mx) : 0.f;
        const float sum = wsum(e);
        if (lane < 16) { IDX[(size_t)token * 128 + h * 16 + lane] = si[my_i >> 4] * 128 + si[16 + (my_i & 15)]; GWT[(size_t)token * 128 + h * 16 + lane] = e / sum; }
        WAVE_LDS_SYNC();
    }
}
__device__ __forceinline__ float gelu_fast(float x) {
    const float u2 = 1.5957691216057308f * (x + 0.044715f * x * x * x);
    return x * (1.f - __builtin_amdgcn_rcpf(1.f + __builtin_amdgcn_exp2f(fminf(1.4426950408889634f * u2, 126.f))));
}
__device__ __forceinline__ void unpack8(const uint4 w, float (&f)[8]) {
    f[0] = __uint_as_float(w.x << 16); f[1] = __uint_as_float(w.x & 0xffff0000u); f[2] = __uint_as_float(w.y << 16); f[3] = __uint_as_float(w.y & 0xffff0000u);
    f[4] = __uint_as_float(w.z << 16); f[5] = __uint_as_float(w.z & 0xffff0000u); f[6] = __uint_as_float(w.w << 16); f[7] = __uint_as_float(w.w & 0xffff0000u);
}
template <bool LAST>
__device__ __forceinline__ void peer_expert_phase(const bf16_t* __restrict__ HS, const int* __restrict__ IDX, const float* __restrict__ GWT, const bf16_t* __restrict__ UB, const bf16_t* __restrict__ VB,
                                                  const float* __restrict__ MODl, float* __restrict__ X, const float* __restrict__ gnext, const float* __restrict__ MODn, bf16_t* __restrict__ Hn,
                                                  float* __restrict__ out, int rows, int tid) {
    const int wave = tid >> 6, lane = tid & 63;
    for (int row = blockIdx.x * 8 + wave; row < rows; row += grid_x() * 8) {
        float h[4][8], acc[4][8];
#pragma unroll
        for (int i = 0; i < 4; ++i) { const bf16_t* hp = HS + (size_t)row * (2 * D) + 8 * lane + 512 * i; float a[8], b[8]; unpack8(*(const uint4*)hp, a); unpack8(*(const uint4*)(hp + D), b);
#pragma unroll
            for (int j = 0; j < 8; ++j) { h[i][j] = a[j] + b[j]; acc[i][j] = 0.f; } }
        const int idx_lo = IDX[(size_t)row * 128 + lane], idx_hi = IDX[(size_t)row * 128 + 64 + lane];
        const float gw_lo = GWT[(size_t)row * 128 + lane], gw_hi = GWT[(size_t)row * 128 + 64 + lane];
        for (int j0 = 0; j0 < 128; j0 += 4) {
            int e[4]; float w[4], d[4];
#pragma unroll
            for (int k = 0; k < 4; ++k) { const int j = j0 + k;
                e[k] = j0 < 64 ? __builtin_amdgcn_readlane(idx_lo, j & 63) : __builtin_amdgcn_readlane(idx_hi, j & 63);
                w[k] = __uint_as_float(j0 < 64 ? __builtin_amdgcn_readlane(__float_as_uint(gw_lo), j & 63) : __builtin_amdgcn_readlane(__float_as_uint(gw_hi), j & 63)); }
            uint4 ur[4][4];
#pragma unroll
            for (int k = 0; k < 4; ++k) { const uint4* up = (const uint4*)(UB + (size_t)e[k] * D) + lane;
#pragma unroll
                for (int i = 0; i < 4; ++i) ur[k][i] = up[64 * i]; }
#pragma unroll
            for (int k = 0; k < 4; ++k) { float s = 0.f;
#pragma unroll
                for (int i = 0; i < 4; ++i) { float f[8]; unpack8(ur[k][i], f);
#pragma unroll
                    for (int j = 0; j < 8; ++j) s += h[i][j] * f[j]; }
                d[k] = s; }
            asm volatile("" : "+v"(d[0]), "+v"(d[1]), "+v"(d[2]), "+v"(d[3]) :: "memory");
            uint4 vr[4][4];
#pragma unroll
            for (int k = 0; k < 4; ++k) { const uint4* vp = (const uint4*)(VB + (size_t)e[k] * D) + lane;
#pragma unroll
                for (int i = 0; i < 4; ++i) vr[k][i] = vp[64 * i]; }
#pragma unroll
            for (int k = 0; k < 4; ++k) d[k] = wsum(d[k]);
#pragma unroll
            for (int k = 0; k < 4; ++k) { const float a = gelu_fast(d[k]) * w[k];
#pragma unroll
                for (int i = 0; i < 4; ++i) { float f[8]; unpack8(vr[k][i], f);
#pragma unroll
                    for (int j = 0; j < 8; ++j) acc[i][j] += a * f[j]; } }
        }
        const float* md = MODl + (row < S ? 0 : NMOD) + 5 * D;
        float xn[4][8]; float ss = 0.f;
#pragma unroll
        for (int i = 0; i < 4; ++i) { const int col = 8 * lane + 512 * i; const float4 g0 = *(const float4*)(md + col), g1 = *(const float4*)(md + col + 4);
            const float4 x0 = *(const float4*)(X + (size_t)row * D + col), x1 = *(const float4*)(X + (size_t)row * D + col + 4);
            xn[i][0] = x0.x + g0.x * acc[i][0]; xn[i][1] = x0.y + g0.y * acc[i][1]; xn[i][2] = x0.z + g0.z * acc[i][2]; xn[i][3] = x0.w + g0.w * acc[i][3];
            xn[i][4] = x1.x + g1.x * acc[i][4]; xn[i][5] = x1.y + g1.y * acc[i][5]; xn[i][6] = x1.z + g1.z * acc[i][6]; xn[i][7] = x1.w + g1.w * acc[i][7];
#pragma unroll
            for (int j = 0; j < 8; ++j) ss += xn[i][j] * xn[i][j];
            if (!LAST) { *(float4*)(X + (size_t)row * D + col) = make_float4(xn[i][0], xn[i][1], xn[i][2], xn[i][3]); *(float4*)(X + (size_t)row * D + col + 4) = make_float4(xn[i][4], xn[i][5], xn[i][6], xn[i][7]); } }
        ss = wsum(ss);
        const float rs = rsqrtf(ss * (1.f / D) + EPS);
        if (LAST) {
#pragma unroll
            for (int i = 0; i < 4; ++i) { const int col = 8 * lane + 512 * i; const float4 g0 = *(const float4*)(gnext + col), g1 = *(const float4*)(gnext + col + 4);
                *(float4*)(out + (size_t)row * D + col) = make_float4(xn[i][0] * rs * g0.x, xn[i][1] * rs * g0.y, xn[i][2] * rs * g0.z, xn[i][3] * rs * g0.w);
                *(float4*)(out + (size_t)row * D + col + 4) = make_float4(xn[i][4] * rs * g1.x, xn[i][5] * rs * g1.y, xn[i][6] * rs * g1.z, xn[i][7] * rs * g1.w); }
        } else {
            const float* mn = MODn + (row < S ? 0 : NMOD);
#pragma unroll
            for (int i = 0; i < 4; ++i) { const int col = 8 * lane + 512 * i; float o[8];
#pragma unroll
                for (int j4 = 0; j4 < 2; ++j4) { const float4 g = *(const float4*)(gnext + col + 4 * j4), sh = *(const float4*)(mn + col + 4 * j4), sc = *(const float4*)(mn + D + col + 4 * j4);
                    o[4 * j4 + 0] = xn[i][4 * j4 + 0] * rs * g.x * (1.f + sc.x) + sh.x; o[4 * j4 + 1] = xn[i][4 * j4 + 1] * rs * g.y * (1.f + sc.y) + sh.y;
                    o[4 * j4 + 2] = xn[i][4 * j4 + 2] * rs * g.z * (1.f + sc.z) + sh.z; o[4 * j4 + 3] = xn[i][4 * j4 + 3] * rs * g.w * (1.f + sc.w) + sh.w; }
                uint4 p; p.x = pk2(o[0], o[1]); p.y = pk2(o[2], o[3]); p.z = pk2(o[4], o[5]); p.w = pk2(o[6], o[7]); *(uint4*)(Hn + (size_t)row * D + col) = p; }
        }
    }
}
__device__ __forceinline__ void quant_rows_phase(const float* __restrict__ src, unsigned char* __restrict__ dst, float* __restrict__ scl, int nrows, int c2, int G2, int tid) {
    const int wave = tid >> 6, lane = tid & 63;
    for (int row = c2 * 8 + wave; row < nrows; row += G2 * 8) {
        const float4* sp = (const float4*)(src + (size_t)row * D) + lane;
        float4 v[8]; float mx = 0.f;
#pragma unroll
        for (int i = 0; i < 8; ++i) { v[i] = sp[64 * i]; mx = fmaxf(mx, fmaxf(fmaxf(fabsf(v[i].x), fabsf(v[i].y)), fmaxf(fabsf(v[i].z), fabsf(v[i].w)))); }
        mx = wmax(mx);
        const float s = mx > 0.f ? mx * (1.f / 127.f) : 1.f, inv = 1.f / s;
#pragma unroll
        for (int i = 0; i < 8; ++i) {
            const unsigned b0 = (unsigned)(__float2int_rn(v[i].x * inv) + 128), b1 = (unsigned)(__float2int_rn(v[i].y * inv) + 128), b2 = (unsigned)(__float2int_rn(v[i].z * inv) + 128), b3 = (unsigned)(__float2int_rn(v[i].w * inv) + 128);
            *(unsigned*)(dst + (size_t)row * D + 4 * lane + 256 * i) = (b0 & 255u) | ((b1 & 255u) << 8) | ((b2 & 255u) << 16) | ((b3 & 255u) << 24);
        }
        if (lane == 0) scl[row] = s;
    }
}
__device__ __forceinline__ void ub16(const uint4 w, float (&f)[16]) {
    f[0] = (float)(w.x & 0xffu); f[1] = (float)((w.x >> 8) & 0xffu); f[2] = (float)((w.x >> 16) & 0xffu); f[3] = (float)(w.x >> 24);
    f[4] = (float)(w.y & 0xffu); f[5] = (float)((w.y >> 8) & 0xffu); f[6] = (float)((w.y >> 16) & 0xffu); f[7] = (float)(w.y >> 24);
    f[8] = (float)(w.z & 0xffu); f[9] = (float)((w.z >> 8) & 0xffu); f[10] = (float)((w.z >> 16) & 0xffu); f[11] = (float)(w.z >> 24);
    f[12] = (float)(w.w & 0xffu); f[13] = (float)((w.w >> 8) & 0xffu); f[14] = (float)((w.w >> 16) & 0xffu); f[15] = (float)(w.w >> 24);
}
template <bool LAST>
__device__ __forceinline__ void peer_expert_q8_phase(const bf16_t* __restrict__ HS, const int* __restrict__ IDX, const float* __restrict__ GWT, const unsigned char* __restrict__ UQ, const unsigned char* __restrict__ VQ,
                                                     const float* __restrict__ SU, const float* __restrict__ SV, const float* __restrict__ MODl, float* __restrict__ X, const float* __restrict__ gnext,
                                                     const float* __restrict__ MODn, bf16_t* __restrict__ Hn, float* __restrict__ out, int rows, int tid) {
    const int wave = tid >> 6, lane = tid & 63;
    for (int row = blockIdx.x * 8 + wave; row < rows; row += grid_x() * 8) {
        float h[2][16], acc[2][16]; float hs = 0.f, accb = 0.f;
#pragma unroll
        for (int i = 0; i < 2; ++i) { const bf16_t* hp = HS + (size_t)row * (2 * D) + 16 * lane + 1024 * i;
#pragma unroll
            for (int c = 0; c < 2; ++c) { float a[8], b[8]; unpack8(*(const uint4*)(hp + 8 * c), a); unpack8(*(const uint4*)(hp + D + 8 * c), b);
#pragma unroll
                for (int j = 0; j < 8; ++j) { h[i][8 * c + j] = a[j] + b[j]; hs += a[j] + b[j]; acc[i][8 * c + j] = 0.f; } } }
        hs = wsum(hs) * 128.f;
        const int idx_lo = IDX[(size_t)row * 128 + lane], idx_hi = IDX[(size_t)row * 128 + 64 + lane];
        const float gw_lo = GWT[(size_t)row * 128 + lane], gw_hi = GWT[(size_t)row * 128 + 64 + lane];
        for (int j0 = 0; j0 < 128; j0 += 8) {
            int e[8]; float w[8], d[8];
#pragma unroll
            for (int k = 0; k < 8; ++k) { const int j = j0 + k;
                e[k] = j0 < 64 ? __builtin_amdgcn_readlane(idx_lo, j & 63) : __builtin_amdgcn_readlane(idx_hi, j & 63);
                w[k] = __uint_as_float(j0 < 64 ? __builtin_amdgcn_readlane(__float_as_uint(gw_lo), j & 63) : __builtin_amdgcn_readlane(__float_as_uint(gw_hi), j & 63)); }
            uint4 ur[8][2];
#pragma unroll
            for (int k = 0; k < 8; ++k) { const uint4* up = (const uint4*)(UQ + (size_t)e[k] * D) + lane; ur[k][0] = up[0]; ur[k][1] = up[64]; }
#pragma unroll
            for (int k = 0; k < 8; ++k) { float s = 0.f;
#pragma unroll
                for (int i = 0; i < 2; ++i) { float f[16]; ub16(ur[k][i], f);
#pragma unroll
                    for (int j = 0; j < 16; ++j) s += h[i][j] * f[j]; }
                d[k] = s; }
            asm volatile("" : "+v"(d[0]), "+v"(d[1]), "+v"(d[2]), "+v"(d[3]), "+v"(d[4]), "+v"(d[5]), "+v"(d[6]), "+v"(d[7]) :: "memory");
            uint4 vr[8][2];
#pragma unroll
            for (int k = 0; k < 8; ++k) { const uint4* vp = (const uint4*)(VQ + (size_t)e[k] * D) + lane; vr[k][0] = vp[0]; vr[k][1] = vp[64]; }
#pragma unroll
            for (int k = 0; k < 8; ++k) d[k] = wsum(d[k]);
#pragma unroll
            for (int k = 0; k < 8; ++k) { const float dd = (d[k] - hs) * SU[e[k]]; const float c = gelu_fast(dd) * w[k] * SV[e[k]]; accb += 128.f * c;
#pragma unroll
                for (int i = 0; i < 2; ++i) { float f[16]; ub16(vr[k][i], f);
#pragma unroll
                    for (int j = 0; j < 16; ++j) acc[i][j] += c * f[j]; } }
        }
        const float* md = MODl + (row < S ? 0 : NMOD) + 5 * D;
        float ss = 0.f;
#pragma unroll
        for (int i = 0; i < 2; ++i)
#pragma unroll
            for (int c4 = 0; c4 < 4; ++c4) { const int col = 16 * lane + 1024 * i + 4 * c4; const float4 g = *(const float4*)(md + col); const float4 x0 = *(const float4*)(X + (size_t)row * D + col);
                float* a = &acc[i][4 * c4];
                a[0] = x0.x + g.x * (a[0] - accb); a[1] = x0.y + g.y * (a[1] - accb); a[2] = x0.z + g.z * (a[2] - accb); a[3] = x0.w + g.w * (a[3] - accb);
                ss += a[0] * a[0] + a[1] * a[1] + a[2] * a[2] + a[3] * a[3];
                if (!LAST) *(float4*)(X + (size_t)row * D + col) = make_float4(a[0], a[1], a[2], a[3]); }
        ss = wsum(ss);
        const float rs = rsqrtf(ss * (1.f / D) + EPS);
        if (LAST) {
#pragma unroll
            for (int i = 0; i < 2; ++i)
#pragma unroll
                for (int c4 = 0; c4 < 4; ++c4) { const int col = 16 * lane + 1024 * i + 4 * c4; const float4 g = *(const float4*)(gnext + col); const float* a = &acc[i][4 * c4];
                    *(float4*)(out + (size_t)row * D + col) = make_float4(a[0] * rs * g.x, a[1] * rs * g.y, a[2] * rs * g.z, a[3] * rs * g.w); }
        } else {
            const float* mn = MODn + (row < S ? 0 : NMOD);
#pragma unroll
            for (int i = 0; i < 2; ++i)
#pragma unroll
                for (int c8 = 0; c8 < 2; ++c8) { const int col = 16 * lane + 1024 * i + 8 * c8; float o[8];
#pragma unroll
                    for (int j4 = 0; j4 < 2; ++j4) { const float4 g = *(const float4*)(gnext + col + 4 * j4), sh = *(const float4*)(mn + col + 4 * j4), sc = *(const float4*)(mn + D + col + 4 * j4); const float* a = &acc[i][8 * c8 + 4 * j4];
                        o[4 * j4 + 0] = a[0] * rs * g.x * (1.f + sc.x) + sh.x; o[4 * j4 + 1] = a[1] * rs * g.y * (1.f + sc.y) + sh.y; o[4 * j4 + 2] = a[2] * rs * g.z * (1.f + sc.z) + sh.z; o[4 * j4 + 3] = a[3] * rs * g.w * (1.f + sc.w) + sh.w; }
                    uint4 p; p.x = pk2(o[0], o[1]); p.y = pk2(o[2], o[3]); p.z = pk2(o[4], o[5]); p.w = pk2(o[6], o[7]); *(uint4*)(Hn + (size_t)row * D + col) = p; }
        }
    }
}
#define XB_TMO      128
#define XB_XCNT(j)  (256  + 64 * (j))
#define XB_XSUB(j)  (1280 + 64 * (j))
#define XB_XGEN(j)  (2304 + 64 * (j))
#define XB_TOP      3328
#define XB_TOPGEN   3392
#define XCD_BAR_WORDS 3456
#define XB_SPIN_CAP (1u << 22)
#define LAS __attribute__((address_space(3)))
__device__ __forceinline__ unsigned xb_ld(unsigned* p)              { return __hip_atomic_load(p, __ATOMIC_RELAXED, __HIP_MEMORY_SCOPE_AGENT); }
__device__ __forceinline__ unsigned xb_add(unsigned* p, unsigned v) { return __hip_atomic_fetch_add(p, v, __ATOMIC_RELAXED, __HIP_MEMORY_SCOPE_AGENT); }
__device__ __forceinline__ unsigned xb_xcc_id() { return (unsigned)__builtin_amdgcn_s_getreg((3 << 11) | 20) & 0xFu; }
#define XB_SPIN(cond, bar) do { unsigned _sp = 0; while (cond) { __builtin_amdgcn_s_sleep(1); \
    if ((++_sp & 255u) == 0u) { if (xb_ld(&(bar)[XB_TMO])) break; if (_sp > XB_SPIN_CAP) { atomicAdd(&(bar)[XB_TMO], 1u); break; } } } } while (0)
struct XcdBarrier { unsigned* bar; unsigned x; volatile LAS unsigned* st; };
__device__ __forceinline__ XcdBarrier xcd_barrier_post(unsigned* bar, volatile LAS unsigned* st) {
    XcdBarrier b; b.bar = bar; b.x = xb_xcc_id(); b.st = st;
    if (threadIdx.x == 0) (void)xb_add(&bar[XB_XCNT(b.x)], 1u);
    return b;
}
__device__ __forceinline__ void xcd_barrier_complete(unsigned* bar, unsigned x, unsigned& nloc, unsigned& nx) {
    const unsigned G = (unsigned)grid_x();
    unsigned sum, cnt, mine, sp = 0u;
    for (;;) {
        sum = 0u; cnt = 0u; mine = 0u;
#pragma unroll
        for (unsigned j = 0; j < 16; ++j) { const unsigned c = xb_ld(&bar[XB_XCNT(j)]); sum += c; cnt += (c > 0u) ? 1u : 0u; mine = (j == x) ? c : mine; }
        if (sum == G) break;
        __builtin_amdgcn_s_sleep(1);
        if ((++sp & 255u) == 0u) { if (xb_ld(&bar[XB_TMO])) break; if (sp > XB_SPIN_CAP) { atomicAdd(&bar[XB_TMO], 1u); break; } }
    }
    nloc = mine > 0u ? mine : 1u; nx = cnt > 0u ? cnt : 1u;
}
__device__ __forceinline__ void xcd_barrier(const XcdBarrier& b) {
    asm volatile("s_waitcnt vmcnt(0)" ::: "memory");
    __syncthreads();
    if (threadIdx.x == 0) {
        unsigned* bar = b.bar; unsigned bx = b.x; asm volatile("" : "+s"(bar), "+s"(bx));
        __builtin_amdgcn_s_waitcnt(0);
        unsigned nloc = b.st[0], nx = b.st[1];
        if (nloc == 0u) { xcd_barrier_complete(bar, bx, nloc, nx); b.st[0] = nloc; b.st[1] = nx; }
        const unsigned old = xb_add(&bar[XB_XSUB(bx)], 1u);
        const unsigned gen = old / nloc;
        if (old + 1u == (gen + 1u) * nloc) {
            __builtin_amdgcn_fence(__ATOMIC_RELEASE, "agent");
            asm volatile("s_waitcnt vmcnt(0)" ::: "memory");
            const unsigned og = xb_add(&bar[XB_TOP], 1u);
            const unsigned tg = og / nx;
            if (og + 1u == (tg + 1u) * nx) xb_add(&bar[XB_TOPGEN], 1u);
            else XB_SPIN(xb_ld(&bar[XB_TOPGEN]) == tg, bar);
            __builtin_amdgcn_fence(__ATOMIC_ACQUIRE, "agent");
            xb_add(&bar[XB_XGEN(bx)], 1u);
            asm volatile("s_waitcnt vmcnt(0)" ::: "memory");
        } else {
            XB_SPIN(xb_ld(&bar[XB_XGEN(bx)]) == gen, bar);
            __builtin_amdgcn_fence(__ATOMIC_ACQUIRE, "agent");
            asm volatile("s_waitcnt vmcnt(0)" ::: "memory");
        }
    }
    __syncthreads();
}

template <bool SIGNED>
__device__ __forceinline__ void quant_rows_sliced_phase(const float* __restrict__ src, unsigned char* __restrict__ dst, float* __restrict__ scl, int nrows, int c2, int G2, int tid) {
    const int wave = tid >> 6, lane = tid & 63;
    for (int row = c2 * 8 + wave; row < nrows; row += G2 * 8) {
        const float4* sp = (const float4*)(src + (size_t)row * D) + lane;
        float4 v[8]; float mx = 0.f;
#pragma unroll
        for (int i = 0; i < 8; ++i) { v[i] = sp[64 * i]; mx = fmaxf(mx, fmaxf(fmaxf(fabsf(v[i].x), fabsf(v[i].y)), fmaxf(fabsf(v[i].z), fabsf(v[i].w)))); }
        mx = wmax(mx);
        const float s = mx > 0.f ? mx * (1.f / 127.f) : 1.f, inv = 1.f / s;
#pragma unroll
        for (int i = 0; i < 8; ++i) {
            constexpr int OFS = SIGNED ? 0 : 128; const unsigned b0 = (unsigned)(__float2int_rn(v[i].x * inv) + OFS), b1 = (unsigned)(__float2int_rn(v[i].y * inv) + OFS), b2 = (unsigned)(__float2int_rn(v[i].z * inv) + OFS), b3 = (unsigned)(__float2int_rn(v[i].w * inv) + OFS);
            const int slice = 2 * i + (lane >> 5), cin = (4 * lane) & 127;
            *(unsigned*)(dst + ((size_t)slice * 16384 + row) * 128 + cin) = (b0 & 255u) | ((b1 & 255u) << 8) | ((b2 & 255u) << 16) | ((b3 & 255u) << 24);
        }
        if (lane == 0) scl[row] = s;
    }
}
struct SliceDeal { int x, nx, r, R; __device__ __forceinline__ void init() {
    unsigned base = ARG_OFF; asm volatile("" : "+v"(base)); const __attribute__((address_space(3))) unsigned* p = (const __attribute__((address_space(3))) unsigned*)(size_t)base;
    unsigned a = p[51], b = p[52], c = p[53], d = p[54]; asm volatile("" : "+v"(a), "+v"(b), "+v"(c), "+v"(d));
    r = (int)__builtin_amdgcn_readfirstlane(a); x = (int)__builtin_amdgcn_readfirstlane(b); nx = (int)__builtin_amdgcn_readfirstlane(c); R = (int)__builtin_amdgcn_readfirstlane(d); } };
typedef _Float16 hf2 __attribute__((ext_vector_type(2)));
typedef unsigned uv4 __attribute__((ext_vector_type(4))); typedef float fv4 __attribute__((ext_vector_type(4)));
typedef __attribute__((address_space(1))) uv4 GU4; typedef __attribute__((address_space(1))) float GF32; typedef __attribute__((address_space(1))) fv4 GF4;
__device__ __forceinline__ uint4 ldg4(const void* p) { const uv4 v = *(const GU4*)p; return make_uint4(v.x, v.y, v.z, v.w); }
__device__ __forceinline__ float4 ldgf4(const void* p) { const fv4 v = *(const GF4*)p; return make_float4(v.x, v.y, v.z, v.w); }
template <int CTRL> __device__ __forceinline__ float dppmov(float v) { return __builtin_bit_cast(float, __builtin_amdgcn_update_dpp(0, __builtin_bit_cast(int, v), CTRL, 0xF, 0xF, true)); }
__device__ __forceinline__ float sum8(float p) { p += dppmov<0xB1>(p); p += dppmov<0x4E>(p); p += dppmov<0x141>(p); return p; }
__device__ __forceinline__ float sum_x8_16_32(float a) { a += dppmov<0x128>(a);
    { auto r = __builtin_amdgcn_permlane16_swap(__builtin_bit_cast(unsigned, a), __builtin_bit_cast(unsigned, a), false, false); a = __builtin_bit_cast(float, r[0]) + __builtin_bit_cast(float, r[1]); }
    { auto r = __builtin_amdgcn_permlane32_swap(__builtin_bit_cast(unsigned, a), __builtin_bit_cast(unsigned, a), false, false); a = __builtin_bit_cast(float, r[0]) + __builtin_bit_cast(float, r[1]); }
    return a; }
struct UItem { int s, row; };
__device__ __forceinline__ UItem u_item(int k, int n, int nrw, const SliceDeal& sd, int wave) { const int kk = k < n ? k : n - 1; UItem it; it.s = sd.x + (kk / nrw) * sd.nx; it.row = sd.r * 8 + wave + (kk % nrw) * sd.R * 8; return it; }
template <unsigned EMASK>
__device__ __forceinline__ void peer_u_pass(const signed char* __restrict__ HQ, const int* __restrict__ IDX, const unsigned char* __restrict__ UQ, int* __restrict__ PART, int rows, int tid) {
    const int wave = __builtin_amdgcn_readfirstlane(tid >> 6), lane = tid & 63, g = lane >> 3, c8 = lane & 7;
    SliceDeal sd; sd.init();
    const int first = sd.r * 8 + wave, stepw = sd.R * 8;
    const int nrw = first < rows ? (rows - first + stepw - 1) / stepw : 0, nsl = sd.x < 16 ? (16 - sd.x + sd.nx - 1) / sd.nx : 0, n = nrw * nsl;
    if (n == 0) return;
    uint4 hrA, hrB, idg; uint4 er[4]; uint4 tA[16], tB[16];
    typedef __attribute__((address_space(3))) uv4 L4;
    const unsigned wl = (unsigned)wave * 512u, wr_id = wl + 16u * (lane & 31), rd_id = wl + 64u * g;
#define U_GLOAD(IT) do { idg = ldg4(IDX + (size_t)(IT).row * 128 + 4 * (lane & 31)); } while (0)
#define U_LDS_E() do { *(L4*)(size_t)wr_id = (uv4){idg.x, idg.y, idg.z, idg.w}; _Pragma("unroll") for (int i_ = 0; i_ < 4; ++i_) { const uv4 v_ = *(const L4*)(size_t)(rd_id + 16u * i_); er[i_] = make_uint4(v_.x, v_.y, v_.z, v_.w); } } while (0)
#define U_LOAD_H(HR, IT) do { HR = ldg4(HQ + (size_t)(IT).row * D + 128 * (IT).s + 16 * c8); } while (0)
#define U_LOAD_T(T, IT) do { const unsigned char* us_ = UQ + (size_t)(IT).s * 16384 * 128 + 16 * c8; _Pragma("unroll") for (int i_ = 0; i_ < 4; ++i_) { \
        T[4 * i_] = ldg4(us_ + (er[i_].x & EMASK) * 128u); T[4 * i_ + 1] = ldg4(us_ + (er[i_].y & EMASK) * 128u); T[4 * i_ + 2] = ldg4(us_ + (er[i_].z & EMASK) * 128u); T[4 * i_ + 3] = ldg4(us_ + (er[i_].w & EMASK) * 128u); } } while (0)
#define U_STEP(HRC, TC, HRN, TN) do { \
        U_LDS_E(); U_GLOAD(itn2); U_LOAD_H(HRN, itn); \
        const unsigned char* us_ = UQ + (size_t)itn.s * 16384 * 128 + 16 * c8; const unsigned e_[16] = {er[0].x, er[0].y, er[0].z, er[0].w, er[1].x, er[1].y, er[1].z, er[1].w, er[2].x, er[2].y, er[2].z, er[2].w, er[3].x, er[3].y, er[3].z, er[3].w}; \
        int keep0_ = 0, keep1_ = 0; \
        _Pragma("unroll") for (int i_ = 0; i_ < 16; ++i_) { \
            TN[i_] = ldg4(us_ + (e_[i_] & EMASK) * 128u); \
            int p_ = __builtin_amdgcn_sdot4((int)TC[i_].x, (int)HRC.x, 0, false); p_ = __builtin_amdgcn_sdot4((int)TC[i_].y, (int)HRC.y, p_, false); \
            p_ = __builtin_amdgcn_sdot4((int)TC[i_].z, (int)HRC.z, p_, false); p_ = __builtin_amdgcn_sdot4((int)TC[i_].w, (int)HRC.w, p_, false); \
            p_ += __builtin_amdgcn_update_dpp(0, p_, 0xB1, 0xF, 0xF, true); p_ += __builtin_amdgcn_update_dpp(0, p_, 0x4E, 0xF, 0xF, true); p_ += __builtin_amdgcn_update_dpp(0, p_, 0x141, 0xF, 0xF, true); \
            if ((i_ & 7) == c8) { if (i_ < 8) keep0_ = p_; else keep1_ = p_; } \
            __builtin_amdgcn_sched_barrier(0); } \
        typedef int i2_ __attribute__((ext_vector_type(2))); \
        *(__attribute__((address_space(1))) i2_*)(PART + ((size_t)itc.s * rows + itc.row) * 128 + 16 * g + 2 * c8) = (i2_){keep0_, keep1_}; \
        __builtin_amdgcn_sched_barrier(0); \
        asm volatile("" :: "v"(idg.x), "v"(HRN.x));     \
        __builtin_amdgcn_sched_barrier(0); \
        itc = itn; itn = itn2; } while (0)
    UItem itc = u_item(0, n, nrw, sd, wave), itn = u_item(1, n, nrw, sd, wave), itn2;
    U_GLOAD(itc); U_LDS_E();
    __builtin_amdgcn_sched_barrier(0);
    U_GLOAD(itn); U_LOAD_H(hrA, itc);
    __builtin_amdgcn_sched_barrier(0);
    U_LOAD_T(tA, itc);
    __builtin_amdgcn_sched_barrier(0);
    { const UItem ita = u_item(2, n, nrw, sd, wave), itb = u_item(3, n, nrw, sd, wave);
      __builtin_amdgcn_sched_barrier(0);
      itn2 = ita; U_STEP(hrA, tA, hrB, tB);
      itn2 = itb; U_STEP(hrB, tB, hrA, tA); }
    for (int k = 2; k < n; k += 2) {
        const UItem ita = u_item(k + 2, n, nrw, sd, wave), itb = u_item(k + 3, n, nrw, sd, wave);
        __builtin_amdgcn_sched_barrier(0);
        itn2 = ita;
        U_STEP(hrA, tA, hrB, tB);
        itn2 = itb;
        U_STEP(hrB, tB, hrA, tA);
    }
#undef U_GLOAD
#undef U_LDS_E
#undef U_LOAD_H
#undef U_LOAD_T
#undef U_STEP
}
__device__ __forceinline__ void peer_coef_pass(const int* __restrict__ PART, const int* __restrict__ IDX, const float* __restrict__ GWT, const float* __restrict__ SU, const float* __restrict__ SV,
                                               const float* __restrict__ SH, signed char* __restrict__ COEFQ, float* __restrict__ CS, int rows, int tid) {
    const int wave = tid >> 6, lane = tid & 63, j0 = 16 * (lane >> 3) + (lane & 7), j1 = j0 + 8;
    for (int row = blockIdx.x * 8 + wave; row < rows; row += grid_x() * 8) {
        const size_t i = (size_t)row * 128;
        int d0 = 0, d1 = 0;
#pragma unroll
        for (int s = 0; s < 16; ++s) { const int2 v = *(const int2*)(PART + (size_t)s * rows * 128 + i + 2 * lane); d0 += v.x; d1 += v.y; }
        const int e0 = IDX[i + j0], e1 = IDX[i + j1]; const float sh = SH[row];
        const float c0 = gelu_fast((float)d0 * SU[e0] * sh) * GWT[i + j0] * SV[e0], c1 = gelu_fast((float)d1 * SU[e1] * sh) * GWT[i + j1] * SV[e1];
        const float mx = wmax(fmaxf(fabsf(c0), fabsf(c1)));
        const float sc = mx > 0.f ? mx * (1.f / 16383.f) : 1.f, inv = 1.f / sc;
        const int q0 = __float2int_rn(c0 * inv), q1 = __float2int_rn(c1 * inv);
        signed char* cq = COEFQ + (size_t)row * 256;
        cq[j0] = (signed char)(q0 >> 7); cq[j1] = (signed char)(q1 >> 7); cq[128 + j0] = (signed char)(q0 & 127); cq[128 + j1] = (signed char)(q1 & 127);
        if (lane == 0) CS[row] = sc;
    }
}
typedef unsigned uv2_ __attribute__((ext_vector_type(2))); typedef int v4i_ __attribute__((ext_vector_type(4)));
__device__ __forceinline__ void peer_v_pass(const signed char* __restrict__ COEFQ, const float* __restrict__ CS, const int* __restrict__ IDX, const unsigned char* __restrict__ VQ, float* __restrict__ F, int rows, int tid) {
    const int wave = __builtin_amdgcn_readfirstlane(tid >> 6), lane = tid & 63, n16 = lane & 15, kg = lane >> 4, rsel = n16 >> 3, c8 = n16 & 7;
    SliceDeal sd; sd.init();
    const int npairs = rows >> 1, first = sd.r * 8 + wave, stepw = sd.R * 8;
    const int nrw = first < npairs ? (npairs - first + stepw - 1) / stepw : 0, nsl = sd.x < 16 ? (16 - sd.x + sd.nx - 1) / sd.nx : 0, n = nrw * nsl;
    if (n == 0) return;
    uint4 rawA[8], rawB[8], ee[2], idg, cfg; uv2_ aq; v4i_ acc[16]; unsigned tr[32];
    const int arow = n16 & 3;
    typedef __attribute__((address_space(3))) uv4 L4; typedef __attribute__((address_space(3))) uv2_ L2_;
    const unsigned wl = (unsigned)wave * 3072u, wr_id = 16u * lane, wr_cf = 1024u + 16u * (lane & 31), rd_id = (unsigned)rsel * 512u + 128u * kg, rd_cf = 1024u + (unsigned)(arow >> 1) * 256u + (unsigned)(arow & 1) * 128u + 32u * kg;
#define V_GLOAD(IT) do { idg = ldg4(IDX + (size_t)(2 * (IT).row) * 128 + 4 * lane); cfg = ldg4(COEFQ + (size_t)(2 * (IT).row) * 256 + 16 * (lane & 31)); } while (0)
#define V_LWRITE(SL) do { *(L4*)(size_t)(wl + (SL) + wr_id) = (uv4){idg.x, idg.y, idg.z, idg.w}; *(L4*)(size_t)(wl + (SL) + wr_cf) = (uv4){cfg.x, cfg.y, cfg.z, cfg.w}; } while (0)
#define V_LREAD(SL_E, Q_E, SL_A, Q_A) do { const uv4 a_ = *(const L4*)(size_t)(wl + (SL_E) + rd_id + 32u * (Q_E)), b_ = *(const L4*)(size_t)(wl + (SL_E) + rd_id + 32u * (Q_E) + 16u); \
        ee[0] = make_uint4(a_.x, a_.y, a_.z, a_.w); ee[1] = make_uint4(b_.x, b_.y, b_.z, b_.w); aq = *(const L2_*)(size_t)(wl + (SL_A) + rd_cf + 8u * (Q_A)); } while (0)
#define V_LOAD_T(RAW, IT) do { const unsigned char* vs_ = VQ + (size_t)(IT).s * 16384 * 128 + 16 * c8; \
        RAW[0] = ldg4(vs_ + ee[0].x * 128u); RAW[1] = ldg4(vs_ + ee[0].y * 128u); RAW[2] = ldg4(vs_ + ee[0].z * 128u); RAW[3] = ldg4(vs_ + ee[0].w * 128u); \
        RAW[4] = ldg4(vs_ + ee[1].x * 128u); RAW[5] = ldg4(vs_ + ee[1].y * 128u); RAW[6] = ldg4(vs_ + ee[1].z * 128u); RAW[7] = ldg4(vs_ + ee[1].w * 128u); } while (0)
#define V_T4(A_, B_, C_, D_, O_) do { const unsigned abl_ = __builtin_amdgcn_perm(B_, A_, 0x05010400u), abh_ = __builtin_amdgcn_perm(B_, A_, 0x07030602u), \
        cdl_ = __builtin_amdgcn_perm(D_, C_, 0x05010400u), cdh_ = __builtin_amdgcn_perm(D_, C_, 0x07030602u); \
        tr[(O_)] = __builtin_amdgcn_perm(cdl_, abl_, 0x05040100u); tr[(O_) + 2] = __builtin_amdgcn_perm(cdl_, abl_, 0x07060302u); \
        tr[(O_) + 4] = __builtin_amdgcn_perm(cdh_, abh_, 0x05040100u); tr[(O_) + 6] = __builtin_amdgcn_perm(cdh_, abh_, 0x07060302u); } while (0)
#define V_TRANS(RAW) do { V_T4(RAW[0].x, RAW[1].x, RAW[2].x, RAW[3].x, 0); V_T4(RAW[4].x, RAW[5].x, RAW[6].x, RAW[7].x, 1); V_T4(RAW[0].y, RAW[1].y, RAW[2].y, RAW[3].y, 8); V_T4(RAW[4].y, RAW[5].y, RAW[6].y, RAW[7].y, 9); \
        V_T4(RAW[0].z, RAW[1].z, RAW[2].z, RAW[3].z, 16); V_T4(RAW[4].z, RAW[5].z, RAW[6].z, RAW[7].z, 17); V_T4(RAW[0].w, RAW[1].w, RAW[2].w, RAW[3].w, 24); V_T4(RAW[4].w, RAW[5].w, RAW[6].w, RAW[7].w, 25); } while (0)
#define V_MMA(FIRST) do { const v4i_ vzero_ = {0, 0, 0, 0}; const uv2_ am_ = n16 < 4 ? aq : (uv2_){0u, 0u}; const long al_ = __builtin_bit_cast(long, am_); \
        _Pragma("unroll") for (int t_ = 0; t_ < 16; ++t_) { const long bl_ = __builtin_bit_cast(long, (uv2_){tr[2 * t_], tr[2 * t_ + 1]}); \
            acc[t_] = __builtin_amdgcn_mfma_i32_16x16x32_i8(al_, bl_, (FIRST) ? vzero_ : acc[t_], 0, 0, 0); } } while (0)
#define V_STEP(RAW, SL_E, Q_E, SL_A, Q_A, IT_T, FIRST) do { \
        V_LREAD(SL_E, Q_E, SL_A, Q_A); \
        V_TRANS(RAW); \
        __builtin_amdgcn_sched_barrier(0); \
        V_LOAD_T(RAW, IT_T); \
        __builtin_amdgcn_sched_barrier(0); \
        V_MMA(FIRST); \
        __builtin_amdgcn_sched_barrier(0); } while (0)
    UItem itc = u_item(0, n, nrw, sd, wave), itn = u_item(1, n, nrw, sd, wave);
    V_GLOAD(itc); V_LWRITE(0u);
    V_LREAD(0u, 0, 0u, 0); V_LOAD_T(rawA, itc);
    __builtin_amdgcn_sched_barrier(0);
    V_LREAD(0u, 1, 0u, 1); V_LOAD_T(rawB, itc);
    __builtin_amdgcn_sched_barrier(0);
    unsigned cur = 0u;
    for (int k = 0; k < n; ++k) {
        const unsigned nxt = 1536u - cur;
        V_GLOAD(itn);
        __builtin_amdgcn_sched_barrier(0);
        V_STEP(rawA, cur, 2, cur, 0, itc, true);
        V_STEP(rawB, cur, 3, cur, 1, itc, false);
        V_LWRITE(nxt);
        __builtin_amdgcn_sched_barrier(0);
        V_STEP(rawA, nxt, 0, cur, 2, itn, false);
        V_STEP(rawB, nxt, 1, cur, 3, itn, false);
        {
            typedef __attribute__((address_space(3))) fv4 LF4;
            const unsigned fs_ = 24576u + (unsigned)wave * 1024u;
            if (kg == 0) { const float cs_ = CS[2 * itc.row + rsel];
#pragma unroll
                for (int q4 = 0; q4 < 4; ++q4) { fv4 o_;
#pragma unroll
                    for (int tt = 0; tt < 4; ++tt) { const v4i_ a_ = acc[4 * q4 + tt]; const int hv_ = rsel ? a_.z : a_.x, lv_ = rsel ? a_.w : a_.y; o_[tt] = (float)(hv_ * 128 + lv_) * cs_; }
                    *(LF4*)(size_t)(fs_ + (unsigned)n16 * 64u + 16u * q4) = o_; } }
            const fv4 w_ = *(const LF4*)(size_t)(fs_ + 16u * lane);
            *(GF4*)(F + (size_t)(2 * itc.row + (lane >> 5)) * D + 128 * itc.s + 4 * (lane & 31)) = w_;
        }
        __builtin_amdgcn_sched_barrier(0);
        itc = itn; itn = u_item(k + 2, n, nrw, sd, wave); cur = nxt;
    }
#undef V_GLOAD
#undef V_LWRITE
#undef V_LREAD
#undef V_LOAD_T
#undef V_T4
#undef V_TRANS
#undef V_MMA
#undef V_STEP
}
template <bool LAST>
__device__ __forceinline__ void peer_row_pass(float* __restrict__ X, const float* __restrict__ F, const float* __restrict__ MODl, const float* __restrict__ gnext, const float* __restrict__ MODn,
                                              bf16_t* __restrict__ Hn, float* __restrict__ out, int rows, int tid) {
    const int wave = tid >> 6, lane = tid & 63;
    for (int row = blockIdx.x * 8 + wave; row < rows; row += grid_x() * 8) {
        const float* md = MODl + (row < S ? 0 : NMOD) + 5 * D;
        float4 v[8]; float ss = 0.f;
#pragma unroll
        for (int i = 0; i < 8; ++i) { const int col = 4 * lane + 256 * i; const float4 x = *(const float4*)(X + (size_t)row * D + col), f = *(const float4*)(F + (size_t)row * D + col), g2 = *(const float4*)(md + col);
            v[i] = make_float4(x.x + g2.x * f.x, x.y + g2.y * f.y, x.z + g2.z * f.z, x.w + g2.w * f.w);
            ss += v[i].x * v[i].x + v[i].y * v[i].y + v[i].z * v[i].z + v[i].w * v[i].w;
            if (!LAST) *(float4*)(X + (size_t)row * D + col) = v[i]; }
        ss = wsum(ss);
        const float rs = rsqrtf(ss * (1.f / D) + EPS);
        const float* mn = LAST ? nullptr : MODn + (row < S ? 0 : NMOD);
#pragma unroll
        for (int i = 0; i < 8; ++i) { const int col = 4 * lane + 256 * i; const float4 g = *(const float4*)(gnext + col);
            if (LAST) *(float4*)(out + (size_t)row * D + col) = make_float4(v[i].x * rs * g.x, v[i].y * rs * g.y, v[i].z * rs * g.z, v[i].w * rs * g.w);
            else { const float4 sh = *(const float4*)(mn + col), sc = *(const float4*)(mn + D + col);
                uint2 p; p.x = pk2(v[i].x * rs * g.x * (1.f + sc.x) + sh.x, v[i].y * rs * g.y * (1.f + sc.y) + sh.y); p.y = pk2(v[i].z * rs * g.z * (1.f + sc.z) + sh.z, v[i].w * rs * g.w * (1.f + sc.w) + sh.w);
                *(uint2*)(Hn + (size_t)row * D + col) = p; } }
    }
}
__device__ __forceinline__ void keys_split_phase(const float* __restrict__ keys, bf16_t* __restrict__ KS, int n_rows, int tid) {
    for (int i = blockIdx.x * 512 + tid; i < n_rows * 32; i += grid_x() * 512) {
        const int row = i >> 5, c4 = (i & 31) * 4; const float4 v = *(const float4*)(keys + (size_t)row * 128 + c4);
        uint2 h; h.x = pk2(v.x, v.y); h.y = pk2(v.z, v.w);
        uint2 lo; lo.x = pk2(v.x - bf2f(h.x), v.y - bf2f(h.x >> 16)); lo.y = pk2(v.z - bf2f(h.y), v.w - bf2f(h.y >> 16));
        *(uint2*)(KS + (size_t)row * 256 + c4) = h; *(uint2*)(KS + (size_t)row * 256 + 128 + c4) = lo;
    }
}
#define SORT16_DESC(K) do { \
    { const unsigned hi_ = max(K[0], K[1]), lo_ = min(K[0], K[1]); K[0] = hi_; K[1] = lo_; } \
    { const unsigned hi_ = max(K[3], K[2]), lo_ = min(K[3], K[2]); K[3] = hi_; K[2] = lo_; } \
    { const unsigned hi_ = max(K[4], K[5]), lo_ = min(K[4], K[5]); K[4] = hi_; K[5] = lo_; } \
    { const unsigned hi_ = max(K[7], K[6]), lo_ = min(K[7], K[6]); K[7] = hi_; K[6] = lo_; } \
    { const unsigned hi_ = max(K[8], K[9]), lo_ = min(K[8], K[9]); K[8] = hi_; K[9] = lo_; } \
    { const unsigned hi_ = max(K[11], K[10]), lo_ = min(K[11], K[10]); K[11] = hi_; K[10] = lo_; } \
    { const unsigned hi_ = max(K[12], K[13]), lo_ = min(K[12], K[13]); K[12] = hi_; K[13] = lo_; } \
    { const unsigned hi_ = max(K[15], K[14]), lo_ = min(K[15], K[14]); K[15] = hi_; K[14] = lo_; } \
    { const unsigned hi_ = max(K[0], K[2]), lo_ = min(K[0], K[2]); K[0] = hi_; K[2] = lo_; } \
    { const unsigned hi_ = max(K[1], K[3]), lo_ = min(K[1], K[3]); K[1] = hi_; K[3] = lo_; } \
    { const unsigned hi_ = max(K[6], K[4]), lo_ = min(K[6], K[4]); K[6] = hi_; K[4] = lo_; } \
    { const unsigned hi_ = max(K[7], K[5]), lo_ = min(K[7], K[5]); K[7] = hi_; K[5] = lo_; } \
    { const unsigned hi_ = max(K[8], K[10]), lo_ = min(K[8], K[10]); K[8] = hi_; K[10] = lo_; } \
    { const unsigned hi_ = max(K[9], K[11]), lo_ = min(K[9], K[11]); K[9] = hi_; K[11] = lo_; } \
    { const unsigned hi_ = max(K[14], K[12]), lo_ = min(K[14], K[12]); K[14] = hi_; K[12] = lo_; } \
    { const unsigned hi_ = max(K[15], K[13]), lo_ = min(K[15], K[13]); K[15] = hi_; K[13] = lo_; } \
    { const unsigned hi_ = max(K[0], K[1]), lo_ = min(K[0], K[1]); K[0] = hi_; K[1] = lo_; } \
    { const unsigned hi_ = max(K[2], K[3]), lo_ = min(K[2], K[3]); K[2] = hi_; K[3] = lo_; } \
    { const unsigned hi_ = max(K[5], K[4]), lo_ = min(K[5], K[4]); K[5] = hi_; K[4] = lo_; } \
    { const unsigned hi_ = max(K[7], K[6]), lo_ = min(K[7], K[6]); K[7] = hi_; K[6] = lo_; } \
    { const unsigned hi_ = max(K[8], K[9]), lo_ = min(K[8], K[9]); K[8] = hi_; K[9] = lo_; } \
    { const unsigned hi_ = max(K[10], K[11]), lo_ = min(K[10], K[11]); K[10] = hi_; K[11] = lo_; } \
    { const unsigned hi_ = max(K[13], K[12]), lo_ = min(K[13], K[12]); K[13] = hi_; K[12] = lo_; } \
    { const unsigned hi_ = max(K[15], K[14]), lo_ = min(K[15], K[14]); K[15] = hi_; K[14] = lo_; } \
    { const unsigned hi_ = max(K[0], K[4]), lo_ = min(K[0], K[4]); K[0] = hi_; K[4] = lo_; } \
    { const unsigned hi_ = max(K[1], K[5]), lo_ = min(K[1], K[5]); K[1] = hi_; K[5] = lo_; } \
    { const unsigned hi_ = max(K[2], K[6]), lo_ = min(K[2], K[6]); K[2] = hi_; K[6] = lo_; } \
    { const unsigned hi_ = max(K[3], K[7]), lo_ = min(K[3], K[7]); K[3] = hi_; K[7] = lo_; } \
    { const unsigned hi_ = max(K[12], K[8]), lo_ = min(K[12], K[8]); K[12] = hi_; K[8] = lo_; } \
    { const unsigned hi_ = max(K[13], K[9]), lo_ = min(K[13], K[9]); K[13] = hi_; K[9] = lo_; } \
    { const unsigned hi_ = max(K[14], K[10]), lo_ = min(K[14], K[10]); K[14] = hi_; K[10] = lo_; } \
    { const unsigned hi_ = max(K[15], K[11]), lo_ = min(K[15], K[11]); K[15] = hi_; K[11] = lo_; } \
    { const unsigned hi_ = max(K[0], K[2]), lo_ = min(K[0], K[2]); K[0] = hi_; K[2] = lo_; } \
    { const unsigned hi_ = max(K[1], K[3]), lo_ = min(K[1], K[3]); K[1] = hi_; K[3] = lo_; } \
    { const unsigned hi_ = max(K[4], K[6]), lo_ = min(K[4], K[6]); K[4] = hi_; K[6] = lo_; } \
    { const unsigned hi_ = max(K[5], K[7]), lo_ = min(K[5], K[7]); K[5] = hi_; K[7] = lo_; } \
    { const unsigned hi_ = max(K[10], K[8]), lo_ = min(K[10], K[8]); K[10] = hi_; K[8] = lo_; } \
    { const unsigned hi_ = max(K[11], K[9]), lo_ = min(K[11], K[9]); K[11] = hi_; K[9] = lo_; } \
    { const unsigned hi_ = max(K[14], K[12]), lo_ = min(K[14], K[12]); K[14] = hi_; K[12] = lo_; } \
    { const unsigned hi_ = max(K[15], K[13]), lo_ = min(K[15], K[13]); K[15] = hi_; K[13] = lo_; } \
    { const unsigned hi_ = max(K[0], K[1]), lo_ = min(K[0], K[1]); K[0] = hi_; K[1] = lo_; } \
    { const unsigned hi_ = max(K[2], K[3]), lo_ = min(K[2], K[3]); K[2] = hi_; K[3] = lo_; } \
    { const unsigned hi_ = max(K[4], K[5]), lo_ = min(K[4], K[5]); K[4] = hi_; K[5] = lo_; } \
    { const unsigned hi_ = max(K[6], K[7]), lo_ = min(K[6], K[7]); K[6] = hi_; K[7] = lo_; } \
    { const unsigned hi_ = max(K[9], K[8]), lo_ = min(K[9], K[8]); K[9] = hi_; K[8] = lo_; } \
    { const unsigned hi_ = max(K[11], K[10]), lo_ = min(K[11], K[10]); K[11] = hi_; K[10] = lo_; } \
    { const unsigned hi_ = max(K[13], K[12]), lo_ = min(K[13], K[12]); K[13] = hi_; K[12] = lo_; } \
    { const unsigned hi_ = max(K[15], K[14]), lo_ = min(K[15], K[14]); K[15] = hi_; K[14] = lo_; } \
    { const unsigned hi_ = max(K[0], K[8]), lo_ = min(K[0], K[8]); K[0] = hi_; K[8] = lo_; } \
    { const unsigned hi_ = max(K[1], K[9]), lo_ = min(K[1], K[9]); K[1] = hi_; K[9] = lo_; } \
    { const unsigned hi_ = max(K[2], K[10]), lo_ = min(K[2], K[10]); K[2] = hi_; K[10] = lo_; } \
    { const unsigned hi_ = max(K[3], K[11]), lo_ = min(K[3], K[11]); K[3] = hi_; K[11] = lo_; } \
    { const unsigned hi_ = max(K[4], K[12]), lo_ = min(K[4], K[12]); K[4] = hi_; K[12] = lo_; } \
    { const unsigned hi_ = max(K[5], K[13]), lo_ = min(K[5], K[13]); K[5] = hi_; K[13] = lo_; } \
    { const unsigned hi_ = max(K[6], K[14]), lo_ = min(K[6], K[14]); K[6] = hi_; K[14] = lo_; } \
    { const unsigned hi_ = max(K[7], K[15]), lo_ = min(K[7], K[15]); K[7] = hi_; K[15] = lo_; } \
    { const unsigned hi_ = max(K[0], K[4]), lo_ = min(K[0], K[4]); K[0] = hi_; K[4] = lo_; } \
    { const unsigned hi_ = max(K[1], K[5]), lo_ = min(K[1], K[5]); K[1] = hi_; K[5] = lo_; } \
    { const unsigned hi_ = max(K[2], K[6]), lo_ = min(K[2], K[6]); K[2] = hi_; K[6] = lo_; } \
    { const unsigned hi_ = max(K[3], K[7]), lo_ = min(K[3], K[7]); K[3] = hi_; K[7] = lo_; } \
    { const unsigned hi_ = max(K[8], K[12]), lo_ = min(K[8], K[12]); K[8] = hi_; K[12] = lo_; } \
    { const unsigned hi_ = max(K[9], K[13]), lo_ = min(K[9], K[13]); K[9] = hi_; K[13] = lo_; } \
    { const unsigned hi_ = max(K[10], K[14]), lo_ = min(K[10], K[14]); K[10] = hi_; K[14] = lo_; } \
    { const unsigned hi_ = max(K[11], K[15]), lo_ = min(K[11], K[15]); K[11] = hi_; K[15] = lo_; } \
    { const unsigned hi_ = max(K[0], K[2]), lo_ = min(K[0], K[2]); K[0] = hi_; K[2] = lo_; } \
    { const unsigned hi_ = max(K[1], K[3]), lo_ = min(K[1], K[3]); K[1] = hi_; K[3] = lo_; } \
    { const unsigned hi_ = max(K[4], K[6]), lo_ = min(K[4], K[6]); K[4] = hi_; K[6] = lo_; } \
    { const unsigned hi_ = max(K[5], K[7]), lo_ = min(K[5], K[7]); K[5] = hi_; K[7] = lo_; } \
    { const unsigned hi_ = max(K[8], K[10]), lo_ = min(K[8], K[10]); K[8] = hi_; K[10] = lo_; } \
    { const unsigned hi_ = max(K[9], K[11]), lo_ = min(K[9], K[11]); K[9] = hi_; K[11] = lo_; } \
    { const unsigned hi_ = max(K[12], K[14]), lo_ = min(K[12], K[14]); K[12] = hi_; K[14] = lo_; } \
    { const unsigned hi_ = max(K[13], K[15]), lo_ = min(K[13], K[15]); K[13] = hi_; K[15] = lo_; } \
    { const unsigned hi_ = max(K[0], K[1]), lo_ = min(K[0], K[1]); K[0] = hi_; K[1] = lo_; } \
    { const unsigned hi_ = max(K[2], K[3]), lo_ = min(K[2], K[3]); K[2] = hi_; K[3] = lo_; } \
    { const unsigned hi_ = max(K[4], K[5]), lo_ = min(K[4], K[5]); K[4] = hi_; K[5] = lo_; } \
    { const unsigned hi_ = max(K[6], K[7]), lo_ = min(K[6], K[7]); K[6] = hi_; K[7] = lo_; } \
    { const unsigned hi_ = max(K[8], K[9]), lo_ = min(K[8], K[9]); K[8] = hi_; K[9] = lo_; } \
    { const unsigned hi_ = max(K[10], K[11]), lo_ = min(K[10], K[11]); K[10] = hi_; K[11] = lo_; } \
    { const unsigned hi_ = max(K[12], K[13]), lo_ = min(K[12], K[13]); K[12] = hi_; K[13] = lo_; } \
    { const unsigned hi_ = max(K[14], K[15]), lo_ = min(K[14], K[15]); K[14] = hi_; K[15] = lo_; } \
} while (0)
#define MERGE16_DESC(K) do { \
    { const unsigned hi_ = max(K[0], K[8]), lo_ = min(K[0], K[8]); K[0] = hi_; K[8] = lo_; } \
    { const unsigned hi_ = max(K[1], K[9]), lo_ = min(K[1], K[9]); K[1] = hi_; K[9] = lo_; } \
    { const unsigned hi_ = max(K[2], K[10]), lo_ = min(K[2], K[10]); K[2] = hi_; K[10] = lo_; } \
    { const unsigned hi_ = max(K[3], K[11]), lo_ = min(K[3], K[11]); K[3] = hi_; K[11] = lo_; } \
    { const unsigned hi_ = max(K[4], K[12]), lo_ = min(K[4], K[12]); K[4] = hi_; K[12] = lo_; } \
    { const unsigned hi_ = max(K[5], K[13]), lo_ = min(K[5], K[13]); K[5] = hi_; K[13] = lo_; } \
    { const unsigned hi_ = max(K[6], K[14]), lo_ = min(K[6], K[14]); K[6] = hi_; K[14] = lo_; } \
    { const unsigned hi_ = max(K[7], K[15]), lo_ = min(K[7], K[15]); K[7] = hi_; K[15] = lo_; } \
    { const unsigned hi_ = max(K[0], K[4]), lo_ = min(K[0], K[4]); K[0] = hi_; K[4] = lo_; } \
    { const unsigned hi_ = max(K[1], K[5]), lo_ = min(K[1], K[5]); K[1] = hi_; K[5] = lo_; } \
    { const unsigned hi_ = max(K[2], K[6]), lo_ = min(K[2], K[6]); K[2] = hi_; K[6] = lo_; } \
    { const unsigned hi_ = max(K[3], K[7]), lo_ = min(K[3], K[7]); K[3] = hi_; K[7] = lo_; } \
    { const unsigned hi_ = max(K[8], K[12]), lo_ = min(K[8], K[12]); K[8] = hi_; K[12] = lo_; } \
    { const unsigned hi_ = max(K[9], K[13]), lo_ = min(K[9], K[13]); K[9] = hi_; K[13] = lo_; } \
    { const unsigned hi_ = max(K[10], K[14]), lo_ = min(K[10], K[14]); K[10] = hi_; K[14] = lo_; } \
    { const unsigned hi_ = max(K[11], K[15]), lo_ = min(K[11], K[15]); K[11] = hi_; K[15] = lo_; } \
    { const unsigned hi_ = max(K[0], K[2]), lo_ = min(K[0], K[2]); K[0] = hi_; K[2] = lo_; } \
    { const unsigned hi_ = max(K[1], K[3]), lo_ = min(K[1], K[3]); K[1] = hi_; K[3] = lo_; } \
    { const unsigned hi_ = max(K[4], K[6]), lo_ = min(K[4], K[6]); K[4] = hi_; K[6] = lo_; } \
    { const unsigned hi_ = max(K[5], K[7]), lo_ = min(K[5], K[7]); K[5] = hi_; K[7] = lo_; } \
    { const unsigned hi_ = max(K[8], K[10]), lo_ = min(K[8], K[10]); K[8] = hi_; K[10] = lo_; } \
    { const unsigned hi_ = max(K[9], K[11]), lo_ = min(K[9], K[11]); K[9] = hi_; K[11] = lo_; } \
    { const unsigned hi_ = max(K[12], K[14]), lo_ = min(K[12], K[14]); K[12] = hi_; K[14] = lo_; } \
    { const unsigned hi_ = max(K[13], K[15]), lo_ = min(K[13], K[15]); K[13] = hi_; K[15] = lo_; } \
    { const unsigned hi_ = max(K[0], K[1]), lo_ = min(K[0], K[1]); K[0] = hi_; K[1] = lo_; } \
    { const unsigned hi_ = max(K[2], K[3]), lo_ = min(K[2], K[3]); K[2] = hi_; K[3] = lo_; } \
    { const unsigned hi_ = max(K[4], K[5]), lo_ = min(K[4], K[5]); K[4] = hi_; K[5] = lo_; } \
    { const unsigned hi_ = max(K[6], K[7]), lo_ = min(K[6], K[7]); K[6] = hi_; K[7] = lo_; } \
    { const unsigned hi_ = max(K[8], K[9]), lo_ = min(K[8], K[9]); K[8] = hi_; K[9] = lo_; } \
    { const unsigned hi_ = max(K[10], K[11]), lo_ = min(K[10], K[11]); K[10] = hi_; K[11] = lo_; } \
    { const unsigned hi_ = max(K[12], K[13]), lo_ = min(K[12], K[13]); K[12] = hi_; K[13] = lo_; } \
    { const unsigned hi_ = max(K[14], K[15]), lo_ = min(K[14], K[15]); K[14] = hi_; K[15] = lo_; } \
} while (0)

__device__ __forceinline__ unsigned enc_key(float f, unsigned tag, unsigned mask) { unsigned u = __float_as_uint(f); u = (u & 0x80000000u) ? ~u : (u | 0x80000000u); return (u & mask) | tag; }
__device__ __forceinline__ float dec_key(unsigned k, unsigned mask) { unsigned u = k & mask; u = (u & 0x80000000u) ? (u & 0x7fffffffu) : ~u; return __uint_as_float(u); }
__device__ __forceinline__ unsigned sel4(int q, unsigned a, unsigned b, unsigned c, unsigned d) { const unsigned lo = (q & 1) ? b : a, hi = (q & 1) ? d : c; return (q & 2) ? hi : lo; }
template <int XM> __device__ __forceinline__ void xmerge16(unsigned (&K)[16], int lane) {
    unsigned o[16];
#pragma unroll
    for (int i = 0; i < 16; ++i) o[i] = (unsigned)shxl_i((int)K[15 - i], XM, lane);
#pragma unroll
    for (int i = 0; i < 16; ++i) K[i] = max(K[i], o[i]);
    MERGE16_DESC(K);
}
constexpr int SEL_KROW = 528;
constexpr int SEL_TAB = 256 * SEL_KROW;
__device__ __forceinline__ void peer_select_sort_phase(const bf16_t* __restrict__ QS, const bf16_t* __restrict__ KS, int* __restrict__ IDX, float* __restrict__ GWT, int rows, char* lds, int tid) {
    const int wave = tid >> 6, lane = tid & 63, n = lane & 15, q = lane >> 4;
    const int G = grid_x(), ngroups = rows / 16;
    const bool byhead = (G % 8) == 0;
    int* li = (int*)(lds + SEL_TAB + wave * 2048);
    for (int h = byhead ? (int)(blockIdx.x & 7) : 0; h < 8; h += byhead ? 8 : 1) {
        __syncthreads();
        for (int c = tid; c < 256 * 32; c += 512) { const int r = c >> 5, ch = c & 31;
            *(uint4*)(lds + r * SEL_KROW + ch * 16) = *(const uint4*)((const char*)KS + ((size_t)(h * 256 + r)) * 512 + ch * 16); }
        __syncthreads();
        const int rank = byhead ? (int)(blockIdx.x >> 3) : (int)blockIdx.x, nrank = byhead ? G / 8 : G;
        for (int grp = rank * 8 + wave; grp < ngroups; grp += nrank * 8) {
            const int token = grp * 16 + n;
            unsigned t12[2][16];
#pragma unroll
            for (int p = 0; p < 2; ++p) {
                bf16x8 qh[4], ql[4];
                const bf16_t* qp = QS + (size_t)token * (2 * D) + h * 256 + p * 128 + 8 * q;
#pragma unroll
                for (int ks = 0; ks < 4; ++ks) { qh[ks] = *(const bf16x8*)(qp + 32 * ks); ql[ks] = *(const bf16x8*)(qp + D + 32 * ks); }
                unsigned ka[16], kb[16];
                const char* kbase = lds + (p * 128 + n) * SEL_KROW + 16 * q;
#pragma unroll
                for (int g = 0; g < 8; ++g) { f32x4 acc = {0.f, 0.f, 0.f, 0.f};
#pragma unroll
                    for (int ks = 0; ks < 4; ++ks) { const bf16x8 kh = *(const bf16x8*)(kbase + 16 * g * SEL_KROW + 64 * ks), kl = *(const bf16x8*)(kbase + 16 * g * SEL_KROW + 256 + 64 * ks);
                        acc = __builtin_amdgcn_mfma_f32_16x16x32_bf16(kh, qh[ks], acc, 0, 0, 0);
                        acc = __builtin_amdgcn_mfma_f32_16x16x32_bf16(kh, ql[ks], acc, 0, 0, 0);
                        acc = __builtin_amdgcn_mfma_f32_16x16x32_bf16(kl, qh[ks], acc, 0, 0, 0); }
#pragma unroll
                    for (int j = 0; j < 4; ++j) { const unsigned k = enc_key(acc[j], (unsigned)(127 - (16 * g + 4 * q + j)), 0xFFFFFF80u); if (g < 4) ka[4 * g + j] = k; else kb[4 * (g - 4) + j] = k; } }
                SORT16_DESC(ka); SORT16_DESC(kb);
#pragma unroll
                for (int i = 0; i < 16; ++i) ka[i] = max(ka[i], kb[15 - i]);
                MERGE16_DESC(ka);
                xmerge16<16>(ka, lane); xmerge16<32>(ka, lane);
#pragma unroll
                for (int i = 0; i < 16; ++i) t12[p][i] = ka[i];
            }
#pragma unroll
            for (int p = 0; p < 2; ++p)
#pragma unroll
                for (int j = 0; j < 4; ++j) li[n * 32 + p * 16 + 4 * q + j] = 127 - (int)(sel4(q, t12[p][j], t12[p][4 + j], t12[p][8 + j], t12[p][12 + j]) & 127u);
            unsigned ck[16];
#pragma unroll
            for (int t = 0; t < 16; ++t) {
                if (t >= 13) { ck[t] = 0u; continue; }
                unsigned sa[4], sb[4];
#pragma unroll
                for (int qq = 0; qq < 4; ++qq) { const int c = qq + 4 * t; int a_, b_;
                    if (c < 16) { a_ = 0; b_ = c; } else if (c < 24) { a_ = 1; b_ = c - 16; } else if (c < 29) { a_ = 2; b_ = c - 24; } else if (c < 33) { a_ = 3; b_ = c - 29; }
                    else if (c < 36) { a_ = 4; b_ = c - 33; } else if (c < 42) { a_ = 5 + ((c - 36) >> 1); b_ = (c - 36) & 1; } else if (c < 50) { a_ = 8 + (c - 42); b_ = 0; } else { a_ = 0; b_ = 0; }
                    sa[qq] = t12[0][a_]; sb[qq] = t12[1][b_]; }
                const int c = q + 4 * t;
                const float sum = dec_key(sel4(q, sa[0], sa[1], sa[2], sa[3]), 0xFFFFFF80u) + dec_key(sel4(q, sb[0], sb[1], sb[2], sb[3]), 0xFFFFFF80u);
                ck[t] = c < 50 ? enc_key(sum, (unsigned)(63 - c), 0xFFFFFFC0u) : 0u;
            }
            SORT16_DESC(ck); xmerge16<16>(ck, lane); xmerge16<32>(ck, lane);
            const float top0 = dec_key(ck[0], 0xFFFFFFC0u);
            float e[4], es = 0.f; int oi[4];
            WAVE_LDS_SYNC();
#pragma unroll
            for (int j = 0; j < 4; ++j) {
                const unsigned kw = sel4(q, ck[j], ck[4 + j], ck[8 + j], ck[12 + j]);
                e[j] = __expf(dec_key(kw, 0xFFFFFFC0u) - top0); es += e[j];
                const int c = 63 - (int)(kw & 63u); int a_, b_;
                if (c < 16) { a_ = 0; b_ = c; } else if (c < 24) { a_ = 1; b_ = c - 16; } else if (c < 29) { a_ = 2; b_ = c - 24; } else if (c < 33) { a_ = 3; b_ = c - 29; }
                else if (c < 36) { a_ = 4; b_ = c - 33; } else if (c < 42) { a_ = 5 + ((c - 36) >> 1); b_ = (c - 36) & 1; } else { a_ = 8 + (c - 42); b_ = 0; }
                oi[j] = li[n * 32 + a_] * 128 + li[n * 32 + 16 + b_];
            }
            es += shxl_f(es, 16, lane); es += shxl_f(es, 32, lane);
            const float inv = 1.f / es;
            *(int4*)(IDX + (size_t)token * 128 + h * 16 + 4 * q) = make_int4(oi[0], oi[1], oi[2], oi[3]);
            *(float4*)(GWT + (size_t)token * 128 + h * 16 + 4 * q) = make_float4(e[0] * inv, e[1] * inv, e[2] * inv, e[3] * inv);
            WAVE_LDS_SYNC();
        }
    }
    __syncthreads();
}
constexpr int LDS_BYTES = 163840, XCH_OFF = 131072, XBW_OFF = 155648;
constexpr size_t W2_BAR = 65536, W2_RANK = 98304, W2_ACNT = 393216  , W2_ROPE = 131072, W2_MOD = 1 * MiB, W2_WIN = 2 * MiB, W2_WBR = 86 * MiB, W2_WOUT = 102 * MiB, W2_WQS = 118 * MiB, W2_X = 150 * MiB,
                 W2_QKV = 280 * MiB, W2_G = 427 * MiB, W2_HS = 280 * MiB, W2_QS = 427 * MiB, W2_B1 = 622 * MiB, W2_O = 687 * MiB, W2_IDX = 752 * MiB, W2_GWT = 761 * MiB,
                 W2_UB = 770 * MiB, W2_VB = 802 * MiB, W2_SU = 834 * MiB, W2_SV = 835 * MiB, W2_KS = 836 * MiB, W2_COEF = 838 * MiB, W2_PART = 557 * MiB, W2_APART = 848 * MiB  , W2_END = 884 * MiB;
struct FArgs { const float* in[22]; float* out; char* ws; };
struct AP {
    static __device__ __forceinline__ const void* ld(int i) {
        unsigned base = ARG_OFF; asm volatile("" : "+v"(base));
        const PG8_LAS unsigned* p = (const PG8_LAS unsigned*)(size_t)base;
        unsigned lo = p[2 * i], hi = p[2 * i + 1]; asm volatile("" : "+v"(lo), "+v"(hi));
        lo = __builtin_amdgcn_readfirstlane(lo); hi = __builtin_amdgcn_readfirstlane(hi);
        return (const void*)(const __attribute__((address_space(1))) void*)(((unsigned long long)hi << 32) | lo);
    }
    static __device__ __forceinline__ const float* in(int i) { return (const float*)ld(i); }
    static __device__ __forceinline__ float* out() { return (float*)ld(22); }
    static __device__ __forceinline__ char* ws() { return (char*)ld(23); }
};
__device__ __forceinline__ int make_tid(int wave_s) { unsigned z = 0u; asm volatile("" : "+v"(z)); int t = wave_s * 64 + (int)__builtin_amdgcn_mbcnt_hi(~0u, __builtin_amdgcn_mbcnt_lo(~0u, z)); asm volatile("" : "+v"(t)); return t; }
#ifndef MK_EMASK
#define MK_EMASK 0xFFFFu
#endif
#ifndef MK_DUP
#define MK_DUP -1
#define MK_DUP_L 0
#endif
#ifndef MK_MASK
#define MK_MASK 1023
#endif
#ifndef MK_PH_LO
#define MK_PH_LO 0
#define MK_PH_HI 1000
#endif
__global__ void __launch_bounds__(512, 2) mk_fwd(FArgs a_unused) {
    extern __shared__ __attribute__((aligned(16))) unsigned char lds[];
    PG8_LAS unsigned char* L = (PG8_LAS unsigned char*)lds;
    const int wave_s = __builtin_amdgcn_readfirstlane((int)threadIdx.x >> 6);
    if (threadIdx.x == 0) *(uint4*)(lds + XBW_OFF) = make_uint4(0u, 0u, 0u, 0u);
    if (threadIdx.x < 24) ((unsigned long long*)(lds + ARG_OFF))[threadIdx.x] = ((const unsigned long long*)&a_unused)[threadIdx.x];
    if (threadIdx.x == 24) ((unsigned long long*)(lds + ARG_OFF))[24] = (unsigned long long)gridDim.x;
    if (threadIdx.x == 25) { const unsigned myx = xb_xcc_id(); const unsigned rk = xb_add((unsigned*)(a_unused.ws + W2_RANK) + 64 * myx, 1u);
        ((unsigned*)(lds + ARG_OFF))[50] = myx; ((unsigned*)(lds + ARG_OFF))[51] = rk; }
    __syncthreads();
    XcdBarrier bar = xcd_barrier_post((unsigned*)(AP::ws() + W2_BAR), (volatile LAS unsigned*)(L + XBW_OFF));
#define WSP(T, off) ((T*)(AP::ws() + (off)))

#if MK_MASK & 1
    { const int tid = make_tid(wave_s); rope_table_phase(WSP(float, W2_ROPE), tid); keys_split_phase(AP::in(18), WSP(bf16_t, W2_KS), NL * 16 * 128, tid); }
#define CONVERT_LAYER(l, b0, nb) do { \
        { const int tid = make_tid(wave_s); cvt_T_phase<1>(AP::in(8) + (size_t)(l) * D * NCOL, D, NCOL, WSP(bf16_t, W2_WIN + (size_t)(l) * 42 * MiB), D, 0, (float*)lds, tid, b0, nb); } \
        { const int tid = make_tid(wave_s); cvt_T_phase<0>(AP::in(13) + (size_t)(l) * 768 * D, 768, D, WSP(bf16_t, W2_WBR + (size_t)(l) * 8 * MiB), D, 0, (float*)lds, tid, b0, nb); } \
        { const int tid = make_tid(wave_s); cvt_T_phase<0>(AP::in(14) + (size_t)(l) * 768 * D, 768, D, WSP(bf16_t, W2_WBR + (size_t)(l) * 8 * MiB), D, 768, (float*)lds, tid, b0, nb); } \
        { const int tid = make_tid(wave_s); cvt_T_phase<0>(AP::in(15) + (size_t)(l) * 512 * D, 512, D, WSP(bf16_t, W2_WBR + (size_t)(l) * 8 * MiB), D, 1536, (float*)lds, tid, b0, nb); } \
        { const int tid = make_tid(wave_s); cvt_T_phase<0>(AP::in(16) + (size_t)(l) * D * D, D, D, WSP(bf16_t, W2_WOUT + (size_t)(l) * 8 * MiB), D, 0, (float*)lds, tid, b0, nb); } \
        { const int tid = make_tid(wave_s); cvt_T_phase<3>(AP::in(17) + (size_t)(l) * D * D, D, D, WSP(bf16_t, W2_WQS + (size_t)(l) * 16 * MiB), D, 0, (float*)lds, tid, b0, nb); } \
        { const int tid = make_tid(wave_s); modvec_phase(AP::in(1), AP::in(3), AP::in(4) + (size_t)(l) * D * NMOD, AP::in(5) + (size_t)(l) * NMOD, WSP(float, W2_MOD) + (size_t)(l) * 2 * NMOD, tid, l, b0, nb); } } while (0)
    CONVERT_LAYER(0, (int)blockIdx.x, grid_x());
#endif
    xcd_barrier(bar);
    if (threadIdx.x == 0) {
        unsigned* bw = (unsigned*)(AP::ws() + W2_BAR); const unsigned myx = ((unsigned*)(lds + ARG_OFF))[50]; unsigned xi = 0, nx = 0, cnt = 1;
        for (unsigned j = 0; j < 16; ++j) { const unsigned c = xb_ld(&bw[XB_XCNT(j)]); if (c > 0u) { if (j < myx) ++xi; ++nx; } if (j == myx) cnt = c > 0u ? c : 1u; }
        ((unsigned*)(lds + ARG_OFF))[52] = xi; ((unsigned*)(lds + ARG_OFF))[53] = nx > 0u ? nx : 1u; ((unsigned*)(lds + ARG_OFF))[54] = cnt; }
    __syncthreads();
#if MK_MASK & 2
    {
        const int tid = make_tid(wave_s);
        norm_mod_phase<0>(AP::in(0), AP::in(2), AP::in(6), WSP(float, W2_MOD), 0, D, WSP(bf16_t, W2_B1), nullptr, MT, tid);
    }
#endif
    xcd_barrier(bar);
    for (int l = 0; l < NL; ++l) {
        const int rows = l < NL - 1 ? MT : S;
        for (int rep = 0; rep < ((MK_DUP == 2 && l == MK_DUP_L) ? 2 : 1); ++rep) {
#if MK_MASK & 4
        {
            const int tid = make_tid(wave_s);
            pg8::Gemm g{WSP(bf16_t, W2_B1), WSP(bf16_t, W2_WIN + (size_t)l * 42 * MiB), };
            pg8::StaticOrder so; so.init(MT, NCOL, grid_x(), blockIdx.x);
            pg8::EpiInprojF E{WSP(bf16_t, W2_QKV), WSP(bf16_t, W2_G), AP::in(10) + l * 128, AP::in(11) + l * 128, WSP(float, W2_ROPE), (PG8_LAS float*)(L + XCH_OFF)};
            pg8::gemm_phase<pg8::EpiInprojF, pg8::StaticOrder, 0, D, D, 32>(L, g, so, E, tid);
        }
#endif
        xcd_barrier(bar);
        }
        for (int rep = 0; rep < ((MK_DUP == 3 && l == MK_DUP_L) ? 2 : 1); ++rep) {
#if MK_MASK & 8
        {
            att::attn_phase(WSP(bf16_t, W2_QKV), WSP(bf16_t, W2_O), AP::in(9) + (size_t)l * 6 * 465, AP::in(12) + l * 4, AP::in(10) + l * 128, AP::in(11) + l * 128, WSP(float, W2_APART), (unsigned*)(AP::ws() + W2_ACNT) + (size_t)l * 128 * 64, l < NL - 1, (char*)lds, wave_s);
            const int G_ = grid_x(), c2 = G_ == 256 ? (int)blockIdx.x - 128 : (int)blockIdx.x, G2 = G_ == 256 ? 128 : G_;
            if (c2 >= 0) {
                const int tid = make_tid(wave_s);
                quant_rows_sliced_phase<true>(AP::in(19) + (size_t)l * 16384 * D, WSP(unsigned char, W2_UB), WSP(float, W2_SU), 16384, c2, G2, tid);
                quant_rows_sliced_phase<true>(AP::in(20) + (size_t)l * 16384 * D, WSP(unsigned char, W2_VB), WSP(float, W2_SV), 16384, c2, G2, tid);
                if (l + 1 < NL) { __syncthreads(); CONVERT_LAYER(l + 1, c2, G2); }
            }
        }
#endif
        xcd_barrier(bar);
        }
        for (int rep = 0; rep < ((MK_DUP == 4 && l == MK_DUP_L) ? 2 : 1); ++rep) {
#if MK_MASK & 16
        {
            const int tid = make_tid(wave_s);
            if (l == 0) ctx_gemm<0>(WSP(bf16_t, W2_O), WSP(bf16_t, W2_WBR), WSP(bf16_t, W2_G), nullptr, nullptr, WSP(bf16_t, W2_B1), tid);
            pg8::Gemm g{WSP(bf16_t, W2_O), WSP(bf16_t, W2_WBR + (size_t)l * 8 * MiB), };
            pg8::StaticOrder so; so.init(S, D, grid_x(), blockIdx.x);
            pg8::EpiBranchF E{WSP(bf16_t, W2_G), WSP(bf16_t, W2_B1)};
            pg8::gemm_phase<pg8::EpiBranchF, pg8::StaticOrder, 0, D, D, 32>(L, g, so, E, tid);
        }
#endif
        xcd_barrier(bar);
        }
        for (int rep = 0; rep < ((MK_DUP == 5 && l == MK_DUP_L) ? 2 : 1); ++rep) {
#if MK_MASK & 32
        {
            const int tid = make_tid(wave_s);
            float* X = WSP(float, W2_X);
            if (l == 0) ctx_gemm<1>(WSP(bf16_t, W2_B1), WSP(bf16_t, W2_WOUT), nullptr, AP::in(2), WSP(float, W2_MOD) + NMOD + 2 * D, X, tid);
            pg8::Gemm g{WSP(bf16_t, W2_B1), WSP(bf16_t, W2_WOUT + (size_t)l * 8 * MiB), };
            pg8::StaticOrder so; so.init(S, D, grid_x(), blockIdx.x);
            pg8::EpiOutF E{l == 0 ? AP::in(0) : X, l == 0 ? AP::in(2) : X + (size_t)S * D, WSP(float, W2_MOD) + (size_t)l * 2 * NMOD, X};
            pg8::gemm_phase<pg8::EpiOutF, pg8::StaticOrder, 0, D, D, 32>(L, g, so, E, tid);
        }
#endif
        xcd_barrier(bar);
        }
        for (int rep = 0; rep < ((MK_DUP == 6 && l == MK_DUP_L) ? 2 : 1); ++rep) {
#if MK_MASK & 64
        {
            const int tid = make_tid(wave_s);
            float* X = WSP(float, W2_X);
            norm2_q_phase(X, AP::in(7) + l * D, WSP(float, W2_MOD) + (size_t)l * 2 * NMOD, WSP(_Float16, W2_O), WSP(signed char, W2_HS), WSP(float, W2_SV + 512 * 1024), rows, tid);
        }
#endif
        xcd_barrier(bar);
        }
        for (int rep = 0; rep < ((MK_DUP == 7 && l == MK_DUP_L) ? 2 : 1); ++rep) {
#if MK_MASK & 128
        {
            const int tid = make_tid(wave_s);
            if (l == 0) ctx_gemm<2>(WSP(bf16_t, W2_O), WSP(bf16_t, W2_WQS), nullptr, nullptr, nullptr, WSP(bf16_t, W2_QS), tid);
            pg8::Gemm g{WSP(bf16_t, W2_O), WSP(bf16_t, W2_WQS + (size_t)l * 16 * MiB), };
            pg8::StaticOrder so; so.init(S, D, grid_x(), blockIdx.x);
            pg8::EpiQsplitF E{WSP(bf16_t, W2_QS)};
            pg8::gemm_phase<pg8::EpiQsplitF, pg8::StaticOrder, 0, D, D, 32, true>(L, g, so, E, tid);
        }
#endif
        xcd_barrier(bar);
        }
        for (int rep = 0; rep < ((MK_DUP == 8 && l == MK_DUP_L) ? 2 : 1); ++rep) {
#if MK_MASK & 256
        {
            const int tid = make_tid(wave_s);
            peer_select_sort_phase(WSP(bf16_t, W2_QS), WSP(bf16_t, W2_KS) + (size_t)l * 16 * 128 * 256, WSP(int, W2_IDX), WSP(float, W2_GWT), rows, (char*)lds, tid);
        }
#endif
        xcd_barrier(bar);
        }
        for (int rep = 0; rep < ((MK_DUP == 9 && l == NL - 1) ? 2 : 1); ++rep) {
        if (rep) xcd_barrier(bar);
        { const int tid = make_tid(wave_s); if (rep == 0) peer_u_pass<0xFFFFu>(WSP(signed char, W2_HS), WSP(int, W2_IDX), WSP(unsigned char, W2_UB), WSP(int, W2_PART), rows, tid);
#if MK_DUP == 9
          else peer_u_pass<MK_EMASK>(WSP(signed char, W2_HS), WSP(int, W2_IDX), WSP(unsigned char, W2_UB), WSP(int, 847 * MiB), rows, tid);
#endif
        }
        }
        xcd_barrier(bar);
        for (int rep = 0; rep < ((MK_DUP == 10 && l == NL - 1) ? 2 : 1); ++rep) { if (rep) xcd_barrier(bar);
        { const int tid = make_tid(wave_s); peer_coef_pass(WSP(int, W2_PART), WSP(int, W2_IDX), WSP(float, W2_GWT), WSP(float, W2_SU), WSP(float, W2_SV), WSP(float, W2_SV + 512 * 1024), WSP(signed char, W2_COEF), WSP(float, W2_SV + 768 * 1024), rows, tid); }
        }
        xcd_barrier(bar);
        for (int rep = 0; rep < ((MK_DUP == 11 && l == NL - 1) ? 2 : 1); ++rep) { if (rep) xcd_barrier(bar);
        { const int tid = make_tid(wave_s); peer_v_pass(WSP(signed char, W2_COEF), WSP(float, W2_SV + 768 * 1024), WSP(int, W2_IDX), WSP(unsigned char, W2_VB), WSP(float, W2_HS)  , rows, tid); }
        }
        xcd_barrier(bar);
        for (int rep = 0; rep < ((MK_DUP == 12 && l == NL - 1) ? 2 : 1); ++rep) { if (rep) xcd_barrier(bar);
        { const int tid = make_tid(wave_s);
          if (l < NL - 1) peer_row_pass<false>(WSP(float, W2_X), WSP(float, W2_HS), WSP(float, W2_MOD) + (size_t)l * 2 * NMOD, AP::in(6) + (l + 1) * D, WSP(float, W2_MOD) + (size_t)(l + 1) * 2 * NMOD, WSP(bf16_t, W2_B1), nullptr, rows, tid);
          else peer_row_pass<true>(WSP(float, W2_X), WSP(float, W2_HS), WSP(float, W2_MOD) + (size_t)l * 2 * NMOD, AP::in(21), nullptr, nullptr, AP::out(), rows, tid); }
        }
        if (l < NL - 1) xcd_barrier(bar);
    }
#undef WSP
}

extern "C" void kernel_launch(void* const* d_in, const int* in_sizes, int n_in, void* d_out, int out_size, void* d_ws, size_t ws_size, hipStream_t stream) {
    static int grid = 0;
    if (grid == 0) {
        if (n_in != 22 || ws_size < W2_END) { fprintf(stderr, "kernel_launch: bad args n_in %d ws %zu\n", n_in, ws_size); grid = -1; return; }
        int dev = 0, cus = 0;
        if (hipGetDevice(&dev) != hipSuccess || hipDeviceGetAttribute(&cus, hipDeviceAttributeMultiprocessorCount, dev) != hipSuccess) { grid = -1; return; }
        if (hipFuncSetAttribute((const void*)mk_fwd, hipFuncAttributeMaxDynamicSharedMemorySize, LDS_BYTES) != hipSuccess) { grid = -1; return; }
        int per_cu = 0;
        if (hipOccupancyMaxActiveBlocksPerMultiprocessor(&per_cu, (const void*)mk_fwd, 512, LDS_BYTES) != hipSuccess || per_cu < 1) { fprintf(stderr, "kernel_launch: occupancy query says %d\n", per_cu); }
        (void)hipGetLastError();
        grid = cus;
    }
    if (grid < 0) return;
    (void)hipMemsetAsync((char*)d_ws, 0, 1 * MiB, stream);
    FArgs a{};
    for (int i = 0; i < 22; ++i) a.in[i] = (const float*)d_in[i];
    a.out = (float*)d_out; a.ws = (char*)d_ws;
    hipLaunchKernelGGL(mk_fwd, dim3(grid), dim3(512), LDS_BYTES, stream, a);
}
```

```cpp
#include <hip/hip_runtime.h>
#include <stdint.h>
#include <stdio.h>
#ifndef MK_PARTSPLIT
#define MK_PARTSPLIT 0
#endif

constexpr int D = 2048, S = 16384, CT = 256, MT = S + CT, NL = 2;
constexpr int NCOL = 10752, NQKV = 4608, NGATE = 6144, NMOD = 12288;
constexpr int QA = 0, KA = 768, VA = 1536, QB = 2304, KB = 3072, VB = 3328, QC = 3584, KC = 4096, VC = 4352;
constexpr float EPS = 1e-6f;
constexpr float QSCALE = 0.08838834764831845f;

typedef unsigned short bf16_t;
typedef short bf16x8 __attribute__((ext_vector_type(8)));
typedef float f32x4 __attribute__((ext_vector_type(4)));

__device__ __forceinline__ float bf2f(unsigned b) { return __uint_as_float((b & 0xffffu) << 16); }
__device__ __forceinline__ bf16_t f2bf(float f) { unsigned u = __float_as_uint(f); u += 0x7fffu + ((u >> 16) & 1u); return (bf16_t)(u >> 16); }
__device__ __forceinline__ unsigned pk2(float lo, float hi) { return (unsigned)f2bf(lo) | ((unsigned)f2bf(hi) << 16); }
template <int CTRL> __device__ __forceinline__ float dpp_mov_f(float v) { return __builtin_bit_cast(float, __builtin_amdgcn_update_dpp(0, __builtin_bit_cast(int, v), CTRL, 0xF, 0xF, true)); }
__device__ __forceinline__ float swz16_f(float v) { return __builtin_bit_cast(float, __builtin_amdgcn_ds_swizzle(__builtin_bit_cast(int, v), 0x401F)); }
__device__ __forceinline__ float wsum(float v) {
    v += dpp_mov_f<0xB1>(v); v += dpp_mov_f<0x4E>(v); v += dpp_mov_f<0x141>(v); v += dpp_mov_f<0x140>(v); v += swz16_f(v);
    return __builtin_bit_cast(float, __builtin_amdgcn_readlane(__builtin_bit_cast(int, v), 0)) + __builtin_bit_cast(float, __builtin_amdgcn_readlane(__builtin_bit_cast(int, v), 32)); }
__device__ __forceinline__ float wmax(float v) {
    v = fmaxf(v, dpp_mov_f<0xB1>(v)); v = fmaxf(v, dpp_mov_f<0x4E>(v)); v = fmaxf(v, dpp_mov_f<0x141>(v)); v = fmaxf(v, dpp_mov_f<0x140>(v)); v = fmaxf(v, swz16_f(v));
    return fmaxf(__builtin_bit_cast(float, __builtin_amdgcn_readlane(__builtin_bit_cast(int, v), 0)), __builtin_bit_cast(float, __builtin_amdgcn_readlane(__builtin_bit_cast(int, v), 32))); }
__device__ __forceinline__ int shxl_i(int v, int M, int lane) { return __builtin_amdgcn_ds_bpermute((lane ^ M) << 2, v); }
__device__ __forceinline__ float shxl_f(float v, int M, int lane) { return __builtin_bit_cast(float, shxl_i(__builtin_bit_cast(int, v), M, lane)); }
__device__ __forceinline__ float silu_f(float x) { return x / (1.f + __expf(-x)); }
__device__ __forceinline__ float sigmoid_f(float x) { return 1.f / (1.f + __expf(-x)); }
__device__ __forceinline__ float gelu_tanh(float x) { const float u = 0.7978845608028654f * (x + 0.044715f * x * x * x); return 0.5f * x * (1.f + tanhf(u)); }

constexpr size_t MiB = 1u << 20;
__device__ __forceinline__ void wave_argmax(float& v, int& i) {
    for (int o = 32; o >= 1; o >>= 1) { const float ov = __shfl_xor(v, o); const int oi = __shfl_xor(i, o); if (ov > v || (ov == v && oi < i)) { v = ov; i = oi; } }
}
constexpr int ARG_OFF = 156672;
__device__ __forceinline__ int grid_x() { unsigned base = ARG_OFF; asm volatile("" : "+v"(base)); const __attribute__((address_space(3))) unsigned* p = (const __attribute__((address_space(3))) unsigned*)(size_t)base; unsigned v = p[48]; asm volatile("" : "+v"(v)); return (int)__builtin_amdgcn_readfirstlane(v); }

namespace pg8 {
#define PG8_LAS __attribute__((address_space(3)))
typedef unsigned u32x4 __attribute__((ext_vector_type(4)));
constexpr int BM = 256, BK = 64, HALF = 128, HTB = HALF * BK * 2, STAGE_BYTES = 8 * HTB, NXCD = 8, WGM = 8;
__host__ __device__ __forceinline__ int lds_byte(int r, int c) { const int st = (r >> 4) * 2 + (c >> 5), rr = r & 15, cc = c & 31, ob = rr * 64 + cc * 2; return st * 1024 + (ob ^ (((ob >> 9) & 1) << 5)); }
__host__ __device__ __forceinline__ void stage_rc(int b, int& R, int& C) { const int st = b / 1024, sb = b % 1024, swz = sb ^ (((sb >> 9) & 1) << 5); R = (st >> 1) * 16 + swz / 64; C = (st & 1) * 32 + (swz % 64) / 2; }
__host__ __device__ __forceinline__ int perm32(int rho) { const int n = rho >> 4, i = rho & 15; return 8 * (i >> 2) + 4 * n + (i & 3); }
struct Unit { int pm, pn; };
struct Gemm { const bf16_t* A; const bf16_t* Bt; };
struct StaticOrder {
    int nM, nN, nwg, G, c;
    __device__ void init(int M, int N, int G_, int c_) { nM = M / BM; nN = N / BM; nwg = nM * nN; G = G_; c = c_; }
    __device__ bool next(int i, Unit& u) const {
        const long L = (long)i * G + c; if (L >= nwg) return false;
        int wgid = (int)L; { const int q = nwg / NXCD, r = nwg % NXCD, xcd = wgid % NXCD, off = wgid / NXCD; wgid = (xcd < r ? xcd * (q + 1) : r * (q + 1) + (xcd - r) * q) + off; }
        const int nig = WGM * nN, gid = wgid / nig, fm = gid * WGM, gsz = (nM - fm) < WGM ? (nM - fm) : WGM;
        u.pm = fm + ((wgid % nig) % gsz); u.pn = (wgid % nig) / gsz; return true;
    }
};
__device__ __forceinline__ unsigned cvt_pk_bf16(float lo, float hi) { unsigned r; asm volatile("v_cvt_pk_bf16_f32 %0, %1, %2" : "=v"(r) : "v"(lo), "v"(hi)); return r; }
typedef _Float16 f16x8 __attribute__((ext_vector_type(8)));
template <bool F16> __device__ __forceinline__ f32x4 mma16(bf16x8 a, bf16x8 b, f32x4 c) {
    if constexpr (F16) return __builtin_amdgcn_mfma_f32_16x16x32_f16(__builtin_bit_cast(f16x8, a), __builtin_bit_cast(f16x8, b), c, 0, 0, 0);
    else return __builtin_amdgcn_mfma_f32_16x16x32_bf16(a, b, c, 0, 0, 0); }
template <int KMAP> __device__ __forceinline__ size_t koffA(int t) { return KMAP == 0 ? (size_t)t * 128 : (size_t)(t & 31) * 128 + (((t >> 5) == 1) ? 4096 : 0); }
template <int KMAP> __device__ __forceinline__ size_t koffB(int t) { return KMAP == 0 ? (size_t)t * 128 : (size_t)(t & 31) * 128 + (((t >> 5) == 2) ? 4096 : 0); }

template <class Epi, class Sched, int KMAP, int LDA, int LDB, int NT, bool F16 = false>
__device__ __forceinline__ void gemm_phase(PG8_LAS unsigned char* lds, const Gemm g, const Sched& S, const Epi& E, int tid) {
    const int wid = __builtin_amdgcn_readfirstlane(tid >> 6), lane = tid & 63, wr = wid >> 2, wc = wid & 3, fr = lane & 15, fq = lane >> 4;
    constexpr int nt = NT;
    unsigned voffA[2], voffB[2];
#pragma unroll
    for (int i = 0; i < 2; ++i) { int R, C; stage_rc(tid * 16 + i * 8192, R, C); const int Rb = Epi::PERM ? ((R & ~31) + perm32(R & 31)) : R;
        voffA[i] = (unsigned)(R * LDA + C) * 2u; voffB[i] = (unsigned)(Rb * LDB + C) * 2u; }
    constexpr size_t kstep = (size_t)(BK * 2);
    constexpr size_t hstepA = (size_t)HALF * LDA * 2, hstepB = (size_t)HALF * LDB * 2, tstepA = 2 * hstepA, tstepB = 2 * hstepB;
    const unsigned ldsw = (unsigned)wid * 1024u;
    const int aoff = lds_byte(wr * 64 + fr, fq * 8), boff = lds_byte(wc * 32 + fr, fq * 8);
#define PG8_SA(b, h) (((b) * 2 + (h)) * HTB)
#define PG8_SB(b, h) ((4 + (b) * 2 + (h)) * HTB)
#define PG8_STAGE(bufoff, gbase, voff) do { _Pragma("unroll") for (int _i = 0; _i < 2; ++_i) \
        __builtin_amdgcn_global_load_lds((const unsigned*)((const char*)(gbase) + (voff)[_i]), (PG8_LAS unsigned*)(lds + (bufoff) + ldsw + _i * 8192), 16, 0, 0); } while (0)
#define PG8_LDA(dst, b, h) do { _Pragma("unroll") for (int m = 0; m < 4; ++m) _Pragma("unroll") for (int k = 0; k < 2; ++k) dst[m][k] = *(const PG8_LAS bf16x8*)(lds + PG8_SA(b, h) + aoff + m * 2048 + k * 1024); } while (0)
#define PG8_LDB(dst, b, h) do { _Pragma("unroll") for (int n = 0; n < 2; ++n) _Pragma("unroll") for (int k = 0; k < 2; ++k) dst[n][k] = *(const PG8_LAS bf16x8*)(lds + PG8_SB(b, h) + boff + n * 2048 + k * 1024); } while (0)
#define PG8_MMA(ai, bj, At, Bt) do { __builtin_amdgcn_s_setprio(1); _Pragma("unroll") for (int m = 0; m < 4; ++m) _Pragma("unroll") for (int n = 0; n < 2; ++n) _Pragma("unroll") for (int k = 0; k < 2; ++k) \
        acc[ai][bj][m][n] = mma16<F16>(Bt[n][k], At[m][k], acc[ai][bj][m][n]); __builtin_amdgcn_s_setprio(0); } while (0)
#define PG8_WAIT_V(n) asm volatile("s_waitcnt vmcnt(" #n ")" ::: "memory")
#define PG8_WAIT_L(n) asm volatile("s_waitcnt lgkmcnt(" #n ")" ::: "memory")
#define PG8_BAR __builtin_amdgcn_s_barrier()
#define PG8_SCHED __builtin_amdgcn_sched_barrier(0)
    Unit cur, nxt; int ui = 0;
    if (!S.next(0, cur)) return;
    f32x4 acc[2][2][4][2];
#pragma unroll
    for (int a = 0; a < 2; ++a)
#pragma unroll
        for (int b = 0; b < 2; ++b)
#pragma unroll
            for (int m = 0; m < 4; ++m)
#pragma unroll
                for (int n = 0; n < 2; ++n) acc[a][b][m][n] = (f32x4){0.f, 0.f, 0.f, 0.f};
    bf16x8 At[4][2], B0[2][2], B1[2][2];
    const char* cA = (const char*)g.A + (size_t)cur.pm * tstepA; const char* cB = (const char*)g.Bt + (size_t)cur.pn * tstepB;
    PG8_STAGE(PG8_SB(0, 0), cB, voffB); PG8_STAGE(PG8_SB(0, 1), cB + hstepB, voffB); PG8_STAGE(PG8_SA(0, 0), cA, voffA); PG8_STAGE(PG8_SA(0, 1), cA + hstepA, voffA);
    if (wr == 1) PG8_BAR;
    PG8_WAIT_V(2); PG8_BAR;
    PG8_STAGE(PG8_SB(1, 0), cB + kstep, voffB); PG8_STAGE(PG8_SA(1, 0), cA + kstep, voffA); PG8_STAGE(PG8_SB(1, 1), cB + hstepB + kstep, voffB);
    PG8_WAIT_V(6); PG8_BAR;
    for (;;) {
        const bool has_next = S.next(ui + 1, nxt);
        const char* nA = has_next ? (const char*)g.A + (size_t)nxt.pm * tstepA : cA; const char* nB = has_next ? (const char*)g.Bt + (size_t)nxt.pn * tstepB : cB;
        for (int t = 0; t < nt; t += 2) {
            const bool last = (t == nt - 2);
            const char* a1 = cA + koffA<KMAP>(t) + kstep;
            const char* a2 = last ? nA : cA + koffA<KMAP>(t + 2); const char* b2 = last ? nB : cB + koffB<KMAP>(t + 2);
            const char* a3 = a2 + kstep; const char* b3 = b2 + kstep;
            if constexpr (Epi::HAS_MID) { if (t == Epi::MID1 || t == Epi::MID2) E.mid(acc, cur, t, tid); }
            PG8_LDB(B0, 0, 0); PG8_LDB(B1, 0, 1); PG8_SCHED; PG8_LDA(At, 0, 0); PG8_STAGE(PG8_SA(1, 1), a1 + hstepA, voffA);
            PG8_WAIT_V(8); PG8_WAIT_L(0); PG8_BAR; PG8_MMA(0, 0, At, B0); PG8_MMA(0, 1, At, B1); PG8_BAR; PG8_SCHED;
            PG8_LDA(At, 0, 1); PG8_STAGE(PG8_SB(0, 0), b2, voffB); PG8_STAGE(PG8_SB(0, 1), b2 + hstepB, voffB); PG8_STAGE(PG8_SA(0, 0), a2, voffA);
            PG8_WAIT_V(8); PG8_WAIT_L(0); PG8_BAR; PG8_MMA(1, 0, At, B0); PG8_MMA(1, 1, At, B1); PG8_BAR; PG8_SCHED;
            PG8_LDB(B0, 1, 0); PG8_LDB(B1, 1, 1); PG8_SCHED; PG8_LDA(At, 1, 0); PG8_STAGE(PG8_SA(0, 1), a2 + hstepA, voffA);
            PG8_WAIT_V(8); PG8_WAIT_L(0); PG8_BAR; PG8_MMA(0, 0, At, B0); PG8_MMA(0, 1, At, B1); PG8_BAR; PG8_SCHED;
            PG8_LDA(At, 1, 1); PG8_STAGE(PG8_SB(1, 0), b3, voffB); PG8_STAGE(PG8_SB(1, 1), b3 + hstepB, voffB); PG8_STAGE(PG8_SA(1, 0), a3, voffA);
            PG8_WAIT_V(8); PG8_WAIT_L(0); PG8_BAR; PG8_MMA(1, 0, At, B0); PG8_MMA(1, 1, At, B1); PG8_BAR; PG8_SCHED;
        }
        if (wr == 0) PG8_BAR;
        E(acc, cur, tid);
        if (!has_next) break;
#pragma unroll
        for (int a = 0; a < 2; ++a)
#pragma unroll
            for (int b = 0; b < 2; ++b)
#pragma unroll
                for (int m = 0; m < 4; ++m)
#pragma unroll
                    for (int n = 0; n < 2; ++n) acc[a][b][m][n] = (f32x4){0.f, 0.f, 0.f, 0.f};
        cur = nxt; cA = nA; cB = nB; ++ui;
        if (wr == 1) PG8_BAR;
    }
    PG8_WAIT_V(0);
    PG8_BAR;
#undef PG8_SA
#undef PG8_SB
#undef PG8_STAGE
#undef PG8_LDA
#undef PG8_LDB
#undef PG8_MMA
#undef PG8_WAIT_V
#undef PG8_WAIT_L
#undef PG8_BAR
#undef PG8_SCHED
}

typedef const f32x4 (&AccC)[2][2][4][2];
typedef f32x4 (&AccM)[2][2][4][2];
__device__ __forceinline__ u32x4 pack8(f32x4 v0, f32x4 v1) { u32x4 w; w.x = cvt_pk_bf16(v0[0], v0[1]); w.y = cvt_pk_bf16(v0[2], v0[3]); w.z = cvt_pk_bf16(v1[0], v1[1]); w.w = cvt_pk_bf16(v1[2], v1[3]); return w; }
__device__ __forceinline__ f32x4 sig4(f32x4 v) { f32x4 r;
#pragma unroll
    for (int j = 0; j < 4; ++j) r[j] = __builtin_amdgcn_rcpf(1.f + __builtin_amdgcn_exp2f(-1.4426950408889634f * v[j])); return r; }
__device__ __forceinline__ f32x4 unpack_lo4(unsigned a, unsigned b) { return (f32x4){__uint_as_float(a << 16), __uint_as_float(a & 0xffff0000u), __uint_as_float(b << 16), __uint_as_float(b & 0xffff0000u)}; }

struct EpiInprojF {
    static constexpr bool PERM = true, HAS_MID = false;
    bf16_t* QKV; bf16_t* G; const float* qn; const float* kn; const float* rope; PG8_LAS float* xch;
    __device__ __forceinline__ void operator()(AccC acc, const Unit& u, int tid) const {
        const int wid_ = __builtin_amdgcn_readfirstlane(tid >> 6), wr = wid_ >> 2, wc = wid_ & 3, fr = tid & 15, fq = (tid >> 4) & 3;
        const int pn = u.pn, rowb = u.pm * BM + wr * 64 + fr;
        if (pn >= 18) {
#pragma unroll
            for (int ai = 0; ai < 2; ++ai)
#pragma unroll
                for (int m = 0; m < 4; ++m) { bf16_t* rowp = G + (size_t)(rowb + ai * HALF + m * 16) * NGATE + (pn - 18) * BM + wc * 32 + 8 * fq;
#pragma unroll
                    for (int bj = 0; bj < 2; ++bj) *(u32x4*)(rowp + bj * HALF) = pack8(acc[ai][bj][m][0], acc[ai][bj][m][1]); }
            return;
        }
        const bool ropet = (pn >= 9 && pn <= 12) || (pn >= 14 && pn <= 16);
        if (!ropet) {
#pragma unroll
            for (int ai = 0; ai < 2; ++ai)
#pragma unroll
                for (int m = 0; m < 4; ++m) { bf16_t* rowp = QKV + (size_t)(rowb + ai * HALF + m * 16) * NQKV + pn * BM + wc * 32 + 8 * fq;
#pragma unroll
                    for (int bj = 0; bj < 2; ++bj) *(u32x4*)(rowp + bj * HALF) = pack8(acc[ai][bj][m][0], acc[ai][bj][m][1]); }
            return;
        }
        const bool nrm = pn <= 12; const int half = wc & 1;
        float rs[2][4];
        f32x4 gg[2][2];
#pragma unroll
        for (int bj = 0; bj < 2; ++bj)
#pragma unroll
            for (int n = 0; n < 2; ++n) gg[bj][n] = (f32x4){1.f, 1.f, 1.f, 1.f};
#pragma unroll
        for (int ai = 0; ai < 2; ++ai)
#pragma unroll
            for (int m = 0; m < 4; ++m) rs[ai][m] = 1.f;
        if (nrm) {
            const float qsc = (pn <= 11 && u.pm < (S / BM)) ? 0.088388347648318440f * 1.4426950408889634f : 1.f;
            const float* gv = (pn <= 11 ? qn : kn) + 64 * half + 8 * fq;
#pragma unroll
            for (int bj = 0; bj < 2; ++bj)
#pragma unroll
                for (int n = 0; n < 2; ++n) gg[bj][n] = *(const f32x4*)(gv + 32 * bj + 4 * n);
#pragma unroll
            for (int ai = 0; ai < 2; ++ai)
#pragma unroll
                for (int m = 0; m < 4; ++m) { float s = 0.f;
#pragma unroll
                    for (int bj = 0; bj < 2; ++bj)
#pragma unroll
                        for (int n = 0; n < 2; ++n) { const f32x4 x = acc[ai][bj][m][n]; s += (x[0] * x[0] + x[1] * x[1]) + (x[2] * x[2] + x[3] * x[3]); }
                    s += shxl_f(s, 16, tid & 63); s += shxl_f(s, 32, tid & 63);
                    if (fq == 0) xch[(ai * HALF + wr * 64 + m * 16 + fr) * 4 + wc] = s; }
            asm volatile("s_waitcnt lgkmcnt(0)" ::: "memory"); __builtin_amdgcn_s_barrier(); asm volatile("" ::: "memory");
#pragma unroll
            for (int ai = 0; ai < 2; ++ai)
#pragma unroll
                for (int m = 0; m < 4; ++m) { const int rl = ai * HALF + wr * 64 + m * 16 + fr; const float tot = xch[rl * 4 + wc] + xch[rl * 4 + (wc ^ 1)];
                    rs[ai][m] = __builtin_amdgcn_rsqf(tot * (1.f / 128.f) + EPS) * qsc; }
        }
        const bool dorope = u.pm < (S / BM);
#pragma unroll
        for (int ai = 0; ai < 2; ++ai)
#pragma unroll
            for (int m = 0; m < 4; ++m) {
                const int r = rowb + ai * HALF + m * 16;
                const int pos = half == 0 ? ((r >> 6) & 255) : (r & 63);
                const float* rp = rope + (size_t)(pos * 32 + 8 * fq) * 2;
                f32x4 y1[2], y2[2];
#pragma unroll
                for (int n = 0; n < 2; ++n) {
                    f32x4 x1 = acc[ai][0][m][n] * rs[ai][m] * gg[0][n], x2 = acc[ai][1][m][n] * rs[ai][m] * gg[1][n];
                    if (dorope) {
                        const f32x4 cs0 = *(const f32x4*)(rp + 8 * n), cs1 = *(const f32x4*)(rp + 8 * n + 4);
                        const f32x4 cc = {cs0[0], cs0[2], cs1[0], cs1[2]}, sn = {cs0[1], cs0[3], cs1[1], cs1[3]};
                        y1[n] = x1 * cc - x2 * sn; y2[n] = x2 * cc + x1 * sn;
                    } else { y1[n] = x1; y2[n] = x2; }
                }
                bf16_t* rowp = QKV + (size_t)r * NQKV + pn * BM + 64 * wc + 8 * fq;
                *(u32x4*)rowp = pack8(y1[0], y1[1]); *(u32x4*)(rowp + 32) = pack8(y2[0], y2[1]);
            }
    }
};
struct EpiBranchF {
    static constexpr bool PERM = true, HAS_MID = true; static constexpr int MID1 = 12, MID2 = 24;
    const bf16_t* G; bf16_t* MB;
    static __device__ __forceinline__ float ex(float x) { return fminf(__builtin_amdgcn_exp2f(-1.4426950408889634f * x), 1e30f); }
    __device__ __forceinline__ void mid(AccM acc, const Unit& u, int t, int tid) const {
        const int wid_ = __builtin_amdgcn_readfirstlane(tid >> 6), wr = wid_ >> 2, wc = wid_ & 3, fr = tid & 15, fq = (tid >> 4) & 3;
        const int gi = (t == MID1) ? 0 : 1;
        const bf16_t* gb = G + (size_t)(u.pm * BM + wr * 64 + fr) * NGATE + gi * D + u.pn * BM + wc * 32 + 8 * fq;
#pragma unroll
        for (int ai = 0; ai < 2; ++ai)
#pragma unroll
            for (int m = 0; m < 4; ++m) {
#pragma unroll
                for (int bj = 0; bj < 2; ++bj) { const bf16_t* gp = gb + (size_t)(ai * HALF + m * 16) * NGATE + bj * HALF;
                    const u32x4 ga = *(const u32x4*)gp, gc = *(const u32x4*)(gp + D);
                    const f32x4 a0 = unpack_lo4(ga.x, ga.y), a1 = unpack_lo4(ga.z, ga.w), c0 = unpack_lo4(gc.x, gc.y), c1 = unpack_lo4(gc.z, gc.w);
#pragma unroll
                    for (int j = 0; j < 4; ++j) {
                        acc[ai][bj][m][0][j] *= (1.f + ex(c0[j])) * __builtin_amdgcn_rcpf(1.f + ex(a0[j]));
                        acc[ai][bj][m][1][j] *= (1.f + ex(c1[j])) * __builtin_amdgcn_rcpf(1.f + ex(a1[j])); } }
                asm volatile("" ::: "memory");
            }
    }
    __device__ __forceinline__ void operator()(AccC acc, const Unit& u, int tid) const {
        const int wid_ = __builtin_amdgcn_readfirstlane(tid >> 6), wr = wid_ >> 2, wc = wid_ & 3, fr = tid & 15, fq = (tid >> 4) & 3;
        const int rowb = u.pm * BM + wr * 64 + fr, colb = u.pn * BM + wc * 32 + 8 * fq;
#pragma unroll
        for (int ai = 0; ai < 2; ++ai)
#pragma unroll
            for (int m = 0; m < 4; ++m) { const size_t r = (size_t)(rowb + ai * HALF + m * 16);
#pragma unroll
                for (int bj = 0; bj < 2; ++bj) { const u32x4 gc = *(const u32x4*)(G + r * NGATE + 2 * D + colb + bj * HALF);
                    const f32x4 c0 = unpack_lo4(gc.x, gc.y), c1 = unpack_lo4(gc.z, gc.w);
                    *(u32x4*)(MB + r * D + colb + bj * HALF) = pack8(acc[ai][bj][m][0] * sig4(c0), acc[ai][bj][m][1] * sig4(c1)); } }
    }
};
struct EpiOutF {
    static constexpr bool PERM = false, HAS_MID = false;
    const float* blat; const float* bctx; const float* MODl; float* X;
    __device__ __forceinline__ void operator()(AccC acc, const Unit& u, int tid) const {
        const int wid_ = __builtin_amdgcn_readfirstlane(tid >> 6), wr = wid_ >> 2, wc = wid_ & 3, fr = tid & 15, fq = (tid >> 4) & 3;
        const int rowb = u.pm * BM + wr * 64 + fr, colb = u.pn * BM + wc * 32 + 4 * fq; const bool isctx = u.pm >= (S / BM);
        const float* md = MODl + (isctx ? NMOD : 0) + 2 * D + colb;
        f32x4 gv[2][2];
#pragma unroll
        for (int bj = 0; bj < 2; ++bj)
#pragma unroll
            for (int n = 0; n < 2; ++n) gv[bj][n] = *(const f32x4*)(md + bj * HALF + n * 16);
#pragma unroll
        for (int ai = 0; ai < 2; ++ai)
#pragma unroll
            for (int m = 0; m < 4; ++m) { const int r = rowb + ai * HALF + m * 16; const float* bp = (isctx ? bctx + (size_t)(r - S) * D : blat + (size_t)r * D) + colb; float* xp = X + (size_t)r * D + colb;
#pragma unroll
                for (int bj = 0; bj < 2; ++bj)
#pragma unroll
                    for (int n = 0; n < 2; ++n) *(f32x4*)(xp + bj * HALF + n * 16) = *(const f32x4*)(bp + bj * HALF + n * 16) + gv[bj][n] * acc[ai][bj][m][n]; }
    }
};
struct EpiQsplitF {
    static constexpr bool PERM = true, HAS_MID = false;
    bf16_t* QS;
    __device__ __forceinline__ void operator()(AccC acc, const Unit& u, int tid) const {
        const int wid_ = __builtin_amdgcn_readfirstlane(tid >> 6), wr = wid_ >> 2, wc = wid_ & 3, fr = tid & 15, fq = (tid >> 4) & 3;
        const int rowb = u.pm * BM + wr * 64 + fr, colb = u.pn * BM + wc * 32 + 8 * fq;
#pragma unroll
        for (int ai = 0; ai < 2; ++ai)
#pragma unroll
            for (int m = 0; m < 4; ++m) { bf16_t* rp = QS + (size_t)(rowb + ai * HALF + m * 16) * (2 * D) + colb;
#pragma unroll
                for (int bj = 0; bj < 2; ++bj) { const f32x4 v0 = acc[ai][bj][m][0], v1 = acc[ai][bj][m][1]; const u32x4 hi = pack8(v0, v1);
                    const f32x4 h0 = unpack_lo4(hi.x, hi.y), h1 = unpack_lo4(hi.z, hi.w);
                    *(u32x4*)(rp + bj * HALF) = hi; *(u32x4*)(rp + D + bj * HALF) = pack8(v0 - h0, v1 - h1); } }
    }
};
}
constexpr int CTX_BROW = 4096 + 16;
template <bool F16 = false>
__device__ __forceinline__ f32x4 ctx_dot(const bf16_t* __restrict__ Ap, unsigned bl, int nk32) {
    typedef unsigned cuv4 __attribute__((ext_vector_type(4))); typedef __attribute__((address_space(1))) cuv4 CG4; typedef __attribute__((address_space(3))) cuv4 CL4;
    f32x4 acc0 = {0.f, 0.f, 0.f, 0.f}, acc1 = {0.f, 0.f, 0.f, 0.f};
    cuv4 a0[8], a1[8];
#pragma unroll
    for (int i = 0; i < 8; ++i) a0[i] = *(const CG4*)(Ap + 32 * i);
    for (int k = 0; k < nk32; k += 16) {
        const bool more1 = k + 8 < nk32, more2 = k + 16 < nk32;
        if (more1) {
#pragma unroll
            for (int i = 0; i < 8; ++i) a1[i] = *(const CG4*)(Ap + 32 * (k + 8 + i)); }
#pragma unroll
        for (int i = 0; i < 8; i += 2) { const cuv4 b0 = *(const CL4*)(size_t)(bl + 64u * (k + i)), b1 = *(const CL4*)(size_t)(bl + 64u * (k + i + 1));
            acc0 = pg8::mma16<F16>(__builtin_bit_cast(bf16x8, b0), __builtin_bit_cast(bf16x8, a0[i]), acc0); acc1 = pg8::mma16<F16>(__builtin_bit_cast(bf16x8, b1), __builtin_bit_cast(bf16x8, a0[i + 1]), acc1); }
        if (more2) {
#pragma unroll
            for (int i = 0; i < 8; ++i) a0[i] = *(const CG4*)(Ap + 32 * (k + 16 + i)); }
        if (more1) {
#pragma unroll
            for (int i = 0; i < 8; i += 2) { const cuv4 b0 = *(const CL4*)(size_t)(bl + 64u * (k + 8 + i)), b1 = *(const CL4*)(size_t)(bl + 64u * (k + 9 + i));
                acc0 = pg8::mma16<F16>(__builtin_bit_cast(bf16x8, b0), __builtin_bit_cast(bf16x8, a1[i]), acc0); acc1 = pg8::mma16<F16>(__builtin_bit_cast(bf16x8, b1), __builtin_bit_cast(bf16x8, a1[i + 1]), acc1); } }
    }
    return acc0 + acc1;
}
template <int MODE>
__device__ __forceinline__ void ctx_gemm(const bf16_t* __restrict__ A, const bf16_t* __restrict__ Bt, const bf16_t* __restrict__ Gr, const float* __restrict__ base, const float* __restrict__ gvec,
                                         void* __restrict__ outp, int tid) {
    const int wave = tid >> 6, lane = tid & 63, fr = lane & 15, fq = lane >> 4;
    typedef unsigned cuv4 __attribute__((ext_vector_type(4))); typedef __attribute__((address_space(1))) cuv4 CG4; typedef __attribute__((address_space(3))) cuv4 CL4;
    for (int item = blockIdx.x; item < 256; item += grid_x()) {
        const int n0 = (item >> 1) * 16, r0 = S + (item & 1) * 128 + wave * 16, row = r0 + fr, col = n0 + 4 * fq;
        __syncthreads();
#pragma unroll
        for (int i = 0; i < 8; ++i) { const int idx = tid + 512 * i, br = idx >> 8, bc = idx & 255; *(CL4*)(size_t)((unsigned)(br * CTX_BROW + bc * 16)) = *(const CG4*)(Bt + (size_t)(n0 + br) * D + bc * 8); }
        __syncthreads();
        const unsigned bl = (unsigned)(fr * CTX_BROW + fq * 16);
        if (MODE == 0) {
            const bf16_t* Ap = A + (size_t)row * D + 8 * fq;
            const f32x4 aa = ctx_dot(Ap, bl, 24), ab = ctx_dot(Ap + 768, bl + 768u * 2u, 24), ac = ctx_dot(Ap + 1536, bl + 1536u * 2u, 16);
            const bf16_t* gp = Gr + (size_t)row * NGATE + col;
            const uint2 g0 = *(const uint2*)gp, g1 = *(const uint2*)(gp + D), g2 = *(const uint2*)(gp + 2 * D);
            const f32x4 s0 = pg8::sig4(pg8::unpack_lo4(g0.x, g0.y)), s1 = pg8::sig4(pg8::unpack_lo4(g1.x, g1.y)), s2 = pg8::sig4(pg8::unpack_lo4(g2.x, g2.y));
            const f32x4 m = s0 * aa + s1 * ab + s2 * ac;
            uint2 p; p.x = pk2(m[0], m[1]); p.y = pk2(m[2], m[3]); *(uint2*)((bf16_t*)outp + (size_t)row * D + col) = p;
        } else if (MODE == 1) {
            const f32x4 acc = ctx_dot(A + (size_t)row * D + 8 * fq, bl, 64);
            const f32x4 b = *(const f32x4*)(base + (size_t)(row - S) * D + col), g = *(const f32x4*)(gvec + col);
            *(f32x4*)((float*)outp + (size_t)row * D + col) = b + g * acc;
        } else {
            const f32x4 acc = ctx_dot<true>(A + (size_t)row * D + 8 * fq, bl, 64);
            uint2 hi; hi.x = pk2(acc[0], acc[1]); hi.y = pk2(acc[2], acc[3]);
            uint2 lo; lo.x = pk2(acc[0] - bf2f(hi.x), acc[1] - bf2f(hi.x >> 16)); lo.y = pk2(acc[2] - bf2f(hi.y), acc[3] - bf2f(hi.y >> 16));
            bf16_t* qp = (bf16_t*)outp + (size_t)row * (2 * D) + col; *(uint2*)qp = hi; *(uint2*)(qp + D) = lo;
        }
    }
    __syncthreads();
}
#define WAVE_LDS_SYNC() asm volatile("s_waitcnt lgkmcnt(0)" ::: "memory")
__device__ __forceinline__ int winperm(int n) {
    const int pn = n >> 8; if (!((pn >= 9 && pn <= 12) || (pn >= 14 && pn <= 16))) return n;
    const int cl = n & 255, wc = cl >> 6, bj = (cl >> 5) & 1, x = cl & 31; return (n & ~255) + 128 * bj + 32 * wc + x;
}
template <int MODE>
__device__ __forceinline__ void cvt_T_phase(const float* __restrict__ W, int K, int N, bf16_t* __restrict__ WT, int ldt, int koff, float* scr, int tid, int b0, int nb) {
    const int nnb = N / 32, nitems = nnb * (K / 64);
    const int k = tid >> 3, n4 = (tid & 7) * 4, n = tid >> 4, k4 = (tid & 15) * 4;
    for (int it0 = b0; it0 < nitems; it0 += 8 * nb) {
        float4 v[8];
#pragma unroll
        for (int t = 0; t < 8; ++t) { const int it = it0 + t * nb; if (it < nitems) { const int n0 = (it % nnb) * 32, k0 = (it / nnb) * 64; v[t] = *(const float4*)(W + (size_t)(k0 + k) * N + n0 + n4); } }
        __syncthreads();
#pragma unroll
        for (int t = 0; t < 8; ++t) { const int it = it0 + t * nb; if (it < nitems) { float* d = scr + t * (64 * 33) + k * 33 + n4; d[0] = v[t].x; d[1] = v[t].y; d[2] = v[t].z; d[3] = v[t].w; } }
        __syncthreads();
#pragma unroll
        for (int t = 0; t < 8; ++t) { const int it = it0 + t * nb; if (it < nitems) { const int n0 = (it % nnb) * 32, k0 = (it / nnb) * 64; const float* sp = scr + t * (64 * 33);
            const float v0 = sp[(k4 + 0) * 33 + n], v1 = sp[(k4 + 1) * 33 + n], v2 = sp[(k4 + 2) * 33 + n], v3 = sp[(k4 + 3) * 33 + n];
            const int dn = MODE == 1 ? winperm(n0 + n) : n0 + n; bf16_t* dp = WT + (size_t)dn * ldt + koff + k0 + k4;
            uint2 h;
            if (MODE == 3) { typedef _Float16 hf2_ __attribute__((ext_vector_type(2))); hf2_ a_; a_.x = (_Float16)v0; a_.y = (_Float16)v1; hf2_ b_; b_.x = (_Float16)v2; b_.y = (_Float16)v3; h.x = __builtin_bit_cast(unsigned, a_); h.y = __builtin_bit_cast(unsigned, b_); }
            else { h.x = pk2(v0, v1); h.y = pk2(v2, v3); }
            *(uint2*)dp = h;
            if (MODE == 2) { uint2 lo; lo.x = pk2(v0 - bf2f(h.x), v1 - bf2f(h.x >> 16)); lo.y = pk2(v2 - bf2f(h.y), v3 - bf2f(h.y >> 16)); *(uint2*)(dp + K) = lo; } } }
    }
}
__device__ __forceinline__ void cvt_plain_phase(const float* __restrict__ src, bf16_t* __restrict__ dst, size_t n8, int tid) {
    for (size_t i = (size_t)blockIdx.x * 512 + tid; i < n8; i += (size_t)grid_x() * 512) {
        const float4 a = *(const float4*)(src + i * 8), b = *(const float4*)(src + i * 8 + 4);
        uint4 o; o.x = pk2(a.x, a.y); o.y = pk2(a.z, a.w); o.z = pk2(b.x, b.y); o.w = pk2(b.z, b.w); *(uint4*)(dst + i * 8) = o;
    }
}
__device__ __forceinline__ void rope_table_phase(float* __restrict__ rope, int tid) {
    for (int i = blockIdx.x * 512 + tid; i < 256 * 32; i += grid_x() * 512) {
        const int pos = i >> 5, f = i & 31; const float inv = powf(10000.f, -(float)f / 32.f); float sn, cs; sincosf((float)pos * inv, &sn, &cs);
        rope[2 * i] = cs; rope[2 * i + 1] = sn;
    }
}
__device__ __forceinline__ void modvec_phase(const float* __restrict__ c, const float* __restrict__ c_ctx, const float* __restrict__ w_mod, const float* __restrict__ b_mod, float* __restrict__ MOD, int tid, int l, int b0, int nb) {
    const int wave = tid >> 6, lane = tid & 63;
    for (int item = b0 * 8 + wave; item < NMOD / 12; item += nb * 8) {
        const int n0 = item * 12;
        const float* w = w_mod + n0;
        float a0[12], a1[12];
#pragma unroll
        for (int j = 0; j < 12; ++j) { a0[j] = 0.f; a1[j] = 0.f; }
#pragma unroll 4
        for (int i = 0; i < 32; ++i) { const int k = lane + 64 * i; const float s0 = silu_f(c[k]), s1 = silu_f(c_ctx[k]); const float4* wp = (const float4*)(w + (size_t)k * NMOD);
            const float4 w0 = wp[0], w1 = wp[1], w2 = wp[2]; const float wv[12] = {w0.x, w0.y, w0.z, w0.w, w1.x, w1.y, w1.z, w1.w, w2.x, w2.y, w2.z, w2.w};
#pragma unroll
            for (int j = 0; j < 12; ++j) { a0[j] += s0 * wv[j]; a1[j] += s1 * wv[j]; } }
#pragma unroll
        for (int j = 0; j < 12; ++j) { a0[j] = wsum(a0[j]); a1[j] = wsum(a1[j]); }
        if (lane == 0) {
#pragma unroll
            for (int j = 0; j < 12; ++j) { const float b = b_mod[n0 + j]; MOD[n0 + j] = a0[j] + b; MOD[NMOD + n0 + j] = a1[j] + b; } }
    }
}
template <int OUT>
__device__ __forceinline__ void norm_mod_phase(const float* __restrict__ xlat, const float* __restrict__ xctx, const float* __restrict__ gnorm, const float* __restrict__ MODl,
                                               int sh_off, int sc_off, bf16_t* __restrict__ Hb, _Float16* __restrict__ Hf, int rows, int tid) {
    const int wave = tid >> 6, lane = tid & 63, nw = grid_x() * 8;
    for (int row0 = blockIdx.x * 8 + wave; row0 < rows; row0 += 2 * nw) {
        const int row1 = row0 + nw; const bool has1 = row1 < rows;
        const float* xr0 = row0 < S ? xlat + (size_t)row0 * D : xctx + (size_t)(row0 - S) * D;
        const float* xr1 = has1 ? (row1 < S ? xlat + (size_t)row1 * D : xctx + (size_t)(row1 - S) * D) : xr0;
        float4 v0[8], v1[8]; float ss0 = 0.f, ss1 = 0.f;
#pragma unroll
        for (int i = 0; i < 8; ++i) { v0[i] = *(const float4*)(xr0 + 4 * lane + 256 * i); v1[i] = *(const float4*)(xr1 + 4 * lane + 256 * i); }
#pragma unroll
        for (int i = 0; i < 8; ++i) { ss0 += v0[i].x * v0[i].x + v0[i].y * v0[i].y + v0[i].z * v0[i].z + v0[i].w * v0[i].w; ss1 += v1[i].x * v1[i].x + v1[i].y * v1[i].y + v1[i].z * v1[i].z + v1[i].w * v1[i].w; }
        ss0 = wsum(ss0); ss1 = wsum(ss1);
        const float rs0 = rsqrtf(ss0 * (1.f / D) + EPS), rs1 = rsqrtf(ss1 * (1.f / D) + EPS);
        const float* md0 = MODl + (row0 < S ? 0 : NMOD); const float* md1 = MODl + (row1 < S ? 0 : NMOD);
#pragma unroll
        for (int i = 0; i < 8; ++i) {
            const int col = 4 * lane + 256 * i;
            const float4 g = *(const float4*)(gnorm + col);
#pragma unroll
            for (int r = 0; r < 2; ++r) {
                if (r == 1 && !has1) break;
                const int row = r ? row1 : row0; const float* md = r ? md1 : md0; const float rs = r ? rs1 : rs0; const float4 v = r ? v1[i] : v0[i];
                const float4 sh = *(const float4*)(md + sh_off + col), sc = *(const float4*)(md + sc_off + col);
                float4 o;
                o.x = v.x * rs * g.x * (1.f + sc.x) + sh.x; o.y = v.y * rs * g.y * (1.f + sc.y) + sh.y;
                o.z = v.z * rs * g.z * (1.f + sc.z) + sh.z; o.w = v.w * rs * g.w * (1.f + sc.w) + sh.w;
                uint2 p; p.x = pk2(o.x, o.y); p.y = pk2(o.z, o.w);
                if (OUT == 0) *(uint2*)(Hb + (size_t)row * D + col) = p;
                else if (OUT == 2) { typedef _Float16 hf4_ __attribute__((ext_vector_type(4))); hf4_ hv; hv.x = (_Float16)o.x; hv.y = (_Float16)o.y; hv.z = (_Float16)o.z; hv.w = (_Float16)o.w; *(hf4_*)(Hf + (size_t)row * D + col) = hv; }
                else { uint2 q; q.x = pk2(o.x - bf2f(p.x), o.y - bf2f(p.x >> 16)); q.y = pk2(o.z - bf2f(p.y), o.w - bf2f(p.y >> 16));
                    *(uint2*)(Hb + (size_t)row * (2 * D) + col) = p; *(uint2*)(Hb + (size_t)row * (2 * D) + D + col) = q;
                    typedef _Float16 hf4_ __attribute__((ext_vector_type(4))); hf4_ hv; hv.x = (_Float16)o.x; hv.y = (_Float16)o.y; hv.z = (_Float16)o.z; hv.w = (_Float16)o.w; *(hf4_*)(Hf + (size_t)row * D + col) = hv; }
            }
        }
    }
}
__device__ __forceinline__ void norm2_q_phase(const float* __restrict__ X, const float* __restrict__ gnorm, const float* __restrict__ MODl, _Float16* __restrict__ Hf, signed char* __restrict__ Hq,
                                              float* __restrict__ SH, int rows, int tid) {
    const int wave = tid >> 6, lane = tid & 63, nw = grid_x() * 8;
    for (int rowi = blockIdx.x * 8 + wave; rowi < rows; rowi += 2 * nw) {
        int row0 = rowi; asm volatile("" : "+v"(row0) :: "memory");
        const int row1 = row0 + nw; const bool has1 = row1 < rows; const int row1c = has1 ? row1 : row0;
        float4 v0[8], v1[8]; float ss0 = 0.f, ss1 = 0.f;
#pragma unroll
        for (int i = 0; i < 8; ++i) { v0[i] = *(const float4*)(X + (size_t)row0 * D + 4 * lane + 256 * i); v1[i] = *(const float4*)(X + (size_t)row1c * D + 4 * lane + 256 * i); }
#pragma unroll
        for (int i = 0; i < 8; ++i) { ss0 += v0[i].x * v0[i].x + v0[i].y * v0[i].y + v0[i].z * v0[i].z + v0[i].w * v0[i].w; ss1 += v1[i].x * v1[i].x + v1[i].y * v1[i].y + v1[i].z * v1[i].z + v1[i].w * v1[i].w; }
        ss0 = wsum(ss0); ss1 = wsum(ss1);
        const float rs0 = rsqrtf(ss0 * (1.f / D) + EPS), rs1 = rsqrtf(ss1 * (1.f / D) + EPS);
        const float* md0 = MODl + (row0 < S ? 0 : NMOD); const float* md1 = MODl + (row1c < S ? 0 : NMOD);
        float mx0 = 0.f, mx1 = 0.f;
#pragma unroll
        for (int i = 0; i < 8; ++i) {
            const int col = 4 * lane + 256 * i; const float4 g = *(const float4*)(gnorm + col);
            { const float4 sh = *(const float4*)(md0 + 3 * D + col), sc = *(const float4*)(md0 + 4 * D + col); float4 o;
              o.x = v0[i].x * rs0 * g.x * (1.f + sc.x) + sh.x; o.y = v0[i].y * rs0 * g.y * (1.f + sc.y) + sh.y; o.z = v0[i].z * rs0 * g.z * (1.f + sc.z) + sh.z; o.w = v0[i].w * rs0 * g.w * (1.f + sc.w) + sh.w;
              v0[i] = o; mx0 = fmaxf(mx0, fmaxf(fmaxf(fabsf(o.x), fabsf(o.y)), fmaxf(fabsf(o.z), fabsf(o.w)))); }
            { const float4 sh = *(const float4*)(md1 + 3 * D + col), sc = *(const float4*)(md1 + 4 * D + col); float4 o;
              o.x = v1[i].x * rs1 * g.x * (1.f + sc.x) + sh.x; o.y = v1[i].y * rs1 * g.y * (1.f + sc.y) + sh.y; o.z = v1[i].z * rs1 * g.z * (1.f + sc.z) + sh.z; o.w = v1[i].w * rs1 * g.w * (1.f + sc.w) + sh.w;
              v1[i] = o; mx1 = fmaxf(mx1, fmaxf(fmaxf(fabsf(o.x), fabsf(o.y)), fmaxf(fabsf(o.z), fabsf(o.w)))); }
        }
        mx0 = wmax(mx0); mx1 = wmax(mx1);
        const float s0 = mx0 > 0.f ? mx0 * (1.f / 127.f) : 1.f, s1 = mx1 > 0.f ? mx1 * (1.f / 127.f) : 1.f, i0 = 1.f / s0, i1 = 1.f / s1;
        typedef _Float16 hf4_ __attribute__((ext_vector_type(4)));
#pragma unroll
        for (int i = 0; i < 8; ++i) {
            const int col = 4 * lane + 256 * i;
            { hf4_ hv; hv.x = (_Float16)v0[i].x; hv.y = (_Float16)v0[i].y; hv.z = (_Float16)v0[i].z; hv.w = (_Float16)v0[i].w; *(hf4_*)(Hf + (size_t)row0 * D + col) = hv;
              const unsigned b0 = (unsigned)__float2int_rn(v0[i].x * i0) & 255u, b1 = (unsigned)__float2int_rn(v0[i].y * i0) & 255u, b2 = (unsigned)__float2int_rn(v0[i].z * i0) & 255u, b3 = (unsigned)__float2int_rn(v0[i].w * i0) & 255u;
              *(unsigned*)(Hq + (size_t)row0 * D + col) = b0 | (b1 << 8) | (b2 << 16) | (b3 << 24); }
            if (has1) { hf4_ hv; hv.x = (_Float16)v1[i].x; hv.y = (_Float16)v1[i].y; hv.z = (_Float16)v1[i].z; hv.w = (_Float16)v1[i].w; *(hf4_*)(Hf + (size_t)row1 * D + col) = hv;
              const unsigned b0 = (unsigned)__float2int_rn(v1[i].x * i1) & 255u, b1 = (unsigned)__float2int_rn(v1[i].y * i1) & 255u, b2 = (unsigned)__float2int_rn(v1[i].z * i1) & 255u, b3 = (unsigned)__float2int_rn(v1[i].w * i1) & 255u;
              *(unsigned*)(Hq + (size_t)row1 * D + col) = b0 | (b1 << 8) | (b2 << 16) | (b3 << 24); }
        }
        if (lane == 0) { SH[row0] = s0; if (has1) SH[row1] = s1; }
    }
}
namespace att {
using s16x4  = __attribute__((ext_vector_type(4))) short;
using f32x16 = __attribute__((ext_vector_type(16))) float;
using u32x4  = __attribute__((ext_vector_type(4))) unsigned;
constexpr int KVBLK = 64, QBLK = 32, NW = 8, LDQ = NQKV, LDK = NQKV, LDO = D;
constexpr float SCALE = 0.088388347648318440f, THR = 8.f, C2 = SCALE * 1.4426950408889634f;
constexpr size_t SHM_V = KVBLK * 128 * 2, SHM_K = KVBLK * 128 * 2, SHM_ATTN = 2 * SHM_V + 2 * SHM_K + NW * 64 * 4;
constexpr int RPB_OFF = 68 * 1024;
#define KSWZ(row, colB) ((row) * 256 + ((colB) ^ (((row) & 7) << 4)))
#define SBAR() __builtin_amdgcn_sched_barrier(0)
__device__ __forceinline__ int crow(int r, int hi) { return (r & 3) + 8 * (r >> 2) + 4 * hi; }
__device__ __forceinline__ unsigned cvtpk(float lo, float hi) { unsigned r; asm volatile("v_cvt_pk_bf16_f32 %0, %1, %2" : "=v"(r) : "v"(lo), "v"(hi)); return r; }
__device__ __forceinline__ void partialSM(f32x16& p0, f32x16& p1, float& m_reg, float& mn, float& alpha) {
  float pmax = p0[0]; for (int r = 1; r < 16; ++r) pmax = fmaxf(pmax, p0[r]); for (int r = 0; r < 16; ++r) pmax = fmaxf(pmax, p1[r]);
  { auto rr = __builtin_amdgcn_permlane32_swap(__float_as_uint(pmax), __float_as_uint(pmax), false, false);
    pmax = fmaxf(__uint_as_float(rr[0]), __uint_as_float(rr[1])); }
  if (__builtin_expect(__all(pmax - m_reg <= THR / SCALE), 1)) { mn = m_reg; alpha = 1.f; }
  else { mn = fmaxf(m_reg, pmax); alpha = __builtin_amdgcn_exp2f((m_reg - mn) * C2); m_reg = mn; }
  float mnC = -mn * C2;
  for (int r = 0; r < 16; ++r) p0[r] = fmaf(p0[r], C2, mnC); for (int r = 0; r < 16; ++r) p1[r] = fmaf(p1[r], C2, mnC);
  for (int r = 0; r < 16; ++r) p0[r] = __builtin_amdgcn_exp2f(p0[r]);
}
template <bool SHIFT>
__device__ __forceinline__ void partialSM_fixed(f32x16& p0, f32x16& p1, float m_reg, float& mn, float& alpha) {
  mn = m_reg; alpha = 1.f;
  if constexpr (SHIFT) { const float mnC = -m_reg * C2; for (int r = 0; r < 16; ++r) p0[r] += mnC; for (int r = 0; r < 16; ++r) p1[r] += mnC; }
  for (int r = 0; r < 16; ++r) p0[r] = __builtin_amdgcn_exp2f(p0[r]);
}
__device__ __forceinline__ void finishSM(f32x16& p0, f32x16& p1, float alpha, float& l_reg, bf16x8& pa0, bf16x8& pa1, bf16x8& pa2, bf16x8& pa3) {
  for (int r = 0; r < 16; ++r) p1[r] = __builtin_amdgcn_exp2f(p1[r]);
  float ps = 0; for (int r = 0; r < 16; ++r) ps += p0[r]; for (int r = 0; r < 16; ++r) ps += p1[r];
  { auto rr = __builtin_amdgcn_permlane32_swap(__float_as_uint(ps), __float_as_uint(ps), false, false);
    ps = __uint_as_float(rr[0]) + __uint_as_float(rr[1]); }
  l_reg = l_reg * alpha + ps;
#define PK4(P, BASE, OUT) do { unsigned a0 = cvtpk(P[BASE + 0], P[BASE + 1]), a1 = cvtpk(P[BASE + 2], P[BASE + 3]);   \
    unsigned b0 = cvtpk(P[BASE + 4], P[BASE + 5]), b1 = cvtpk(P[BASE + 6], P[BASE + 7]);                              \
    auto r0 = __builtin_amdgcn_permlane32_swap(a0, b0, false, false); auto r1 = __builtin_amdgcn_permlane32_swap(a1, b1, false, false); \
    u32x4 w = {r0[0], r1[0], r0[1], r1[1]}; OUT = *reinterpret_cast<bf16x8*>(&w); } while (0)
  PK4(p0, 0, pa0); PK4(p0, 8, pa1); PK4(p1, 0, pa2); PK4(p1, 8, pa3);
#undef PK4
}
__device__ __forceinline__ void qkt(f32x16& p0, f32x16& p1, const char* Ks, const bf16x8* qr, int r32, int hi) {
  p0 = f32x16{}; p1 = f32x16{};
  for (int d0 = 0; d0 < 8; ++d0) { int cb = (d0 * 16 + hi * 8) * 2;
    bf16x8 b0 = *reinterpret_cast<const bf16x8*>(Ks + KSWZ(r32, cb));
    bf16x8 b1 = *reinterpret_cast<const bf16x8*>(Ks + KSWZ(32 + r32, cb));
    p0 = __builtin_amdgcn_mfma_f32_32x32x16_bf16(b0, qr[d0], p0, 0, 0, 0);
    p1 = __builtin_amdgcn_mfma_f32_32x32x16_bf16(b1, qr[d0], p1, 0, 0, 0); }
}
__device__ __forceinline__ int v_st(int k, int c) { const int kk = (k & ~0xC) | ((k & 4) << 1) | ((k & 8) >> 1); return ((kk >> 3) * 4 + (c >> 5)) * 512 + ((kk & 7) * 32 + (c & 31)) * 2; }
__device__ __forceinline__ int v_rd_base(int lane) { return ((lane & 3) << 3) | (((lane >> 2) & 3) << 6) | (((lane >> 4) & 1) << 5) | (((lane >> 5) & 1) << 8); }
constexpr int v_rd_off(int d0, int ks, int half) { return d0 * 512 + ks * 4096 + half * 2048; }
template <int OFF> __device__ __forceinline__ s16x4 tr_read(int vb) { s16x4 r; asm volatile("ds_read_b64_tr_b16 %0, %1 offset:%2" : "=&v"(r) : "v"(vb), "i"(OFF) : "memory"); return r; }
template <int D0> __device__ __forceinline__ void pv_one(f32x16& od, int vb, bf16x8 pa0, bf16x8 pa1, bf16x8 pa2, bf16x8 pa3) {
  const s16x4 l0 = tr_read<v_rd_off(D0, 0, 0)>(vb), h0 = tr_read<v_rd_off(D0, 0, 1)>(vb), l1 = tr_read<v_rd_off(D0, 1, 0)>(vb), h1 = tr_read<v_rd_off(D0, 1, 1)>(vb);
  const s16x4 l2 = tr_read<v_rd_off(D0, 2, 0)>(vb), h2 = tr_read<v_rd_off(D0, 2, 1)>(vb), l3 = tr_read<v_rd_off(D0, 3, 0)>(vb), h3 = tr_read<v_rd_off(D0, 3, 1)>(vb);
  asm volatile("s_waitcnt lgkmcnt(0)" ::: "memory"); SBAR();
#define PK(L, H) (bf16x8){L[0], L[1], L[2], L[3], H[0], H[1], H[2], H[3]}
  od = __builtin_amdgcn_mfma_f32_32x32x16_bf16(pa0, PK(l0, h0), od, 0, 0, 0);
  od = __builtin_amdgcn_mfma_f32_32x32x16_bf16(pa1, PK(l1, h1), od, 0, 0, 0);
  od = __builtin_amdgcn_mfma_f32_32x32x16_bf16(pa2, PK(l2, h2), od, 0, 0, 0);
  od = __builtin_amdgcn_mfma_f32_32x32x16_bf16(pa3, PK(l3, h3), od, 0, 0, 0);
#undef PK
}
__device__ __forceinline__ void pv_d0(f32x16* o, int vb, bf16x8 pa0, bf16x8 pa1, bf16x8 pa2, bf16x8 pa3) {
  pv_one<0>(o[0], vb, pa0, pa1, pa2, pa3); pv_one<1>(o[1], vb, pa0, pa1, pa2, pa3); pv_one<2>(o[2], vb, pa0, pa1, pa2, pa3); pv_one<3>(o[3], vb, pa0, pa1, pa2, pa3);
}
struct UnitP { int q0, nt, kstart, nlat, r0, hq; float sinkl2, mfix; int j0; float* pmine; const float* pother; unsigned* cnt; };
template <int KIND> __device__ __forceinline__ int krow_of(const UnitP& u, int j) {
  if (KIND == 1) return 64 * (u.j0 + j);
  if (KIND == 3) return S + 64 * j;
  return j < u.nlat ? u.kstart + 64 * j : S + 64 * (j - u.nlat);
}
template <int KIND> __device__ __forceinline__ void apply_mask(f32x16& p0, f32x16& p1, const UnitP& u, int j, int wid, int r32, int hi, const float* rpbs) {
  if (KIND == 2) {
    if (j < u.nlat) {
      const int krow = u.kstart + 64 * j, tw = u.q0 + wid * 32;
      if (!(krow >= tw + 31 - 128 && krow + 63 <= tw + 128)) {
        const int t = tw + r32;
#pragma unroll
        for (int r = 0; r < 16; ++r) { const int d0 = krow + crow(r, hi) - t, d1 = d0 + 32;
          p0[r] = (d0 >= -128 && d0 <= 128) ? p0[r] : -INFINITY; p1[r] = (d1 >= -128 && d1 <= 128) ? p1[r] : -INFINITY; }
      }
    }
  } else if (KIND == 0) {
    if (j < u.nlat) {
      const int kr = u.kstart / 64 + j, qr = u.r0 + (wid >> 1), qc = (wid & 1) * 32 + r32;
      const int rsq = min(max(qr - 4, 0), 248), cs = min(max(qc - 8, 0), 48);
      const bool row_ok = (kr >= rsq) && (kr < rsq + 8);
      const int bidx = min(max(kr - qr + 7, 0), 14) * 31 + 15 - qc;
#pragma unroll
      for (int r = 0; r < 16; ++r) { const int kc0 = crow(r, hi);
        const bool ok0 = row_ok && kc0 >= cs && kc0 < cs + 16;
        const float b0 = rpbs[ok0 ? bidx + kc0 : 0];
        p0[r] = ok0 ? p0[r] + b0 : -INFINITY;
        if ((r & 3) == 3) asm volatile("" ::: "memory"); }
#pragma unroll
      for (int r = 0; r < 16; ++r) { const int kc1 = crow(r, hi) + 32;
        const bool ok1 = row_ok && kc1 >= cs && kc1 < cs + 16;
        const float b1 = rpbs[ok1 ? bidx + kc1 : 0];
        p1[r] = ok1 ? p1[r] + b1 : -INFINITY;
        if ((r & 3) == 3) asm volatile("" ::: "memory"); }
    }
  }
}
template <int KIND, int SDEPTH, bool PART = false, bool SHIFT = false>
__device__ __forceinline__ void attn_unit(const bf16_t* __restrict__ Qb, const bf16_t* __restrict__ Kh, const bf16_t* __restrict__ Vh, bf16_t* __restrict__ Ob, const UnitP u, char* lds, int tid) {
  const int wid = tid >> 6, lane = tid & 63, r32 = lane & 31, hi = lane >> 5;
  char* V_lds = lds; char* K_lds = lds + 2 * SHM_V;
  float* wsf = (float*)(lds + 2 * SHM_V + 2 * SHM_K) + wid * 64; float* li_l = wsf; float* al_l = wsf + 32;
  const float* rpbs = (const float*)(lds + RPB_OFF);
  float m_reg = (KIND == 1) ? u.mfix : -1e30f, l_reg = 0; f32x16 o[4] = {}; bf16x8 qr[8];
#define PSM(P0, P1, MN, AL) do { if constexpr (KIND == 1) partialSM_fixed<SHIFT>(P0, P1, m_reg, MN, AL); else partialSM(P0, P1, m_reg, MN, AL); } while (0)
#define QKT(P0, P1, KS) qkt(P0, P1, KS, qr, r32, hi)
  const bf16_t* Qw = Qb + (long)(wid * QBLK + r32) * LDQ + hi * 8;
#pragma unroll
  for (int d0 = 0; d0 < 8; ++d0) qr[d0] = *reinterpret_cast<const bf16x8*>(Qw + d0 * 16);
  const int sr = tid >> 4, sc = (tid & 15) * 8, vst0 = v_st(sr, sc), vst1 = v_st(32 + sr, sc);
  const int vb0 = (int)(uintptr_t)V_lds + v_rd_base(lane);
  struct { bf16x8 vs0, vs1, ks0, ks1; } sr_[SDEPTH];
  const unsigned goff0 = (unsigned)(sr * LDK + sc) * 2u, goff1 = goff0 + 32u * LDK * 2u;
  const char* Kc = (const char*)Kh; const char* Vc = (const char*)Vh;
#define SLOAD(i, jj) do { const unsigned tb_ = (unsigned)krow_of<KIND>(u, (jj)) * (unsigned)(LDK * 2); const char* kp_ = Kc + tb_; const char* vp_ = Vc + tb_; \
    sr_[i].vs0 = *reinterpret_cast<const bf16x8*>(vp_ + goff0); sr_[i].vs1 = *reinterpret_cast<const bf16x8*>(vp_ + goff1); \
    sr_[i].ks0 = *reinterpret_cast<const bf16x8*>(kp_ + goff0); sr_[i].ks1 = *reinterpret_cast<const bf16x8*>(kp_ + goff1); } while (0)
#define SWRITE(b, i) do { *(bf16x8*)(V_lds + (b) * SHM_V + vst0) = sr_[i].vs0; *(bf16x8*)(V_lds + (b) * SHM_V + vst1) = sr_[i].vs1; int kc = sc * 2;               \
    *(bf16x8*)(K_lds + (b) * SHM_K + KSWZ(sr, kc)) = sr_[i].ks0; *(bf16x8*)(K_lds + (b) * SHM_K + KSWZ(32 + sr, kc)) = sr_[i].ks1; } while (0)
#define SWAIT() do { if constexpr (SDEPTH == 2) asm volatile("s_waitcnt vmcnt(4)" ::: "memory"); else asm volatile("s_waitcnt vmcnt(0)" ::: "memory"); } while (0)
#define RESC(a) do { if (KIND != 1 && __any((a) < 1.f)) { if (hi == 0) al_l[r32] = (a); asm volatile("s_waitcnt lgkmcnt(0)" ::: "memory"); \
    for (int d = 0; d < 4; ++d) for (int r = 0; r < 16; ++r) o[d][r] *= al_l[crow(r, hi)]; } } while (0)
  f32x16 pA0, pA1, pB0, pB1; float mnA, mnB, alA, alB; bf16x8 pa0, pa1, pa2, pa3; const int NT = u.nt;
  constexpr int SE = 0, SO = SDEPTH - 1;
  SLOAD(SE, 0); asm volatile("s_waitcnt vmcnt(0)" ::: "memory"); SWRITE(0, SE); __syncthreads();
  QKT(pA0, pA1, K_lds); apply_mask<KIND>(pA0, pA1, u, 0, wid, r32, hi, rpbs); PSM(pA0, pA1, mnA, alA);
  SLOAD(SO, 1); if constexpr (SDEPTH == 2) { if (2 < NT) SLOAD(SE, 2); }
  SWAIT(); SWRITE(1, SO); __syncthreads();
  for (int j = 1; j + 1 < NT; j += 2) {
    SBAR(); QKT(pB0, pB1, K_lds + SHM_K); apply_mask<KIND>(pB0, pB1, u, j, wid, r32, hi, rpbs);
    finishSM(pA0, pA1, alA, l_reg, pa0, pa1, pa2, pa3); SBAR();
    SLOAD(SO, j + SDEPTH); SBAR();
    pv_d0(o, vb0, pa0, pa1, pa2, pa3); PSM(pB0, pB1, mnB, alB);
    __syncthreads(); SWAIT(); SWRITE(0, SE);
    RESC(alB); __syncthreads();
    SBAR(); QKT(pA0, pA1, K_lds); apply_mask<KIND>(pA0, pA1, u, j + 1, wid, r32, hi, rpbs);
    finishSM(pB0, pB1, alB, l_reg, pa0, pa1, pa2, pa3); SBAR();
    if (SDEPTH == 1 || j + 3 < NT) SLOAD(SE, j + 1 + SDEPTH); SBAR();
    pv_d0(o, vb0 + (int)SHM_V, pa0, pa1, pa2, pa3); PSM(pA0, pA1, mnA, alA);
    __syncthreads(); SWAIT(); SWRITE(1, SO);
    RESC(alA); __syncthreads();
  }
  SBAR(); QKT(pB0, pB1, K_lds + SHM_K); apply_mask<KIND>(pB0, pB1, u, NT - 1, wid, r32, hi, rpbs);
  finishSM(pA0, pA1, alA, l_reg, pa0, pa1, pa2, pa3); SBAR();
  pv_d0(o, vb0, pa0, pa1, pa2, pa3); PSM(pB0, pB1, mnB, alB);
  __syncthreads(); RESC(alB);
  finishSM(pB0, pB1, alB, l_reg, pa0, pa1, pa2, pa3); SBAR();
  pv_d0(o, vb0 + (int)SHM_V, pa0, pa1, pa2, pa3);
  if (KIND >= 2) l_reg += __builtin_amdgcn_exp2f(u.sinkl2 - m_reg * C2);
  if constexpr (PART) {
    unsigned* pm = (unsigned*)u.pmine + (size_t)wid * 64 * 65 + lane;
#pragma unroll
    for (int d = 0; d < 4; ++d)
#pragma unroll
      for (int r = 0; r < 16; ++r) __hip_atomic_store(pm + (d * 16 + r) * 64, __float_as_uint(o[d][r]), __ATOMIC_RELAXED, __HIP_MEMORY_SCOPE_AGENT);
    __hip_atomic_store(pm + 64 * 64, __float_as_uint(l_reg), __ATOMIC_RELAXED, __HIP_MEMORY_SCOPE_AGENT);
    asm volatile("s_waitcnt vmcnt(0)" ::: "memory");
    __syncthreads();
    unsigned* flag = (unsigned*)(lds + 2 * SHM_V + 2 * SHM_K + NW * 64 * 4);
    if (tid == 0) { const unsigned old = __hip_atomic_fetch_add(u.cnt, 1u, __ATOMIC_RELAXED, __HIP_MEMORY_SCOPE_AGENT); *flag = old; }
    __syncthreads();
    if (*flag == 0u) { __syncthreads(); return; }
    const unsigned* po = (const unsigned*)u.pother + (size_t)wid * 64 * 65 + lane;
#pragma unroll
    for (int d = 0; d < 4; ++d)
#pragma unroll
      for (int r = 0; r < 16; ++r) o[d][r] += __uint_as_float(__hip_atomic_load(po + (d * 16 + r) * 64, __ATOMIC_RELAXED, __HIP_MEMORY_SCOPE_AGENT));
    l_reg += __uint_as_float(__hip_atomic_load(po + 64 * 64, __ATOMIC_RELAXED, __HIP_MEMORY_SCOPE_AGENT));
  }
  if (hi == 0) li_l[r32] = l_reg; asm volatile("s_waitcnt lgkmcnt(0)" ::: "memory");
  float rli[16];
#pragma unroll
  for (int r = 0; r < 16; ++r) rli[r] = __builtin_amdgcn_rcpf(li_l[crow(r, hi)]);
  bf16_t* Ow = Ob + (long)(wid * QBLK) * LDO;
#pragma unroll
  for (int r = 0; r < 16; ++r) { const int orow = crow(r, hi);
#pragma unroll
    for (int d0 = 0; d0 < 4; ++d0) Ow[(long)orow * LDO + d0 * 32 + r32] = f2bf(o[d0][r] * rli[r]); }
  __syncthreads();
#undef PSM
#undef SLOAD
#undef SWRITE
#undef SWAIT
#undef RESC
}
#undef KSWZ
#undef SBAR

__device__ __forceinline__ void attn_phase(const bf16_t* __restrict__ QKV, bf16_t* __restrict__ O, const float* __restrict__ rpb, const float* __restrict__ sink, const float* __restrict__ qn, const float* __restrict__ kn, float* __restrict__ pbuf, unsigned* __restrict__ pcnt, bool do_ctx, char* lds, int wave_s) {
  const int G = grid_x(), c = blockIdx.x;
  const bool bal = (G == 256);
  float mfix;
  { unsigned zz_ = 0u; asm volatile("" : "+v"(zz_)); const int lane_ = (int)__builtin_amdgcn_mbcnt_hi(~0u, __builtin_amdgcn_mbcnt_lo(~0u, zz_)); const float gq = wmax(fmaxf(fabsf(qn[lane_]), fabsf(qn[lane_ + 64]))), gk = wmax(fmaxf(fabsf(kn[lane_]), fabsf(kn[lane_ + 64]))); mfix = __builtin_bit_cast(float, __builtin_amdgcn_readfirstlane(__builtin_bit_cast(int, 128.f * gq * gk * 1.03f))); }
  for (int p = c; p < ((bal && MK_PARTSPLIT) ? 256 : 384); p += G) {
    unsigned z_ = 0u; asm volatile("" : "+v"(z_)); int tid = wave_s * 64 + (int)__builtin_amdgcn_mbcnt_hi(~0u, __builtin_amdgcn_mbcnt_lo(~0u, z_)); asm volatile("" : "+v"(tid));
    UnitP u; u.sinkl2 = -INFINITY; u.r0 = 0; u.kstart = 0; u.nlat = 0; u.hq = 0; u.j0 = 0; u.pmine = nullptr; u.pother = nullptr; u.cnt = nullptr; const int qb = p / 6, h = p % 6;
    u.q0 = qb * 256; u.nt = MT / 64; u.mfix = mfix;
    if (__builtin_amdgcn_readfirstlane((int)(mfix * C2 <= 64.f))) attn_unit<1, 2, false, false>(QKV + (size_t)u.q0 * NQKV + QB + h * 128, QKV + KB + (h / 3) * 128, QKV + VB + (h / 3) * 128, O + (size_t)u.q0 * D + 768 + h * 128, u, lds, tid);
    else attn_unit<1, 1, false, true>(QKV + (size_t)u.q0 * NQKV + QB + h * 128, QKV + KB + (h / 3) * 128, QKV + VB + (h / 3) * 128, O + (size_t)u.q0 * D + 768 + h * 128, u, lds, tid);
  }
  if (bal && MK_PARTSPLIT) {
    unsigned z_ = 0u; asm volatile("" : "+v"(z_)); int tid = wave_s * 64 + (int)__builtin_amdgcn_mbcnt_hi(~0u, __builtin_amdgcn_mbcnt_lo(~0u, z_)); asm volatile("" : "+v"(tid));
    constexpr int KSPLIT = 186;
    const int ub = c & 127, half = c >> 7, p = 256 + ub, qb = p / 6, h = p % 6;
    UnitP u; u.sinkl2 = -INFINITY; u.r0 = 0; u.kstart = 0; u.nlat = 0; u.hq = 0; u.q0 = qb * 256; u.mfix = mfix;
    u.j0 = half ? KSPLIT : 0; u.nt = half ? MT / 64 - KSPLIT : KSPLIT;
    u.pmine = pbuf + (size_t)(ub * 2 + half) * (8 * 64 * 65); u.pother = pbuf + (size_t)(ub * 2 + (half ^ 1)) * (8 * 64 * 65); u.cnt = pcnt + 64 * ub;
    attn_unit<1, 2, true, true>(QKV + (size_t)u.q0 * NQKV + QB + h * 128, QKV + KB + (h / 3) * 128, QKV + VB + (h / 3) * 128, O + (size_t)u.q0 * D + 768 + h * 128, u, lds, tid);
  }
  const int c2 = bal ? c - 128 : c, G2 = bal ? 128 : G;
  if (c2 >= 0) {
    for (int p = c2; p < 384; p += G2) {
      unsigned z_ = 0u; asm volatile("" : "+v"(z_)); int tid = wave_s * 64 + (int)__builtin_amdgcn_mbcnt_hi(~0u, __builtin_amdgcn_mbcnt_lo(~0u, z_)); asm volatile("" : "+v"(tid));
      UnitP u; u.sinkl2 = -INFINITY; u.hq = 0; u.mfix = 0.f; u.j0 = 0; u.pmine = nullptr; u.pother = nullptr; u.cnt = nullptr; const int qb = p / 6, h = p % 6;
      u.q0 = qb * 256; u.r0 = qb * 4; const int rstart = min(max(u.r0 - 4, 0), 244); u.kstart = rstart * 64; u.nlat = 12; u.nt = 16;
      { float* rp = (float*)(lds + RPB_OFF); for (int t = tid; t < 465; t += 512) rp[t] = rpb[h * 465 + t] * (1.f / SCALE); }
      __syncthreads();
      attn_unit<0, 1>(QKV + (size_t)u.q0 * NQKV + QA + h * 128, QKV + KA + h * 128, QKV + VA + h * 128, O + (size_t)u.q0 * D + h * 128, u, lds, tid);
    }
    for (int p = c2; p < 256; p += G2) {
      unsigned z_ = 0u; asm volatile("" : "+v"(z_)); int tid = wave_s * 64 + (int)__builtin_amdgcn_mbcnt_hi(~0u, __builtin_amdgcn_mbcnt_lo(~0u, z_)); asm volatile("" : "+v"(tid));
      UnitP u; u.r0 = 0; u.hq = 0; u.mfix = 0.f; u.j0 = 0; u.pmine = nullptr; u.pother = nullptr; u.cnt = nullptr; const int qb = p / 4, h = p % 4;
      u.q0 = qb * 256; u.kstart = max(u.q0 - 128, 0); const int kend = min(u.q0 + 384, S); u.nlat = (kend - u.kstart) / 64; u.nt = u.nlat + 4; u.sinkl2 = sink[h] * 1.4426950408889634f;
      attn_unit<2, 1>(QKV + (size_t)u.q0 * NQKV + QC + h * 128, QKV + KC + (h / 2) * 128, QKV + VC + (h / 2) * 128, O + (size_t)u.q0 * D + 1536 + h * 128, u, lds, tid);
    }
    if (do_ctx) for (int p = c2; p < 16; p += G2) {
      unsigned z_ = 0u; asm volatile("" : "+v"(z_)); int tid = wave_s * 64 + (int)__builtin_amdgcn_mbcnt_hi(~0u, __builtin_amdgcn_mbcnt_lo(~0u, z_)); asm volatile("" : "+v"(tid));
      UnitP u; u.sinkl2 = -INFINITY; u.r0 = 0; u.kstart = 0; u.nlat = 0; u.hq = 0; u.mfix = 0.f; u.j0 = 0; u.pmine = nullptr; u.pother = nullptr; u.cnt = nullptr; u.q0 = S; u.nt = 4;
      int qcol, kcol, vcol, ocol;
      if (p < 6) { qcol = QA + p * 128; kcol = KA + p * 128; vcol = VA + p * 128; ocol = p * 128; }
      else if (p < 12) { const int hh = p - 6; qcol = QB + hh * 128; kcol = KB + (hh / 3) * 128; vcol = VB + (hh / 3) * 128; ocol = 768 + hh * 128; }
      else { const int hh = p - 12; qcol = QC + hh * 128; kcol = KC + (hh / 2) * 128; vcol = VC + (hh / 2) * 128; ocol = 1536 + hh * 128; u.sinkl2 = sink[hh] * 1.4426950408889634f; }
      attn_unit<3, 1>(QKV + (size_t)S * NQKV + qcol, QKV + kcol, QKV + vcol, O + (size_t)S * D + ocol, u, lds, tid);
    }
  }
}
}
__device__ __forceinline__ void peer_select_phase(const bf16_t* __restrict__ QS, const float* __restrict__ keys, int* __restrict__ IDX, float* __restrict__ GWT, int rows, char* lds, int tid) {
    const int wave = tid >> 6, lane = tid & 63;
    float* sq = (float*)lds + wave * 256; float* ss = (float*)(lds + 8192) + wave * 32; int* si = (int*)(lds + 8192 + 1024) + wave * 32;
    for (int item = blockIdx.x * 8 + wave; item < rows * 8; item += grid_x() * 8) {
        const int token = item >> 3, h = item & 7;
        { const bf16_t* qp = QS + (size_t)token * (2 * D) + h * 256 + lane * 4; const uint2 hi = *(const uint2*)qp, lo = *(const uint2*)(qp + D);
          *(float4*)(sq + lane * 4) = make_float4(bf2f(hi.x) + bf2f(lo.x), bf2f(hi.x >> 16) + bf2f(lo.x >> 16), bf2f(hi.y) + bf2f(lo.y), bf2f(hi.y >> 16) + bf2f(lo.y >> 16)); }
        WAVE_LDS_SYNC();
        float sc[2][2];
#pragma unroll
        for (int p = 0; p < 2; ++p)
#pragma unroll
            for (int r = 0; r < 2; ++r) {
                const float4* kp = (const float4*)(keys + ((size_t)((h * 2 + p) * 128 + lane + 64 * r)) * 128);
                float acc = 0.f;
#pragma unroll 8
                for (int d4 = 0; d4 < 32; ++d4) { const float4 kv = kp[d4]; const float4 q = *(const float4*)(sq + p * 128 + d4 * 4); acc += q.x * kv.x + q.y * kv.y + q.z * kv.z + q.w * kv.w; }
                sc[p][r] = acc;
            }
#pragma unroll
        for (int p = 0; p < 2; ++p) {
            float v0 = sc[p][0], v1 = sc[p][1];
            for (int k = 0; k < 16; ++k) {
                float bv; int bi; if (v0 >= v1) { bv = v0; bi = lane; } else { bv = v1; bi = lane + 64; }
                wave_argmax(bv, bi);
                if (lane == 0) { ss[p * 16 + k] = bv; si[p * 16 + k] = bi; }
                if (bi == lane) v0 = -INFINITY; else if (bi == lane + 64) v1 = -INFINITY;
            }
        }
        WAVE_LDS_SYNC();
        float cv[4];
#pragma unroll
        for (int r = 0; r < 4; ++r) { const int ci = lane + 64 * r; cv[r] = ss[ci >> 4] + ss[16 + (ci & 15)]; }
        float my_s = 0.f; int my_i = 0;
        for (int k = 0; k < 16; ++k) {
            float bv = cv[0]; int bi = lane;
#pragma unroll
            for (int r = 1; r < 4; ++r) if (cv[r] > bv) { bv = cv[r]; bi = lane + 64 * r; }
            wave_argmax(bv, bi);
            if (lane == k) { my_s = bv; my_i = bi; }
#pragma unroll
            for (int r = 0; r < 4; ++r) if (bi == lane + 64 * r) cv[r] = -INFINITY;
        }
        const float mx = __shfl(my_s, 0);
        const float e = lane < 16 ? __expf(my_s - mx) : 0.f;
        const float sum = wsum(e);
        if (lane < 16) { IDX[(size_t)token * 128 + h * 16 + lane] = si[my_i >> 4] * 128 + si[16 + (my_i & 15)]; GWT[(size_t)token * 128 + h * 16 + lane] = e / sum; }
        WAVE_LDS_SYNC();
    }
}
__device__ __forceinline__ float gelu_fast(float x) {
    const float u2 = 1.5957691216057308f * (x + 0.044715f * x * x * x);
    return x * (1.f - __builtin_amdgcn_rcpf(1.f + __builtin_amdgcn_exp2f(fminf(1.4426950408889634f * u2, 126.f))));
}
__device__ __forceinline__ void unpack8(const uint4 w, float (&f)[8]) {
    f[0] = __uint_as_float(w.x << 16); f[1] = __uint_as_float(w.x & 0xffff0000u); f[2] = __uint_as_float(w.y << 16); f[3] = __uint_as_float(w.y & 0xffff0000u);
    f[4] = __uint_as_float(w.z << 16); f[5] = __uint_as_float(w.z & 0xffff0000u); f[6] = __uint_as_float(w.w << 16); f[7] = __uint_as_float(w.w & 0xffff0000u);
}
template <bool LAST>
__device__ __forceinline__ void peer_expert_phase(const bf16_t* __restrict__ HS, const int* __restrict__ IDX, const float* __restrict__ GWT, const bf16_t* __restrict__ UB, const bf16_t* __restrict__ VB,
                                                  const float* __restrict__ MODl, float* __restrict__ X, const float* __restrict__ gnext, const float* __restrict__ MODn, bf16_t* __restrict__ Hn,
                                                  float* __restrict__ out, int rows, int tid) {
    const int wave = tid >> 6, lane = tid & 63;
    for (int row = blockIdx.x * 8 + wave; row < rows; row += grid_x() * 8) {
        float h[4][8], acc[4][8];
#pragma unroll
        for (int i = 0; i < 4; ++i) { const bf16_t* hp = HS + (size_t)row * (2 * D) + 8 * lane + 512 * i; float a[8], b[8]; unpack8(*(const uint4*)hp, a); unpack8(*(const uint4*)(hp + D), b);
#pragma unroll
            for (int j = 0; j < 8; ++j) { h[i][j] = a[j] + b[j]; acc[i][j] = 0.f; } }
        const int idx_lo = IDX[(size_t)row * 128 + lane], idx_hi = IDX[(size_t)row * 128 + 64 + lane];
        const float gw_lo = GWT[(size_t)row * 128 + lane], gw_hi = GWT[(size_t)row * 128 + 64 + lane];
        for (int j0 = 0; j0 < 128; j0 += 4) {
            int e[4]; float w[4], d[4];
#pragma unroll
            for (int k = 0; k < 4; ++k) { const int j = j0 + k;
                e[k] = j0 < 64 ? __builtin_amdgcn_readlane(idx_lo, j & 63) : __builtin_amdgcn_readlane(idx_hi, j & 63);
                w[k] = __uint_as_float(j0 < 64 ? __builtin_amdgcn_readlane(__float_as_uint(gw_lo), j & 63) : __builtin_amdgcn_readlane(__float_as_uint(gw_hi), j & 63)); }
            uint4 ur[4][4];
#pragma unroll
            for (int k = 0; k < 4; ++k) { const uint4* up = (const uint4*)(UB + (size_t)e[k] * D) + lane;
#pragma unroll
                for (int i = 0; i < 4; ++i) ur[k][i] = up[64 * i]; }
#pragma unroll
            for (int k = 0; k < 4; ++k) { float s = 0.f;
#pragma unroll
                for (int i = 0; i < 4; ++i) { float f[8]; unpack8(ur[k][i], f);
#pragma unroll
                    for (int j = 0; j < 8; ++j) s += h[i][j] * f[j]; }
                d[k] = s; }
            asm volatile("" : "+v"(d[0]), "+v"(d[1]), "+v"(d[2]), "+v"(d[3]) :: "memory");
            uint4 vr[4][4];
#pragma unroll
            for (int k = 0; k < 4; ++k) { const uint4* vp = (const uint4*)(VB + (size_t)e[k] * D) + lane;
#pragma unroll
                for (int i = 0; i < 4; ++i) vr[k][i] = vp[64 * i]; }
#pragma unroll
            for (int k = 0; k < 4; ++k) d[k] = wsum(d[k]);
#pragma unroll
            for (int k = 0; k < 4; ++k) { const float a = gelu_fast(d[k]) * w[k];
#pragma unroll
                for (int i = 0; i < 4; ++i) { float f[8]; unpack8(vr[k][i], f);
#pragma unroll
                    for (int j = 0; j < 8; ++j) acc[i][j] += a * f[j]; } }
        }
        const float* md = MODl + (row < S ? 0 : NMOD) + 5 * D;
        float xn[4][8]; float ss = 0.f;
#pragma unroll
        for (int i = 0; i < 4; ++i) { const int col = 8 * lane + 512 * i; const float4 g0 = *(const float4*)(md + col), g1 = *(const float4*)(md + col + 4);
            const float4 x0 = *(const float4*)(X + (size_t)row * D + col), x1 = *(const float4*)(X + (size_t)row * D + col + 4);
            xn[i][0] = x0.x + g0.x * acc[i][0]; xn[i][1] = x0.y + g0.y * acc[i][1]; xn[i][2] = x0.z + g0.z * acc[i][2]; xn[i][3] = x0.w + g0.w * acc[i][3];
            xn[i][4] = x1.x + g1.x * acc[i][4]; xn[i][5] = x1.y + g1.y * acc[i][5]; xn[i][6] = x1.z + g1.z * acc[i][6]; xn[i][7] = x1.w + g1.w * acc[i][7];
#pragma unroll
            for (int j = 0; j < 8; ++j) ss += xn[i][j] * xn[i][j];
            if (!LAST) { *(float4*)(X + (size_t)row * D + col) = make_float4(xn[i][0], xn[i][1], xn[i][2], xn[i][3]); *(float4*)(X + (size_t)row * D + col + 4) = make_float4(xn[i][4], xn[i][5], xn[i][6], xn[i][7]); } }
        ss = wsum(ss);
        const float rs = rsqrtf(ss * (1.f / D) + EPS);
        if (LAST) {
#pragma unroll
            for (int i = 0; i < 4; ++i) { const int col = 8 * lane + 512 * i; const float4 g0 = *(const float4*)(gnext + col), g1 = *(const float4*)(gnext + col + 4);
                *(float4*)(out + (size_t)row * D + col) = make_float4(xn[i][0] * rs * g0.x, xn[i][1] * rs * g0.y, xn[i][2] * rs * g0.z, xn[i][3] * rs * g0.w);
                *(float4*)(out + (size_t)row * D + col + 4) = make_float4(xn[i][4] * rs * g1.x, xn[i][5] * rs * g1.y, xn[i][6] * rs * g1.z, xn[i][7] * rs * g1.w); }
        } else {
            const float* mn = MODn + (row < S ? 0 : NMOD);
#pragma unroll
            for (int i = 0; i < 4; ++i) { const int col = 8 * lane + 512 * i; float o[8];
#pragma unroll
                for (int j4 = 0; j4 < 2; ++j4) { const float4 g = *(const float4*)(gnext + col + 4 * j4), sh = *(const float4*)(mn + col + 4 * j4), sc = *(const float4*)(mn + D + col + 4 * j4);
                    o[4 * j4 + 0] = xn[i][4 * j4 + 0] * rs * g.x * (1.f + sc.x) + sh.x; o[4 * j4 + 1] = xn[i][4 * j4 + 1] * rs * g.y * (1.f + sc.y) + sh.y;
                    o[4 * j4 + 2] = xn[i][4 * j4 + 2] * rs * g.z * (1.f + sc.z) + sh.z; o[4 * j4 + 3] = xn[i][4 * j4 + 3] * rs * g.w * (1.f + sc.w) + sh.w; }
                uint4 p; p.x = pk2(o[0], o[1]); p.y = pk2(o[2], o[3]); p.z = pk2(o[4], o[5]); p.w = pk2(o[6], o[7]); *(uint4*)(Hn + (size_t)row * D + col) = p; }
        }
    }
}
__device__ __forceinline__ void quant_rows_phase(const float* __restrict__ src, unsigned char* __restrict__ dst, float* __restrict__ scl, int nrows, int c2, int G2, int tid) {
    const int wave = tid >> 6, lane = tid & 63;
    for (int row = c2 * 8 + wave; row < nrows; row += G2 * 8) {
        const float4* sp = (const float4*)(src + (size_t)row * D) + lane;
        float4 v[8]; float mx = 0.f;
#pragma unroll
        for (int i = 0; i < 8; ++i) { v[i] = sp[64 * i]; mx = fmaxf(mx, fmaxf(fmaxf(fabsf(v[i].x), fabsf(v[i].y)), fmaxf(fabsf(v[i].z), fabsf(v[i].w)))); }
        mx = wmax(mx);
        const float s = mx > 0.f ? mx * (1.f / 127.f) : 1.f, inv = 1.f / s;
#pragma unroll
        for (int i = 0; i < 8; ++i) {
            const unsigned b0 = (unsigned)(__float2int_rn(v[i].x * inv) + 128), b1 = (unsigned)(__float2int_rn(v[i].y * inv) + 128), b2 = (unsigned)(__float2int_rn(v[i].z * inv) + 128), b3 = (unsigned)(__float2int_rn(v[i].w * inv) + 128);
            *(unsigned*)(dst + (size_t)row * D + 4 * lane + 256 * i) = (b0 & 255u) | ((b1 & 255u) << 8) | ((b2 & 255u) << 16) | ((b3 & 255u) << 24);
        }
        if (lane == 0) scl[row] = s;
    }
}
__device__ __forceinline__ void ub16(const uint4 w, float (&f)[16]) {
    f[0] = (float)(w.x & 0xffu); f[1] = (float)((w.x >> 8) & 0xffu); f[2] = (float)((w.x >> 16) & 0xffu); f[3] = (float)(w.x >> 24);
    f[4] = (float)(w.y & 0xffu); f[5] = (float)((w.y >> 8) & 0xffu); f[6] = (float)((w.y >> 16) & 0xffu); f[7] = (float)(w.y >> 24);
    f[8] = (float)(w.z & 0xffu); f[9] = (float)((w.z >> 8) & 0xffu); f[10] = (float)((w.z >> 16) & 0xffu); f[11] = (float)(w.z >> 24);
    f[12] = (float)(w.w & 0xffu); f[13] = (float)((w.w >> 8) & 0xffu); f[14] = (float)((w.w >> 16) & 0xffu); f[15] = (float)(w.w >> 24);
}
template <bool LAST>
__device__ __forceinline__ void peer_expert_q8_phase(const bf16_t* __restrict__ HS, const int* __restrict__ IDX, const float* __restrict__ GWT, const unsigned char* __restrict__ UQ, const unsigned char* __restrict__ VQ,
                                                     const float* __restrict__ SU, const float* __restrict__ SV, const float* __restrict__ MODl, float* __restrict__ X, const float* __restrict__ gnext,
                                                     const float* __restrict__ MODn, bf16_t* __restrict__ Hn, float* __restrict__ out, int rows, int tid) {
    const int wave = tid >> 6, lane = tid & 63;
    for (int row = blockIdx.x * 8 + wave; row < rows; row += grid_x() * 8) {
        float h[2][16], acc[2][16]; float hs = 0.f, accb = 0.f;
#pragma unroll
        for (int i = 0; i < 2; ++i) { const bf16_t* hp = HS + (size_t)row * (2 * D) + 16 * lane + 1024 * i;
#pragma unroll
            for (int c = 0; c < 2; ++c) { float a[8], b[8]; unpack8(*(const uint4*)(hp + 8 * c), a); unpack8(*(const uint4*)(hp + D + 8 * c), b);
#pragma unroll
                for (int j = 0; j < 8; ++j) { h[i][8 * c + j] = a[j] + b[j]; hs += a[j] + b[j]; acc[i][8 * c + j] = 0.f; } } }
        hs = wsum(hs) * 128.f;
        const int idx_lo = IDX[(size_t)row * 128 + lane], idx_hi = IDX[(size_t)row * 128 + 64 + lane];
        const float gw_lo = GWT[(size_t)row * 128 + lane], gw_hi = GWT[(size_t)row * 128 + 64 + lane];
        for (int j0 = 0; j0 < 128; j0 += 8) {
            int e[8]; float w[8], d[8];
#pragma unroll
            for (int k = 0; k < 8; ++k) { const int j = j0 + k;
                e[k] = j0 < 64 ? __builtin_amdgcn_readlane(idx_lo, j & 63) : __builtin_amdgcn_readlane(idx_hi, j & 63);
                w[k] = __uint_as_float(j0 < 64 ? __builtin_amdgcn_readlane(__float_as_uint(gw_lo), j & 63) : __builtin_amdgcn_readlane(__float_as_uint(gw_hi), j & 63)); }
            uint4 ur[8][2];
#pragma unroll
            for (int k = 0; k < 8; ++k) { const uint4* up = (const uint4*)(UQ + (size_t)e[k] * D) + lane; ur[k][0] = up[0]; ur[k][1] = up[64]; }
#pragma unroll
            for (int k = 0; k < 8; ++k) { float s = 0.f;
#pragma unroll
                for (int i = 0; i < 2; ++i) { float f[16]; ub16(ur[k][i], f);
#pragma unroll
                    for (int j = 0; j < 16; ++j) s += h[i][j] * f[j]; }
                d[k] = s; }
            asm volatile("" : "+v"(d[0]), "+v"(d[1]), "+v"(d[2]), "+v"(d[3]), "+v"(d[4]), "+v"(d[5]), "+v"(d[6]), "+v"(d[7]) :: "memory");
            uint4 vr[8][2];
#pragma unroll
            for (int k = 0; k < 8; ++k) { const uint4* vp = (const uint4*)(VQ + (size_t)e[k] * D) + lane; vr[k][0] = vp[0]; vr[k][1] = vp[64]; }
#pragma unroll
            for (int k = 0; k < 8; ++k) d[k] = wsum(d[k]);
#pragma unroll
            for (int k = 0; k < 8; ++k) { const float dd = (d[k] - hs) * SU[e[k]]; const float c = gelu_fast(dd) * w[k] * SV[e[k]]; accb += 128.f * c;
#pragma unroll
                for (int i = 0; i < 2; ++i) { float f[16]; ub16(vr[k][i], f);
#pragma unroll
                    for (int j = 0; j < 16; ++j) acc[i][j] += c * f[j]; } }
        }
        const float* md = MODl + (row < S ? 0 : NMOD) + 5 * D;
        float ss = 0.f;
#pragma unroll
        for (int i = 0; i < 2; ++i)
#pragma unroll
            for (int c4 = 0; c4 < 4; ++c4) { const int col = 16 * lane + 1024 * i + 4 * c4; const float4 g = *(const float4*)(md + col); const float4 x0 = *(const float4*)(X + (size_t)row * D + col);
                float* a = &acc[i][4 * c4];
                a[0] = x0.x + g.x * (a[0] - accb); a[1] = x0.y + g.y * (a[1] - accb); a[2] = x0.z + g.z * (a[2] - accb); a[3] = x0.w + g.w * (a[3] - accb);
                ss += a[0] * a[0] + a[1] * a[1] + a[2] * a[2] + a[3] * a[3];
                if (!LAST) *(float4*)(X + (size_t)row * D + col) = make_float4(a[0], a[1], a[2], a[3]); }
        ss = wsum(ss);
        const float rs = rsqrtf(ss * (1.f / D) + EPS);
        if (LAST) {
#pragma unroll
            for (int i = 0; i < 2; ++i)
#pragma unroll
                for (int c4 = 0; c4 < 4; ++c4) { const int col = 16 * lane + 1024 * i + 4 * c4; const float4 g = *(const float4*)(gnext + col); const float* a = &acc[i][4 * c4];
                    *(float4*)(out + (size_t)row * D + col) = make_float4(a[0] * rs * g.x, a[1] * rs * g.y, a[2] * rs * g.z, a[3] * rs * g.w); }
        } else {
            const float* mn = MODn + (row < S ? 0 : NMOD);
#pragma unroll
            for (int i = 0; i < 2; ++i)
#pragma unroll
                for (int c8 = 0; c8 < 2; ++c8) { const int col = 16 * lane + 1024 * i + 8 * c8; float o[8];
#pragma unroll
                    for (int j4 = 0; j4 < 2; ++j4) { const float4 g = *(const float4*)(gnext + col + 4 * j4), sh = *(const float4*)(mn + col + 4 * j4), sc = *(const float4*)(mn + D + col + 4 * j4); const float* a = &acc[i][8 * c8 + 4 * j4];
                        o[4 * j4 + 0] = a[0] * rs * g.x * (1.f + sc.x) + sh.x; o[4 * j4 + 1] = a[1] * rs * g.y * (1.f + sc.y) + sh.y; o[4 * j4 + 2] = a[2] * rs * g.z * (1.f + sc.z) + sh.z; o[4 * j4 + 3] = a[3] * rs * g.w * (1.f + sc.w) + sh.w; }
                    uint4 p; p.x = pk2(o[0], o[1]); p.y = pk2(o[2], o[3]); p.z = pk2(o[4], o[5]); p.w = pk2(o[6], o[7]); *(uint4*)(Hn + (size_t)row * D + col) = p; }
        }
    }
}
#define XB_TMO      128
#define XB_XCNT(j)  (256  + 64 * (j))
#define XB_XSUB(j)  (1280 + 64 * (j))
#define XB_XGEN(j)  (2304 + 64 * (j))
#define XB_TOP      3328
#define XB_TOPGEN   3392
#define XCD_BAR_WORDS 3456
#define XB_SPIN_CAP (1u << 22)
#define LAS __attribute__((address_space(3)))
__device__ __forceinline__ unsigned xb_ld(unsigned* p)              { return __hip_atomic_load(p, __ATOMIC_RELAXED, __HIP_MEMORY_SCOPE_AGENT); }
__device__ __forceinline__ unsigned xb_add(unsigned* p, unsigned v) { return __hip_atomic_fetch_add(p, v, __ATOMIC_RELAXED, __HIP_MEMORY_SCOPE_AGENT); }
__device__ __forceinline__ unsigned xb_xcc_id() { return (unsigned)__builtin_amdgcn_s_getreg((3 << 11) | 20) & 0xFu; }
#define XB_SPIN(cond, bar) do { unsigned _sp = 0; while (cond) { __builtin_amdgcn_s_sleep(1); \
    if ((++_sp & 255u) == 0u) { if (xb_ld(&(bar)[XB_TMO])) break; if (_sp > XB_SPIN_CAP) { atomicAdd(&(bar)[XB_TMO], 1u); break; } } } } while (0)
struct XcdBarrier { unsigned* bar; unsigned x; volatile LAS unsigned* st; };
__device__ __forceinline__ XcdBarrier xcd_barrier_post(unsigned* bar, volatile LAS unsigned* st) {
    XcdBarrier b; b.bar = bar; b.x = xb_xcc_id(); b.st = st;
    if (threadIdx.x == 0) (void)xb_add(&bar[XB_XCNT(b.x)], 1u);
    return b;
}
__device__ __forceinline__ void xcd_barrier_complete(unsigned* bar, unsigned x, unsigned& nloc, unsigned& nx) {
    const unsigned G = (unsigned)grid_x();
    unsigned sum, cnt, mine, sp = 0u;
    for (;;) {
        sum = 0u; cnt = 0u; mine = 0u;
#pragma unroll
        for (unsigned j = 0; j < 16; ++j) { const unsigned c = xb_ld(&bar[XB_XCNT(j)]); sum += c; cnt += (c > 0u) ? 1u : 0u; mine = (j == x) ? c : mine; }
        if (sum == G) break;
        __builtin_amdgcn_s_sleep(1);
        if ((++sp & 255u) == 0u) { if (xb_ld(&bar[XB_TMO])) break; if (sp > XB_SPIN_CAP) { atomicAdd(&bar[XB_TMO], 1u); break; } }
    }
    nloc = mine > 0u ? mine : 1u; nx = cnt > 0u ? cnt : 1u;
}
__device__ __forceinline__ void xcd_barrier(const XcdBarrier& b) {
    asm volatile("s_waitcnt vmcnt(0)" ::: "memory");
    __syncthreads();
    if (threadIdx.x == 0) {
        unsigned* bar = b.bar; unsigned bx = b.x; asm volatile("" : "+s"(bar), "+s"(bx));
        __builtin_amdgcn_s_waitcnt(0);
        unsigned nloc = b.st[0], nx = b.st[1];
        if (nloc == 0u) { xcd_barrier_complete(bar, bx, nloc, nx); b.st[0] = nloc; b.st[1] = nx; }
        const unsigned old = xb_add(&bar[XB_XSUB(bx)], 1u);
        const unsigned gen = old / nloc;
        if (old + 1u == (gen + 1u) * nloc) {
            __builtin_amdgcn_fence(__ATOMIC_RELEASE, "agent");
            asm volatile("s_waitcnt vmcnt(0)" ::: "memory");
            const unsigned og = xb_add(&bar[XB_TOP], 1u);
            const unsigned tg = og / nx;
            if (og + 1u == (tg + 1u) * nx) xb_add(&bar[XB_TOPGEN], 1u);
            else XB_SPIN(xb_ld(&bar[XB_TOPGEN]) == tg, bar);
            __builtin_amdgcn_fence(__ATOMIC_ACQUIRE, "agent");
            xb_add(&bar[XB_XGEN(bx)], 1u);
            asm volatile("s_waitcnt vmcnt(0)" ::: "memory");
        } else {
            XB_SPIN(xb_ld(&bar[XB_XGEN(bx)]) == gen, bar);
            __builtin_amdgcn_fence(__ATOMIC_ACQUIRE, "agent");
            asm volatile("s_waitcnt vmcnt(0)" ::: "memory");
        }
    }
    __syncthreads();
}

template <bool SIGNED>
__device__ __forceinline__ void quant_rows_sliced_phase(const float* __restrict__ src, unsigned char* __restrict__ dst, float* __restrict__ scl, int nrows, int c2, int G2, int tid) {
    const int wave = tid >> 6, lane = tid & 63;
    for (int row = c2 * 8 + wave; row < nrows; row += G2 * 8) {
        const float4* sp = (const float4*)(src + (size_t)row * D) + lane;
        float4 v[8]; float mx = 0.f;
#pragma unroll
        for (int i = 0; i < 8; ++i) { v[i] = sp[64 * i]; mx = fmaxf(mx, fmaxf(fmaxf(fabsf(v[i].x), fabsf(v[i].y)), fmaxf(fabsf(v[i].z), fabsf(v[i].w)))); }
        mx = wmax(mx);
        const float s = mx > 0.f ? mx * (1.f / 127.f) : 1.f, inv = 1.f / s;
#pragma unroll
        for (int i = 0; i < 8; ++i) {
            constexpr int OFS = SIGNED ? 0 : 128; const unsigned b0 = (unsigned)(__float2int_rn(v[i].x * inv) + OFS), b1 = (unsigned)(__float2int_rn(v[i].y * inv) + OFS), b2 = (unsigned)(__float2int_rn(v[i].z * inv) + OFS), b3 = (unsigned)(__float2int_rn(v[i].w * inv) + OFS);
            const int slice = 2 * i + (lane >> 5), cin = (4 * lane) & 127;
            *(unsigned*)(dst + ((size_t)slice * 16384 + row) * 128 + cin) = (b0 & 255u) | ((b1 & 255u) << 8) | ((b2 & 255u) << 16) | ((b3 & 255u) << 24);
        }
        if (lane == 0) scl[row] = s;
    }
}
struct SliceDeal { int x, nx, r, R; __device__ __forceinline__ void init() {
    unsigned base = ARG_OFF; asm volatile("" : "+v"(base)); const __attribute__((address_space(3))) unsigned* p = (const __attribute__((address_space(3))) unsigned*)(size_t)base;
    unsigned a = p[51], b = p[52], c = p[53], d = p[54]; asm volatile("" : "+v"(a), "+v"(b), "+v"(c), "+v"(d));
    r = (int)__builtin_amdgcn_readfirstlane(a); x = (int)__builtin_amdgcn_readfirstlane(b); nx = (int)__builtin_amdgcn_readfirstlane(c); R = (int)__builtin_amdgcn_readfirstlane(d); } };
typedef _Float16 hf2 __attribute__((ext_vector_type(2)));
typedef unsigned uv4 __attribute__((ext_vector_type(4))); typedef float fv4 __attribute__((ext_vector_type(4)));
typedef __attribute__((address_space(1))) uv4 GU4; typedef __attribute__((address_space(1))) float GF32; typedef __attribute__((address_space(1))) fv4 GF4;
__device__ __forceinline__ uint4 ldg4(const void* p) { const uv4 v = *(const GU4*)p; return make_uint4(v.x, v.y, v.z, v.w); }
__device__ __forceinline__ float4 ldgf4(const void* p) { const fv4 v = *(const GF4*)p; return make_float4(v.x, v.y, v.z, v.w); }
template <int CTRL> __device__ __forceinline__ float dppmov(float v) { return __builtin_bit_cast(float, __builtin_amdgcn_update_dpp(0, __builtin_bit_cast(int, v), CTRL, 0xF, 0xF, true)); }
__device__ __forceinline__ float sum8(float p) { p += dppmov<0xB1>(p); p += dppmov<0x4E>(p); p += dppmov<0x141>(p); return p; }
__device__ __forceinline__ float sum_x8_16_32(float a) { a += dppmov<0x128>(a);
    { auto r = __builtin_amdgcn_permlane16_swap(__builtin_bit_cast(unsigned, a), __builtin_bit_cast(unsigned, a), false, false); a = __builtin_bit_cast(float, r[0]) + __builtin_bit_cast(float, r[1]); }
    { auto r = __builtin_amdgcn_permlane32_swap(__builtin_bit_cast(unsigned, a), __builtin_bit_cast(unsigned, a), false, false); a = __builtin_bit_cast(float, r[0]) + __builtin_bit_cast(float, r[1]); }
    return a; }
struct UItem { int s, row; };
__device__ __forceinline__ UItem u_item(int k, int n, int nrw, const SliceDeal& sd, int wave) { const int kk = k < n ? k : n - 1; UItem it; it.s = sd.x + (kk / nrw) * sd.nx; it.row = sd.r * 8 + wave + (kk % nrw) * sd.R * 8; return it; }
template <unsigned EMASK>
__device__ __forceinline__ void peer_u_pass(const signed char* __restrict__ HQ, const int* __restrict__ IDX, const unsigned char* __restrict__ UQ, int* __restrict__ PART, int rows, int tid) {
    const int wave = __builtin_amdgcn_readfirstlane(tid >> 6), lane = tid & 63, g = lane >> 3, c8 = lane & 7;
    SliceDeal sd; sd.init();
    const int first = sd.r * 8 + wave, stepw = sd.R * 8;
    const int nrw = first < rows ? (rows - first + stepw - 1) / stepw : 0, nsl = sd.x < 16 ? (16 - sd.x + sd.nx - 1) / sd.nx : 0, n = nrw * nsl;
    if (n == 0) return;
    uint4 hrA, hrB, idg; uint4 er[4]; uint4 tA[16], tB[16];
    typedef __attribute__((address_space(3))) uv4 L4;
    const unsigned wl = (unsigned)wave * 512u, wr_id = wl + 16u * (lane & 31), rd_id = wl + 64u * g;
#define U_GLOAD(IT) do { idg = ldg4(IDX + (size_t)(IT).row * 128 + 4 * (lane & 31)); } while (0)
#define U_LDS_E() do { *(L4*)(size_t)wr_id = (uv4){idg.x, idg.y, idg.z, idg.w}; _Pragma("unroll") for (int i_ = 0; i_ < 4; ++i_) { const uv4 v_ = *(const L4*)(size_t)(rd_id + 16u * i_); er[i_] = make_uint4(v_.x, v_.y, v_.z, v_.w); } } while (0)
#define U_LOAD_H(HR, IT) do { HR = ldg4(HQ + (size_t)(IT).row * D + 128 * (IT).s + 16 * c8); } while (0)
#define U_LOAD_T(T, IT) do { const unsigned char* us_ = UQ + (size_t)(IT).s * 16384 * 128 + 16 * c8; _Pragma("unroll") for (int i_ = 0; i_ < 4; ++i_) { \
        T[4 * i_] = ldg4(us_ + (er[i_].x & EMASK) * 128u); T[4 * i_ + 1] = ldg4(us_ + (er[i_].y & EMASK) * 128u); T[4 * i_ + 2] = ldg4(us_ + (er[i_].z & EMASK) * 128u); T[4 * i_ + 3] = ldg4(us_ + (er[i_].w & EMASK) * 128u); } } while (0)
#define U_STEP(HRC, TC, HRN, TN) do { \
        U_LDS_E(); U_GLOAD(itn2); U_LOAD_H(HRN, itn); \
        const unsigned char* us_ = UQ + (size_t)itn.s * 16384 * 128 + 16 * c8; const unsigned e_[16] = {er[0].x, er[0].y, er[0].z, er[0].w, er[1].x, er[1].y, er[1].z, er[1].w, er[2].x, er[2].y, er[2].z, er[2].w, er[3].x, er[3].y, er[3].z, er[3].w}; \
        int keep0_ = 0, keep1_ = 0; \
        _Pragma("unroll") for (int i_ = 0; i_ < 16; ++i_) { \
            TN[i_] = ldg4(us_ + (e_[i_] & EMASK) * 128u); \
            int p_ = __builtin_amdgcn_sdot4((int)TC[i_].x, (int)HRC.x, 0, false); p_ = __builtin_amdgcn_sdot4((int)TC[i_].y, (int)HRC.y, p_, false); \
            p_ = __builtin_amdgcn_sdot4((int)TC[i_].z, (int)HRC.z, p_, false); p_ = __builtin_amdgcn_sdot4((int)TC[i_].w, (int)HRC.w, p_, false); \
            p_ += __builtin_amdgcn_update_dpp(0, p_, 0xB1, 0xF, 0xF, true); p_ += __builtin_amdgcn_update_dpp(0, p_, 0x4E, 0xF, 0xF, true); p_ += __builtin_amdgcn_update_dpp(0, p_, 0x141, 0xF, 0xF, true); \
            if ((i_ & 7) == c8) { if (i_ < 8) keep0_ = p_; else keep1_ = p_; } \
            __builtin_amdgcn_sched_barrier(0); } \
        typedef int i2_ __attribute__((ext_vector_type(2))); \
        *(__attribute__((address_space(1))) i2_*)(PART + ((size_t)itc.s * rows + itc.row) * 128 + 16 * g + 2 * c8) = (i2_){keep0_, keep1_}; \
        __builtin_amdgcn_sched_barrier(0); \
        asm volatile("" :: "v"(idg.x), "v"(HRN.x));     \
        __builtin_amdgcn_sched_barrier(0); \
        itc = itn; itn = itn2; } while (0)
    UItem itc = u_item(0, n, nrw, sd, wave), itn = u_item(1, n, nrw, sd, wave), itn2;
    U_GLOAD(itc); U_LDS_E();
    __builtin_amdgcn_sched_barrier(0);
    U_GLOAD(itn); U_LOAD_H(hrA, itc);
    __builtin_amdgcn_sched_barrier(0);
    U_LOAD_T(tA, itc);
    __builtin_amdgcn_sched_barrier(0);
    { const UItem ita = u_item(2, n, nrw, sd, wave), itb = u_item(3, n, nrw, sd, wave);
      __builtin_amdgcn_sched_barrier(0);
      itn2 = ita; U_STEP(hrA, tA, hrB, tB);
      itn2 = itb; U_STEP(hrB, tB, hrA, tA); }
    for (int k = 2; k < n; k += 2) {
        const UItem ita = u_item(k + 2, n, nrw, sd, wave), itb = u_item(k + 3, n, nrw, sd, wave);
        __builtin_amdgcn_sched_barrier(0);
        itn2 = ita;
        U_STEP(hrA, tA, hrB, tB);
        itn2 = itb;
        U_STEP(hrB, tB, hrA, tA);
    }
#undef U_GLOAD
#undef U_LDS_E
#undef U_LOAD_H
#undef U_LOAD_T
#undef U_STEP
}
__device__ __forceinline__ void peer_coef_pass(const int* __restrict__ PART, const int* __restrict__ IDX, const float* __restrict__ GWT, const float* __restrict__ SU, const float* __restrict__ SV,
                                               const float* __restrict__ SH, signed char* __restrict__ COEFQ, float* __restrict__ CS, int rows, int tid) {
    const int wave = tid >> 6, lane = tid & 63, j0 = 16 * (lane >> 3) + (lane & 7), j1 = j0 + 8;
    for (int row = blockIdx.x * 8 + wave; row < rows; row += grid_x() * 8) {
        const size_t i = (size_t)row * 128;
        int d0 = 0, d1 = 0;
#pragma unroll
        for (int s = 0; s < 16; ++s) { const int2 v = *(const int2*)(PART + (size_t)s * rows * 128 + i + 2 * lane); d0 += v.x; d1 += v.y; }
        const int e0 = IDX[i + j0], e1 = IDX[i + j1]; const float sh = SH[row];
        const float c0 = gelu_fast((float)d0 * SU[e0] * sh) * GWT[i + j0] * SV[e0], c1 = gelu_fast((float)d1 * SU[e1] * sh) * GWT[i + j1] * SV[e1];
        const float mx = wmax(fmaxf(fabsf(c0), fabsf(c1)));
        const float sc = mx > 0.f ? mx * (1.f / 16383.f) : 1.f, inv = 1.f / sc;
        const int q0 = __float2int_rn(c0 * inv), q1 = __float2int_rn(c1 * inv);
        signed char* cq = COEFQ + (size_t)row * 256;
        cq[j0] = (signed char)(q0 >> 7); cq[j1] = (signed char)(q1 >> 7); cq[128 + j0] = (signed char)(q0 & 127); cq[128 + j1] = (signed char)(q1 & 127);
        if (lane == 0) CS[row] = sc;
    }
}
typedef unsigned uv2_ __attribute__((ext_vector_type(2))); typedef int v4i_ __attribute__((ext_vector_type(4)));
__device__ __forceinline__ void peer_v_pass(const signed char* __restrict__ COEFQ, const float* __restrict__ CS, const int* __restrict__ IDX, const unsigned char* __restrict__ VQ, float* __restrict__ F, int rows, int tid) {
    const int wave = __builtin_amdgcn_readfirstlane(tid >> 6), lane = tid & 63, n16 = lane & 15, kg = lane >> 4, rsel = n16 >> 3, c8 = n16 & 7;
    SliceDeal sd; sd.init();
    const int npairs = rows >> 1, first = sd.r * 8 + wave, stepw = sd.R * 8;
    const int nrw = first < npairs ? (npairs - first + stepw - 1) / stepw : 0, nsl = sd.x < 16 ? (16 - sd.x + sd.nx - 1) / sd.nx : 0, n = nrw * nsl;
    if (n == 0) return;
    uint4 rawA[8], rawB[8], ee[2], idg, cfg; uv2_ aq; v4i_ acc[16]; unsigned tr[32];
    const int arow = n16 & 3;
    typedef __attribute__((address_space(3))) uv4 L4; typedef __attribute__((address_space(3))) uv2_ L2_;
    const unsigned wl = (unsigned)wave * 3072u, wr_id = 16u * lane, wr_cf = 1024u + 16u * (lane & 31), rd_id = (unsigned)rsel * 512u + 128u * kg, rd_cf = 1024u + (unsigned)(arow >> 1) * 256u + (unsigned)(arow & 1) * 128u + 32u * kg;
#define V_GLOAD(IT) do { idg = ldg4(IDX + (size_t)(2 * (IT).row) * 128 + 4 * lane); cfg = ldg4(COEFQ + (size_t)(2 * (IT).row) * 256 + 16 * (lane & 31)); } while (0)
#define V_LWRITE(SL) do { *(L4*)(size_t)(wl + (SL) + wr_id) = (uv4){idg.x, idg.y, idg.z, idg.w}; *(L4*)(size_t)(wl + (SL) + wr_cf) = (uv4){cfg.x, cfg.y, cfg.z, cfg.w}; } while (0)
#define V_LREAD(SL_E, Q_E, SL_A, Q_A) do { const uv4 a_ = *(const L4*)(size_t)(wl + (SL_E) + rd_id + 32u * (Q_E)), b_ = *(const L4*)(size_t)(wl + (SL_E) + rd_id + 32u * (Q_E) + 16u); \
        ee[0] = make_uint4(a_.x, a_.y, a_.z, a_.w); ee[1] = make_uint4(b_.x, b_.y, b_.z, b_.w); aq = *(const L2_*)(size_t)(wl + (SL_A) + rd_cf + 8u * (Q_A)); } while (0)
#define V_LOAD_T(RAW, IT) do { const unsigned char* vs_ = VQ + (size_t)(IT).s * 16384 * 128 + 16 * c8; \
        RAW[0] = ldg4(vs_ + ee[0].x * 128u); RAW[1] = ldg4(vs_ + ee[0].y * 128u); RAW[2] = ldg4(vs_ + ee[0].z * 128u); RAW[3] = ldg4(vs_ + ee[0].w * 128u); \
        RAW[4] = ldg4(vs_ + ee[1].x * 128u); RAW[5] = ldg4(vs_ + ee[1].y * 128u); RAW[6] = ldg4(vs_ + ee[1].z * 128u); RAW[7] = ldg4(vs_ + ee[1].w * 128u); } while (0)
#define V_T4(A_, B_, C_, D_, O_) do { const unsigned abl_ = __builtin_amdgcn_perm(B_, A_, 0x05010400u), abh_ = __builtin_amdgcn_perm(B_, A_, 0x07030602u), \
        cdl_ = __builtin_amdgcn_perm(D_, C_, 0x05010400u), cdh_ = __builtin_amdgcn_perm(D_, C_, 0x07030602u); \
        tr[(O_)] = __builtin_amdgcn_perm(cdl_, abl_, 0x05040100u); tr[(O_) + 2] = __builtin_amdgcn_perm(cdl_, abl_, 0x07060302u); \
        tr[(O_) + 4] = __builtin_amdgcn_perm(cdh_, abh_, 0x05040100u); tr[(O_) + 6] = __builtin_amdgcn_perm(cdh_, abh_, 0x07060302u); } while (0)
#define V_TRANS(RAW) do { V_T4(RAW[0].x, RAW[1].x, RAW[2].x, RAW[3].x, 0); V_T4(RAW[4].x, RAW[5].x, RAW[6].x, RAW[7].x, 1); V_T4(RAW[0].y, RAW[1].y, RAW[2].y, RAW[3].y, 8); V_T4(RAW[4].y, RAW[5].y, RAW[6].y, RAW[7].y, 9); \
        V_T4(RAW[0].z, RAW[1].z, RAW[2].z, RAW[3].z, 16); V_T4(RAW[4].z, RAW[5].z, RAW[6].z, RAW[7].z, 17); V_T4(RAW[0].w, RAW[1].w, RAW[2].w, RAW[3].w, 24); V_T4(RAW[4].w, RAW[5].w, RAW[6].w, RAW[7].w, 25); } while (0)
#define V_MMA(FIRST) do { const v4i_ vzero_ = {0, 0, 0, 0}; const uv2_ am_ = n16 < 4 ? aq : (uv2_){0u, 0u}; const long al_ = __builtin_bit_cast(long, am_); \
        _Pragma("unroll") for (int t_ = 0; t_ < 16; ++t_) { const long bl_ = __builtin_bit_cast(long, (uv2_){tr[2 * t_], tr[2 * t_ + 1]}); \
            acc[t_] = __builtin_amdgcn_mfma_i32_16x16x32_i8(al_, bl_, (FIRST) ? vzero_ : acc[t_], 0, 0, 0); } } while (0)
#define V_STEP(RAW, SL_E, Q_E, SL_A, Q_A, IT_T, FIRST) do { \
        V_LREAD(SL_E, Q_E, SL_A, Q_A); \
        V_TRANS(RAW); \
        __builtin_amdgcn_sched_barrier(0); \
        V_LOAD_T(RAW, IT_T); \
        __builtin_amdgcn_sched_barrier(0); \
        V_MMA(FIRST); \
        __builtin_amdgcn_sched_barrier(0); } while (0)
    UItem itc = u_item(0, n, nrw, sd, wave), itn = u_item(1, n, nrw, sd, wave);
    V_GLOAD(itc); V_LWRITE(0u);
    V_LREAD(0u, 0, 0u, 0); V_LOAD_T(rawA, itc);
    __builtin_amdgcn_sched_barrier(0);
    V_LREAD(0u, 1, 0u, 1); V_LOAD_T(rawB, itc);
    __builtin_amdgcn_sched_barrier(0);
    unsigned cur = 0u;
    for (int k = 0; k < n; ++k) {
        const unsigned nxt = 1536u - cur;
        V_GLOAD(itn);
        __builtin_amdgcn_sched_barrier(0);
        V_STEP(rawA, cur, 2, cur, 0, itc, true);
        V_STEP(rawB, cur, 3, cur, 1, itc, false);
        V_LWRITE(nxt);
        __builtin_amdgcn_sched_barrier(0);
        V_STEP(rawA, nxt, 0, cur, 2, itn, false);
        V_STEP(rawB, nxt, 1, cur, 3, itn, false);
        {
            typedef __attribute__((address_space(3))) fv4 LF4;
            const unsigned fs_ = 24576u + (unsigned)wave * 1024u;
            if (kg == 0) { const float cs_ = CS[2 * itc.row + rsel];
#pragma unroll
                for (int q4 = 0; q4 < 4; ++q4) { fv4 o_;
#pragma unroll
                    for (int tt = 0; tt < 4; ++tt) { const v4i_ a_ = acc[4 * q4 + tt]; const int hv_ = rsel ? a_.z : a_.x, lv_ = rsel ? a_.w : a_.y; o_[tt] = (float)(hv_ * 128 + lv_) * cs_; }
                    *(LF4*)(size_t)(fs_ + (unsigned)n16 * 64u + 16u * q4) = o_; } }
            const fv4 w_ = *(const LF4*)(size_t)(fs_ + 16u * lane);
            *(GF4*)(F + (size_t)(2 * itc.row + (lane >> 5)) * D + 128 * itc.s + 4 * (lane & 31)) = w_;
        }
        __builtin_amdgcn_sched_barrier(0);
        itc = itn; itn = u_item(k + 2, n, nrw, sd, wave); cur = nxt;
    }
#undef V_GLOAD
#undef V_LWRITE
#undef V_LREAD
#undef V_LOAD_T
#undef V_T4
#undef V_TRANS
#undef V_MMA
#undef V_STEP
}
template <bool LAST>
__device__ __forceinline__ void peer_row_pass(float* __restrict__ X, const float* __restrict__ F, const float* __restrict__ MODl, const float* __restrict__ gnext, const float* __restrict__ MODn,
                                              bf16_t* __restrict__ Hn, float* __restrict__ out, int rows, int tid) {
    const int wave = tid >> 6, lane = tid & 63;
    for (int row = blockIdx.x * 8 + wave; row < rows; row += grid_x() * 8) {
        const float* md = MODl + (row < S ? 0 : NMOD) + 5 * D;
        float4 v[8]; float ss = 0.f;
#pragma unroll
        for (int i = 0; i < 8; ++i) { const int col = 4 * lane + 256 * i; const float4 x = *(const float4*)(X + (size_t)row * D + col), f = *(const float4*)(F + (size_t)row * D + col), g2 = *(const float4*)(md + col);
            v[i] = make_float4(x.x + g2.x * f.x, x.y + g2.y * f.y, x.z + g2.z * f.z, x.w + g2.w * f.w);
            ss += v[i].x * v[i].x + v[i].y * v[i].y + v[i].z * v[i].z + v[i].w * v[i].w;
            if (!LAST) *(float4*)(X + (size_t)row * D + col) = v[i]; }
        ss = wsum(ss);
        const float rs = rsqrtf(ss * (1.f / D) + EPS);
        const float* mn = LAST ? nullptr : MODn + (row < S ? 0 : NMOD);
#pragma unroll
        for (int i = 0; i < 8; ++i) { const int col = 4 * lane + 256 * i; const float4 g = *(const float4*)(gnext + col);
            if (LAST) *(float4*)(out + (size_t)row * D + col) = make_float4(v[i].x * rs * g.x, v[i].y * rs * g.y, v[i].z * rs * g.z, v[i].w * rs * g.w);
            else { const float4 sh = *(const float4*)(mn + col), sc = *(const float4*)(mn + D + col);
                uint2 p; p.x = pk2(v[i].x * rs * g.x * (1.f + sc.x) + sh.x, v[i].y * rs * g.y * (1.f + sc.y) + sh.y); p.y = pk2(v[i].z * rs * g.z * (1.f + sc.z) + sh.z, v[i].w * rs * g.w * (1.f + sc.w) + sh.w);
                *(uint2*)(Hn + (size_t)row * D + col) = p; } }
    }
}
__device__ __forceinline__ void keys_split_phase(const float* __restrict__ keys, bf16_t* __restrict__ KS, int n_rows, int tid) {
    for (int i = blockIdx.x * 512 + tid; i < n_rows * 32; i += grid_x() * 512) {
        const int row = i >> 5, c4 = (i & 31) * 4; const float4 v = *(const float4*)(keys + (size_t)row * 128 + c4);
        uint2 h; h.x = pk2(v.x, v.y); h.y = pk2(v.z, v.w);
        uint2 lo; lo.x = pk2(v.x - bf2f(h.x), v.y - bf2f(h.x >> 16)); lo.y = pk2(v.z - bf2f(h.y), v.w - bf2f(h.y >> 16));
        *(uint2*)(KS + (size_t)row * 256 + c4) = h; *(uint2*)(KS + (size_t)row * 256 + 128 + c4) = lo;
    }
}
#define SORT16_DESC(K) do { \
    { const unsigned hi_ = max(K[0], K[1]), lo_ = min(K[0], K[1]); K[0] = hi_; K[1] = lo_; } \
    { const unsigned hi_ = max(K[3], K[2]), lo_ = min(K[3], K[2]); K[3] = hi_; K[2] = lo_; } \
    { const unsigned hi_ = max(K[4], K[5]), lo_ = min(K[4], K[5]); K[4] = hi_; K[5] = lo_; } \
    { const unsigned hi_ = max(K[7], K[6]), lo_ = min(K[7], K[6]); K[7] = hi_; K[6] = lo_; } \
    { const unsigned hi_ = max(K[8], K[9]), lo_ = min(K[8], K[9]); K[8] = hi_; K[9] = lo_; } \
    { const unsigned hi_ = max(K[11], K[10]), lo_ = min(K[11], K[10]); K[11] = hi_; K[10] = lo_; } \
    { const unsigned hi_ = max(K[12], K[13]), lo_ = min(K[12], K[13]); K[12] = hi_; K[13] = lo_; } \
    { const unsigned hi_ = max(K[15], K[14]), lo_ = min(K[15], K[14]); K[15] = hi_; K[14] = lo_; } \
    { const unsigned hi_ = max(K[0], K[2]), lo_ = min(K[0], K[2]); K[0] = hi_; K[2] = lo_; } \
    { const unsigned hi_ = max(K[1], K[3]), lo_ = min(K[1], K[3]); K[1] = hi_; K[3] = lo_; } \
    { const unsigned hi_ = max(K[6], K[4]), lo_ = min(K[6], K[4]); K[6] = hi_; K[4] = lo_; } \
    { const unsigned hi_ = max(K[7], K[5]), lo_ = min(K[7], K[5]); K[7] = hi_; K[5] = lo_; } \
    { const unsigned hi_ = max(K[8], K[10]), lo_ = min(K[8], K[10]); K[8] = hi_; K[10] = lo_; } \
    { const unsigned hi_ = max(K[9], K[11]), lo_ = min(K[9], K[11]); K[9] = hi_; K[11] = lo_; } \
    { const unsigned hi_ = max(K[14], K[12]), lo_ = min(K[14], K[12]); K[14] = hi_; K[12] = lo_; } \
    { const unsigned hi_ = max(K[15], K[13]), lo_ = min(K[15], K[13]); K[15] = hi_; K[13] = lo_; } \
    { const unsigned hi_ = max(K[0], K[1]), lo_ = min(K[0], K[1]); K[0] = hi_; K[1] = lo_; } \
    { const unsigned hi_ = max(K[2], K[3]), lo_ = min(K[2], K[3]); K[2] = hi_; K[3] = lo_; } \
    { const unsigned hi_ = max(K[5], K[4]), lo_ = min(K[5], K[4]); K[5] = hi_; K[4] = lo_; } \
    { const unsigned hi_ = max(K[7], K[6]), lo_ = min(K[7], K[6]); K[7] = hi_; K[6] = lo_; } \
    { const unsigned hi_ = max(K[8], K[9]), lo_ = min(K[8], K[9]); K[8] = hi_; K[9] = lo_; } \
    { const unsigned hi_ = max(K[10], K[11]), lo_ = min(K[10], K[11]); K[10] = hi_; K[11] = lo_; } \
    { const unsigned hi_ = max(K[13], K[12]), lo_ = min(K[13], K[12]); K[13] = hi_; K[12] = lo_; } \
    { const unsigned hi_ = max(K[15], K[14]), lo_ = min(K[15], K[14]); K[15] = hi_; K[14] = lo_; } \
    { const unsigned hi_ = max(K[0], K[4]), lo_ = min(K[0], K[4]); K[0] = hi_; K[4] = lo_; } \
    { const unsigned hi_ = max(K[1], K[5]), lo_ = min(K[1], K[5]); K[1] = hi_; K[5] = lo_; } \
    { const unsigned hi_ = max(K[2], K[6]), lo_ = min(K[2], K[6]); K[2] = hi_; K[6] = lo_; } \
    { const unsigned hi_ = max(K[3], K[7]), lo_ = min(K[3], K[7]); K[3] = hi_; K[7] = lo_; } \
    { const unsigned hi_ = max(K[12], K[8]), lo_ = min(K[12], K[8]); K[12] = hi_; K[8] = lo_; } \
    { const unsigned hi_ = max(K[13], K[9]), lo_ = min(K[13], K[9]); K[13] = hi_; K[9] = lo_; } \
    { const unsigned hi_ = max(K[14], K[10]), lo_ = min(K[14], K[10]); K[14] = hi_; K[10] = lo_; } \
    { const unsigned hi_ = max(K[15], K[11]), lo_ = min(K[15], K[11]); K[15] = hi_; K[11] = lo_; } \
    { const unsigned hi_ = max(K[0], K[2]), lo_ = min(K[0], K[2]); K[0] = hi_; K[2] = lo_; } \
    { const unsigned hi_ = max(K[1], K[3]), lo_ = min(K[1], K[3]); K[1] = hi_; K[3] = lo_; } \
    { const unsigned hi_ = max(K[4], K[6]), lo_ = min(K[4], K[6]); K[4] = hi_; K[6] = lo_; } \
    { const unsigned hi_ = max(K[5], K[7]), lo_ = min(K[5], K[7]); K[5] = hi_; K[7] = lo_; } \
    { const unsigned hi_ = max(K[10], K[8]), lo_ = min(K[10], K[8]); K[10] = hi_; K[8] = lo_; } \
    { const unsigned hi_ = max(K[11], K[9]), lo_ = min(K[11], K[9]); K[11] = hi_; K[9] = lo_; } \
    { const unsigned hi_ = max(K[14], K[12]), lo_ = min(K[14], K[12]); K[14] = hi_; K[12] = lo_; } \
    { const unsigned hi_ = max(K[15], K[13]), lo_ = min(K[15], K[13]); K[15] = hi_; K[13] = lo_; } \
    { const unsigned hi_ = max(K[0], K[1]), lo_ = min(K[0], K[1]); K[0] = hi_; K[1] = lo_; } \
    { const unsigned hi_ = max(K[2], K[3]), lo_ = min(K[2], K[3]); K[2] = hi_; K[3] = lo_; } \
    { const unsigned hi_ = max(K[4], K[5]), lo_ = min(K[4], K[5]); K[4] = hi_; K[5] = lo_; } \
    { const unsigned hi_ = max(K[6], K[7]), lo_ = min(K[6], K[7]); K[6] = hi_; K[7] = lo_; } \
    { const unsigned hi_ = max(K[9], K[8]), lo_ = min(K[9], K[8]); K[9] = hi_; K[8] = lo_; } \
    { const unsigned hi_ = max(K[11], K[10]), lo_ = min(K[11], K[10]); K[11] = hi_; K[10] = lo_; } \
    { const unsigned hi_ = max(K[13], K[12]), lo_ = min(K[13], K[12]); K[13] = hi_; K[12] = lo_; } \
    { const unsigned hi_ = max(K[15], K[14]), lo_ = min(K[15], K[14]); K[15] = hi_; K[14] = lo_; } \
    { const unsigned hi_ = max(K[0], K[8]), lo_ = min(K[0], K[8]); K[0] = hi_; K[8] = lo_; } \
    { const unsigned hi_ = max(K[1], K[9]), lo_ = min(K[1], K[9]); K[1] = hi_; K[9] = lo_; } \
    { const unsigned hi_ = max(K[2], K[10]), lo_ = min(K[2], K[10]); K[2] = hi_; K[10] = lo_; } \
    { const unsigned hi_ = max(K[3], K[11]), lo_ = min(K[3], K[11]); K[3] = hi_; K[11] = lo_; } \
    { const unsigned hi_ = max(K[4], K[12]), lo_ = min(K[4], K[12]); K[4] = hi_; K[12] = lo_; } \
    { const unsigned hi_ = max(K[5], K[13]), lo_ = min(K[5], K[13]); K[5] = hi_; K[13] = lo_; } \
    { const unsigned hi_ = max(K[6], K[14]), lo_ = min(K[6], K[14]); K[6] = hi_; K[14] = lo_; } \
    { const unsigned hi_ = max(K[7], K[15]), lo_ = min(K[7], K[15]); K[7] = hi_; K[15] = lo_; } \
    { const unsigned hi_ = max(K[0], K[4]), lo_ = min(K[0], K[4]); K[0] = hi_; K[4] = lo_; } \
    { const unsigned hi_ = max(K[1], K[5]), lo_ = min(K[1], K[5]); K[1] = hi_; K[5] = lo_; } \
    { const unsigned hi_ = max(K[2], K[6]), lo_ = min(K[2], K[6]); K[2] = hi_; K[6] = lo_; } \
    { const unsigned hi_ = max(K[3], K[7]), lo_ = min(K[3], K[7]); K[3] = hi_; K[7] = lo_; } \
    { const unsigned hi_ = max(K[8], K[12]), lo_ = min(K[8], K[12]); K[8] = hi_; K[12] = lo_; } \
    { const unsigned hi_ = max(K[9], K[13]), lo_ = min(K[9], K[13]); K[9] = hi_; K[13] = lo_; } \
    { const unsigned hi_ = max(K[10], K[14]), lo_ = min(K[10], K[14]); K[10] = hi_; K[14] = lo_; } \
    { const unsigned hi_ = max(K[11], K[15]), lo_ = min(K[11], K[15]); K[11] = hi_; K[15] = lo_; } \
    { const unsigned hi_ = max(K[0], K[2]), lo_ = min(K[0], K[2]); K[0] = hi_; K[2] = lo_; } \
    { const unsigned hi_ = max(K[1], K[3]), lo_ = min(K[1], K[3]); K[1] = hi_; K[3] = lo_; } \
    { const unsigned hi_ = max(K[4], K[6]), lo_ = min(K[4], K[6]); K[4] = hi_; K[6] = lo_; } \
    { const unsigned hi_ = max(K[5], K[7]), lo_ = min(K[5], K[7]); K[5] = hi_; K[7] = lo_; } \
    { const unsigned hi_ = max(K[8], K[10]), lo_ = min(K[8], K[10]); K[8] = hi_; K[10] = lo_; } \
    { const unsigned hi_ = max(K[9], K[11]), lo_ = min(K[9], K[11]); K[9] = hi_; K[11] = lo_; } \
    { const unsigned hi_ = max(K[12], K[14]), lo_ = min(K[12], K[14]); K[12] = hi_; K[14] = lo_; } \
    { const unsigned hi_ = max(K[13], K[15]), lo_ = min(K[13], K[15]); K[13] = hi_; K[15] = lo_; } \
    { const unsigned hi_ = max(K[0], K[1]), lo_ = min(K[0], K[1]); K[0] = hi_; K[1] = lo_; } \
    { const unsigned hi_ = max(K[2], K[3]), lo_ = min(K[2], K[3]); K[2] = hi_; K[3] = lo_; } \
    { const unsigned hi_ = max(K[4], K[5]), lo_ = min(K[4], K[5]); K[4] = hi_; K[5] = lo_; } \
    { const unsigned hi_ = max(K[6], K[7]), lo_ = min(K[6], K[7]); K[6] = hi_; K[7] = lo_; } \
    { const unsigned hi_ = max(K[8], K[9]), lo_ = min(K[8], K[9]); K[8] = hi_; K[9] = lo_; } \
    { const unsigned hi_ = max(K[10], K[11]), lo_ = min(K[10], K[11]); K[10] = hi_; K[11] = lo_; } \
    { const unsigned hi_ = max(K[12], K[13]), lo_ = min(K[12], K[13]); K[12] = hi_; K[13] = lo_; } \
    { const unsigned hi_ = max(K[14], K[15]), lo_ = min(K[14], K[15]); K[14] = hi_; K[15] = lo_; } \
} while (0)
#define MERGE16_DESC(K) do { \
    { const unsigned hi_ = max(K[0], K[8]), lo_ = min(K[0], K[8]); K[0] = hi_; K[8] = lo_; } \
    { const unsigned hi_ = max(K[1], K[9]), lo_ = min(K[1], K[9]); K[1] = hi_; K[9] = lo_; } \
    { const unsigned hi_ = max(K[2], K[10]), lo_ = min(K[2], K[10]); K[2] = hi_; K[10] = lo_; } \
    { const unsigned hi_ = max(K[3], K[11]), lo_ = min(K[3], K[11]); K[3] = hi_; K[11] = lo_; } \
    { const unsigned hi_ = max(K[4], K[12]), lo_ = min(K[4], K[12]); K[4] = hi_; K[12] = lo_; } \
    { const unsigned hi_ = max(K[5], K[13]), lo_ = min(K[5], K[13]); K[5] = hi_; K[13] = lo_; } \
    { const unsigned hi_ = max(K[6], K[14]), lo_ = min(K[6], K[14]); K[6] = hi_; K[14] = lo_; } \
    { const unsigned hi_ = max(K[7], K[15]), lo_ = min(K[7], K[15]); K[7] = hi_; K[15] = lo_; } \
    { const unsigned hi_ = max(K[0], K[4]), lo_ = min(K[0], K[4]); K[0] = hi_; K[4] = lo_; } \
    { const unsigned hi_ = max(K[1], K[5]), lo_ = min(K[1], K[5]); K[1] = hi_; K[5] = lo_; } \
    { const unsigned hi_ = max(K[2], K[6]), lo_ = min(K[2], K[6]); K[2] = hi_; K[6] = lo_; } \
    { const unsigned hi_ = max(K[3], K[7]), lo_ = min(K[3], K[7]); K[3] = hi_; K[7] = lo_; } \
    { const unsigned hi_ = max(K[8], K[12]), lo_ = min(K[8], K[12]); K[8] = hi_; K[12] = lo_; } \
    { const unsigned hi_ = max(K[9], K[13]), lo_ = min(K[9], K[13]); K[9] = hi_; K[13] = lo_; } \
    { const unsigned hi_ = max(K[10], K[14]), lo_ = min(K[10], K[14]); K[10] = hi_; K[14] = lo_; } \
    { const unsigned hi_ = max(K[11], K[15]), lo_ = min(K[11], K[15]); K[11] = hi_; K[15] = lo_; } \
    { const unsigned hi_ = max(K[0], K[2]), lo_ = min(K[0], K[2]); K[0] = hi_; K[2] = lo_; } \
    { const unsigned hi_ = max(K[1], K[3]), lo_ = min(K[1], K[3]); K[1] = hi_; K[3] = lo_; } \
    { const unsigned hi_ = max(K[4], K[6]), lo_ = min(K[4], K[6]); K[4] = hi_; K[6] = lo_; } \
    { const unsigned hi_ = max(K[5], K[7]), lo_ = min(K[5], K[7]); K[5] = hi_; K[7] = lo_; } \
    { const unsigned hi_ = max(K[8], K[10]), lo_ = min(K[8], K[10]); K[8] = hi_; K[10] = lo_; } \
    { const unsigned hi_ = max(K[9], K[11]), lo_ = min(K[9], K[11]); K[9] = hi_; K[11] = lo_; } \
    { const unsigned hi_ = max(K[12], K[14]), lo_ = min(K[12], K[14]); K[12] = hi_; K[14] = lo_; } \
    { const unsigned hi_ = max(K[13], K[15]), lo_ = min(K[13], K[15]); K[13] = hi_; K[15] = lo_; } \
    { const unsigned hi_ = max(K[0], K[1]), lo_ = min(K[0], K[1]); K[0] = hi_; K[1] = lo_; } \
    { const unsigned hi_ = max(K[2], K[3]), lo_ = min(K[2], K[3]); K[2] = hi_; K[3] = lo_; } \
    { const unsigned hi_ = max(K[4], K[5]), lo_ = min(K[4], K[5]); K[4] = hi_; K[5] = lo_; } \
    { const unsigned hi_ = max(K[6], K[7]), lo_ = min(K[6], K[7]); K[6] = hi_; K[7] = lo_; } \
    { const unsigned hi_ = max(K[8], K[9]), lo_ = min(K[8], K[9]); K[8] = hi_; K[9] = lo_; } \
    { const unsigned hi_ = max(K[10], K[11]), lo_ = min(K[10], K[11]); K[10] = hi_; K[11] = lo_; } \
    { const unsigned hi_ = max(K[12], K[13]), lo_ = min(K[12], K[13]); K[12] = hi_; K[13] = lo_; } \
    { const unsigned hi_ = max(K[14], K[15]), lo_ = min(K[14], K[15]); K[14] = hi_; K[15] = lo_; } \
} while (0)

__device__ __forceinline__ unsigned enc_key(float f, unsigned tag, unsigned mask) { unsigned u = __float_as_uint(f); u = (u & 0x80000000u) ? ~u : (u | 0x80000000u); return (u & mask) | tag; }
__device__ __forceinline__ float dec_key(unsigned k, unsigned mask) { unsigned u = k & mask; u = (u & 0x80000000u) ? (u & 0x7fffffffu) : ~u; return __uint_as_float(u); }
__device__ __forceinline__ unsigned sel4(int q, unsigned a, unsigned b, unsigned c, unsigned d) { const unsigned lo = (q & 1) ? b : a, hi = (q & 1) ? d : c; return (q & 2) ? hi : lo; }
template <int XM> __device__ __forceinline__ void xmerge16(unsigned (&K)[16], int lane) {
    unsigned o[16];
#pragma unroll
    for (int i = 0; i < 16; ++i) o[i] = (unsigned)shxl_i((int)K[15 - i], XM, lane);
#pragma unroll
    for (int i = 0; i < 16; ++i) K[i] = max(K[i], o[i]);
    MERGE16_DESC(K);
}
constexpr int SEL_KROW = 528;
constexpr int SEL_TAB = 256 * SEL_KROW;
__device__ __forceinline__ void peer_select_sort_phase(const bf16_t* __restrict__ QS, const bf16_t* __restrict__ KS, int* __restrict__ IDX, float* __restrict__ GWT, int rows, char* lds, int tid) {
    const int wave = tid >> 6, lane = tid & 63, n = lane & 15, q = lane >> 4;
    const int G = grid_x(), ngroups = rows / 16;
    const bool byhead = (G % 8) == 0;
    int* li = (int*)(lds + SEL_TAB + wave * 2048);
    for (int h = byhead ? (int)(blockIdx.x & 7) : 0; h < 8; h += byhead ? 8 : 1) {
        __syncthreads();
        for (int c = tid; c < 256 * 32; c += 512) { const int r = c >> 5, ch = c & 31;
            *(uint4*)(lds + r * SEL_KROW + ch * 16) = *(const uint4*)((const char*)KS + ((size_t)(h * 256 + r)) * 512 + ch * 16); }
        __syncthreads();
        const int rank = byhead ? (int)(blockIdx.x >> 3) : (int)blockIdx.x, nrank = byhead ? G / 8 : G;
        for (int grp = rank * 8 + wave; grp < ngroups; grp += nrank * 8) {
            const int token = grp * 16 + n;
            unsigned t12[2][16];
#pragma unroll
            for (int p = 0; p < 2; ++p) {
                bf16x8 qh[4], ql[4];
                const bf16_t* qp = QS + (size_t)token * (2 * D) + h * 256 + p * 128 + 8 * q;
#pragma unroll
                for (int ks = 0; ks < 4; ++ks) { qh[ks] = *(const bf16x8*)(qp + 32 * ks); ql[ks] = *(const bf16x8*)(qp + D + 32 * ks); }
                unsigned ka[16], kb[16];
                const char* kbase = lds + (p * 128 + n) * SEL_KROW + 16 * q;
#pragma unroll
                for (int g = 0; g < 8; ++g) { f32x4 acc = {0.f, 0.f, 0.f, 0.f};
#pragma unroll
                    for (int ks = 0; ks < 4; ++ks) { const bf16x8 kh = *(const bf16x8*)(kbase + 16 * g * SEL_KROW + 64 * ks), kl = *(const bf16x8*)(kbase + 16 * g * SEL_KROW + 256 + 64 * ks);
                        acc = __builtin_amdgcn_mfma_f32_16x16x32_bf16(kh, qh[ks], acc, 0, 0, 0);
                        acc = __builtin_amdgcn_mfma_f32_16x16x32_bf16(kh, ql[ks], acc, 0, 0, 0);
                        acc = __builtin_amdgcn_mfma_f32_16x16x32_bf16(kl, qh[ks], acc, 0, 0, 0); }
#pragma unroll
                    for (int j = 0; j < 4; ++j) { const unsigned k = enc_key(acc[j], (unsigned)(127 - (16 * g + 4 * q + j)), 0xFFFFFF80u); if (g < 4) ka[4 * g + j] = k; else kb[4 * (g - 4) + j] = k; } }
                SORT16_DESC(ka); SORT16_DESC(kb);
#pragma unroll
                for (int i = 0; i < 16; ++i) ka[i] = max(ka[i], kb[15 - i]);
                MERGE16_DESC(ka);
                xmerge16<16>(ka, lane); xmerge16<32>(ka, lane);
#pragma unroll
                for (int i = 0; i < 16; ++i) t12[p][i] = ka[i];
            }
#pragma unroll
            for (int p = 0; p < 2; ++p)
#pragma unroll
                for (int j = 0; j < 4; ++j) li[n * 32 + p * 16 + 4 * q + j] = 127 - (int)(sel4(q, t12[p][j], t12[p][4 + j], t12[p][8 + j], t12[p][12 + j]) & 127u);
            unsigned ck[16];
#pragma unroll
            for (int t = 0; t < 16; ++t) {
                if (t >= 13) { ck[t] = 0u; continue; }
                unsigned sa[4], sb[4];
#pragma unroll
                for (int qq = 0; qq < 4; ++qq) { const int c = qq + 4 * t; int a_, b_;
                    if (c < 16) { a_ = 0; b_ = c; } else if (c < 24) { a_ = 1; b_ = c - 16; } else if (c < 29) { a_ = 2; b_ = c - 24; } else if (c < 33) { a_ = 3; b_ = c - 29; }
                    else if (c < 36) { a_ = 4; b_ = c - 33; } else if (c < 42) { a_ = 5 + ((c - 36) >> 1); b_ = (c - 36) & 1; } else if (c < 50) { a_ = 8 + (c - 42); b_ = 0; } else { a_ = 0; b_ = 0; }
                    sa[qq] = t12[0][a_]; sb[qq] = t12[1][b_]; }
                const int c = q + 4 * t;
                const float sum = dec_key(sel4(q, sa[0], sa[1], sa[2], sa[3]), 0xFFFFFF80u) + dec_key(sel4(q, sb[0], sb[1], sb[2], sb[3]), 0xFFFFFF80u);
                ck[t] = c < 50 ? enc_key(sum, (unsigned)(63 - c), 0xFFFFFFC0u) : 0u;
            }
            SORT16_DESC(ck); xmerge16<16>(ck, lane); xmerge16<32>(ck, lane);
            const float top0 = dec_key(ck[0], 0xFFFFFFC0u);
            float e[4], es = 0.f; int oi[4];
            WAVE_LDS_SYNC();
#pragma unroll
            for (int j = 0; j < 4; ++j) {
                const unsigned kw = sel4(q, ck[j], ck[4 + j], ck[8 + j], ck[12 + j]);
                e[j] = __expf(dec_key(kw, 0xFFFFFFC0u) - top0); es += e[j];
                const int c = 63 - (int)(kw & 63u); int a_, b_;
                if (c < 16) { a_ = 0; b_ = c; } else if (c < 24) { a_ = 1; b_ = c - 16; } else if (c < 29) { a_ = 2; b_ = c - 24; } else if (c < 33) { a_ = 3; b_ = c - 29; }
                else if (c < 36) { a_ = 4; b_ = c - 33; } else if (c < 42) { a_ = 5 + ((c - 36) >> 1); b_ = (c - 36) & 1; } else { a_ = 8 + (c - 42); b_ = 0; }
                oi[j] = li[n * 32 + a_] * 128 + li[n * 32 + 16 + b_];
            }
            es += shxl_f(es, 16, lane); es += shxl_f(es, 32, lane);
            const float inv = 1.f / es;
            *(int4*)(IDX + (size_t)token * 128 + h * 16 + 4 * q) = make_int4(oi[0], oi[1], oi[2], oi[3]);
            *(float4*)(GWT + (size_t)token * 128 + h * 16 + 4 * q) = make_float4(e[0] * inv, e[1] * inv, e[2] * inv, e[3] * inv);
            WAVE_LDS_SYNC();
        }
    }
    __syncthreads();
}
constexpr int LDS_BYTES = 163840, XCH_OFF = 131072, XBW_OFF = 155648;
constexpr size_t W2_BAR = 65536, W2_RANK = 98304, W2_ACNT = 393216  , W2_ROPE = 131072, W2_MOD = 1 * MiB, W2_WIN = 2 * MiB, W2_WBR = 86 * MiB, W2_WOUT = 102 * MiB, W2_WQS = 118 * MiB, W2_X = 150 * MiB,
                 W2_QKV = 280 * MiB, W2_G = 427 * MiB, W2_HS = 280 * MiB, W2_QS = 427 * MiB, W2_B1 = 622 * MiB, W2_O = 687 * MiB, W2_IDX = 752 * MiB, W2_GWT = 761 * MiB,
                 W2_UB = 770 * MiB, W2_VB = 802 * MiB, W2_SU = 834 * MiB, W2_SV = 835 * MiB, W2_KS = 836 * MiB, W2_COEF = 838 * MiB, W2_PART = 557 * MiB, W2_APART = 848 * MiB  , W2_END = 884 * MiB;
struct FArgs { const float* in[22]; float* out; char* ws; };
struct AP {
    static __device__ __forceinline__ const void* ld(int i) {
        unsigned base = ARG_OFF; asm volatile("" : "+v"(base));
        const PG8_LAS unsigned* p = (const PG8_LAS unsigned*)(size_t)base;
        unsigned lo = p[2 * i], hi = p[2 * i + 1]; asm volatile("" : "+v"(lo), "+v"(hi));
        lo = __builtin_amdgcn_readfirstlane(lo); hi = __builtin_amdgcn_readfirstlane(hi);
        return (const void*)(const __attribute__((address_space(1))) void*)(((unsigned long long)hi << 32) | lo);
    }
    static __device__ __forceinline__ const float* in(int i) { return (const float*)ld(i); }
    static __device__ __forceinline__ float* out() { return (float*)ld(22); }
    static __device__ __forceinline__ char* ws() { return (char*)ld(23); }
};
__device__ __forceinline__ int make_tid(int wave_s) { unsigned z = 0u; asm volatile("" : "+v"(z)); int t = wave_s * 64 + (int)__builtin_amdgcn_mbcnt_hi(~0u, __builtin_amdgcn_mbcnt_lo(~0u, z)); asm volatile("" : "+v"(t)); return t; }
#ifndef MK_EMASK
#define MK_EMASK 0xFFFFu
#endif
#ifndef MK_DUP
#define MK_DUP -1
#define MK_DUP_L 0
#endif
#ifndef MK_MASK
#define MK_MASK 1023
#endif
#ifndef MK_PH_LO
#define MK_PH_LO 0
#define MK_PH_HI 1000
#endif
__global__ void __launch_bounds__(512, 2) mk_fwd(FArgs a_unused) {
    extern __shared__ __attribute__((aligned(16))) unsigned char lds[];
    PG8_LAS unsigned char* L = (PG8_LAS unsigned char*)lds;
    const int wave_s = __builtin_amdgcn_readfirstlane((int)threadIdx.x >> 6);
    if (threadIdx.x == 0) *(uint4*)(lds + XBW_OFF) = make_uint4(0u, 0u, 0u, 0u);
    if (threadIdx.x < 24) ((unsigned long long*)(lds + ARG_OFF))[threadIdx.x] = ((const unsigned long long*)&a_unused)[threadIdx.x];
    if (threadIdx.x == 24) ((unsigned long long*)(lds + ARG_OFF))[24] = (unsigned long long)gridDim.x;
    if (threadIdx.x == 25) { const unsigned myx = xb_xcc_id(); const unsigned rk = xb_add((unsigned*)(a_unused.ws + W2_RANK) + 64 * myx, 1u);
        ((unsigned*)(lds + ARG_OFF))[50] = myx; ((unsigned*)(lds + ARG_OFF))[51] = rk; }
    __syncthreads();
    XcdBarrier bar = xcd_barrier_post((unsigned*)(AP::ws() + W2_BAR), (volatile LAS unsigned*)(L + XBW_OFF));
#define WSP(T, off) ((T*)(AP::ws() + (off)))

#if MK_MASK & 1
    { const int tid = make_tid(wave_s); rope_table_phase(WSP(float, W2_ROPE), tid); keys_split_phase(AP::in(18), WSP(bf16_t, W2_KS), NL * 16 * 128, tid); }
#define CONVERT_LAYER(l, b0, nb) do { \
        { const int tid = make_tid(wave_s); cvt_T_phase<1>(AP::in(8) + (size_t)(l) * D * NCOL, D, NCOL, WSP(bf16_t, W2_WIN + (size_t)(l) * 42 * MiB), D, 0, (float*)lds, tid, b0, nb); } \
        { const int tid = make_tid(wave_s); cvt_T_phase<0>(AP::in(13) + (size_t)(l) * 768 * D, 768, D, WSP(bf16_t, W2_WBR + (size_t)(l) * 8 * MiB), D, 0, (float*)lds, tid, b0, nb); } \
        { const int tid = make_tid(wave_s); cvt_T_phase<0>(AP::in(14) + (size_t)(l) * 768 * D, 768, D, WSP(bf16_t, W2_WBR + (size_t)(l) * 8 * MiB), D, 768, (float*)lds, tid, b0, nb); } \
        { const int tid = make_tid(wave_s); cvt_T_phase<0>(AP::in(15) + (size_t)(l) * 512 * D, 512, D, WSP(bf16_t, W2_WBR + (size_t)(l) * 8 * MiB), D, 1536, (float*)lds, tid, b0, nb); } \
        { const int tid = make_tid(wave_s); cvt_T_phase<0>(AP::in(16) + (size_t)(l) * D * D, D, D, WSP(bf16_t, W2_WOUT + (size_t)(l) * 8 * MiB), D, 0, (float*)lds, tid, b0, nb); } \
        { const int tid = make_tid(wave_s); cvt_T_phase<3>(AP::in(17) + (size_t)(l) * D * D, D, D, WSP(bf16_t, W2_WQS + (size_t)(l) * 16 * MiB), D, 0, (float*)lds, tid, b0, nb); } \
        { const int tid = make_tid(wave_s); modvec_phase(AP::in(1), AP::in(3), AP::in(4) + (size_t)(l) * D * NMOD, AP::in(5) + (size_t)(l) * NMOD, WSP(float, W2_MOD) + (size_t)(l) * 2 * NMOD, tid, l, b0, nb); } } while (0)
    CONVERT_LAYER(0, (int)blockIdx.x, grid_x());
#endif
    xcd_barrier(bar);
    if (threadIdx.x == 0) {
        unsigned* bw = (unsigned*)(AP::ws() + W2_BAR); const unsigned myx = ((unsigned*)(lds + ARG_OFF))[50]; unsigned xi = 0, nx = 0, cnt = 1;
        for (unsigned j = 0; j < 16; ++j) { const unsigned c = xb_ld(&bw[XB_XCNT(j)]); if (c > 0u) { if (j < myx) ++xi; ++nx; } if (j == myx) cnt = c > 0u ? c : 1u; }
        ((unsigned*)(lds + ARG_OFF))[52] = xi; ((unsigned*)(lds + ARG_OFF))[53] = nx > 0u ? nx : 1u; ((unsigned*)(lds + ARG_OFF))[54] = cnt; }
    __syncthreads();
#if MK_MASK & 2
    {
        const int tid = make_tid(wave_s);
        norm_mod_phase<0>(AP::in(0), AP::in(2), AP::in(6), WSP(float, W2_MOD), 0, D, WSP(bf16_t, W2_B1), nullptr, MT, tid);
    }
#endif
    xcd_barrier(bar);
    for (int l = 0; l < NL; ++l) {
        const int rows = l < NL - 1 ? MT : S;
        for (int rep = 0; rep < ((MK_DUP == 2 && l == MK_DUP_L) ? 2 : 1); ++rep) {
#if MK_MASK & 4
        {
            const int tid = make_tid(wave_s);
            pg8::Gemm g{WSP(bf16_t, W2_B1), WSP(bf16_t, W2_WIN + (size_t)l * 42 * MiB), };
            pg8::StaticOrder so; so.init(MT, NCOL, grid_x(), blockIdx.x);
            pg8::EpiInprojF E{WSP(bf16_t, W2_QKV), WSP(bf16_t, W2_G), AP::in(10) + l * 128, AP::in(11) + l * 128, WSP(float, W2_ROPE), (PG8_LAS float*)(L + XCH_OFF)};
            pg8::gemm_phase<pg8::EpiInprojF, pg8::StaticOrder, 0, D, D, 32>(L, g, so, E, tid);
        }
#endif
        xcd_barrier(bar);
        }
        for (int rep = 0; rep < ((MK_DUP == 3 && l == MK_DUP_L) ? 2 : 1); ++rep) {
#if MK_MASK & 8
        {
            att::attn_phase(WSP(bf16_t, W2_QKV), WSP(bf16_t, W2_O), AP::in(9) + (size_t)l * 6 * 465, AP::in(12) + l * 4, AP::in(10) + l * 128, AP::in(11) + l * 128, WSP(float, W2_APART), (unsigned*)(AP::ws() + W2_ACNT) + (size_t)l * 128 * 64, l < NL - 1, (char*)lds, wave_s);
            const int G_ = grid_x(), c2 = G_ == 256 ? (int)blockIdx.x - 128 : (int)blockIdx.x, G2 = G_ == 256 ? 128 : G_;
            if (c2 >= 0) {
                const int tid = make_tid(wave_s);
                quant_rows_sliced_phase<true>(AP::in(19) + (size_t)l * 16384 * D, WSP(unsigned char, W2_UB), WSP(float, W2_SU), 16384, c2, G2, tid);
                quant_rows_sliced_phase<true>(AP::in(20) + (size_t)l * 16384 * D, WSP(unsigned char, W2_VB), WSP(float, W2_SV), 16384, c2, G2, tid);
                if (l + 1 < NL) { __syncthreads(); CONVERT_LAYER(l + 1, c2, G2); }
            }
        }
#endif
        xcd_barrier(bar);
        }
        for (int rep = 0; rep < ((MK_DUP == 4 && l == MK_DUP_L) ? 2 : 1); ++rep) {
#if MK_MASK & 16
        {
            const int tid = make_tid(wave_s);
            if (l == 0) ctx_gemm<0>(WSP(bf16_t, W2_O), WSP(bf16_t, W2_WBR), WSP(bf16_t, W2_G), nullptr, nullptr, WSP(bf16_t, W2_B1), tid);
            pg8::Gemm g{WSP(bf16_t, W2_O), WSP(bf16_t, W2_WBR + (size_t)l * 8 * MiB), };
            pg8::StaticOrder so; so.init(S, D, grid_x(), blockIdx.x);
            pg8::EpiBranchF E{WSP(bf16_t, W2_G), WSP(bf16_t, W2_B1)};
            pg8::gemm_phase<pg8::EpiBranchF, pg8::StaticOrder, 0, D, D, 32>(L, g, so, E, tid);
        }
#endif
        xcd_barrier(bar);
        }
        for (int rep = 0; rep < ((MK_DUP == 5 && l == MK_DUP_L) ? 2 : 1); ++rep) {
#if MK_MASK & 32
        {
            const int tid = make_tid(wave_s);
            float* X = WSP(float, W2_X);
            if (l == 0) ctx_gemm<1>(WSP(bf16_t, W2_B1), WSP(bf16_t, W2_WOUT), nullptr, AP::in(2), WSP(float, W2_MOD) + NMOD + 2 * D, X, tid);
            pg8::Gemm g{WSP(bf16_t, W2_B1), WSP(bf16_t, W2_WOUT + (size_t)l * 8 * MiB), };
            pg8::StaticOrder so; so.init(S, D, grid_x(), blockIdx.x);
            pg8::EpiOutF E{l == 0 ? AP::in(0) : X, l == 0 ? AP::in(2) : X + (size_t)S * D, WSP(float, W2_MOD) + (size_t)l * 2 * NMOD, X};
            pg8::gemm_phase<pg8::EpiOutF, pg8::StaticOrder, 0, D, D, 32>(L, g, so, E, tid);
        }
#endif
        xcd_barrier(bar);
        }
        for (int rep = 0; rep < ((MK_DUP == 6 && l == MK_DUP_L) ? 2 : 1); ++rep) {
#if MK_MASK & 64
        {
            const int tid = make_tid(wave_s);
            float* X = WSP(float, W2_X);
            norm2_q_phase(X, AP::in(7) + l * D, WSP(float, W2_MOD) + (size_t)l * 2 * NMOD, WSP(_Float16, W2_O), WSP(signed char, W2_HS), WSP(float, W2_SV + 512 * 1024), rows, tid);
        }
#endif
        xcd_barrier(bar);
        }
        for (int rep = 0; rep < ((MK_DUP == 7 && l == MK_DUP_L) ? 2 : 1); ++rep) {
#if MK_MASK & 128
        {
            const int tid = make_tid(wave_s);
            if (l == 0) ctx_gemm<2>(WSP(bf16_t, W2_O), WSP(bf16_t, W2_WQS), nullptr, nullptr, nullptr, WSP(bf16_t, W2_QS), tid);
            pg8::Gemm g{WSP(bf16_t, W2_O), WSP(bf16_t, W2_WQS + (size_t)l * 16 * MiB), };
            pg8::StaticOrder so; so.init(S, D, grid_x(), blockIdx.x);
            pg8::EpiQsplitF E{WSP(bf16_t, W2_QS)};
            pg8::gemm_phase<pg8::EpiQsplitF, pg8::StaticOrder, 0, D, D, 32, true>(L, g, so, E, tid);
        }
#endif
        xcd_barrier(bar);
        }
        for (int rep = 0; rep < ((MK_DUP == 8 && l == MK_DUP_L) ? 2 : 1); ++rep) {
#if MK_MASK & 256
        {
            const int tid = make_tid(wave_s);
            peer_select_sort_phase(WSP(bf16_t, W2_QS), WSP(bf16_t, W2_KS) + (size_t)l * 16 * 128 * 256, WSP(int, W2_IDX), WSP(float, W2_GWT), rows, (char*)lds, tid);
        }
#endif
        xcd_barrier(bar);
        }
        for (int rep = 0; rep < ((MK_DUP == 9 && l == NL - 1) ? 2 : 1); ++rep) {
        if (rep) xcd_barrier(bar);
        { const int tid = make_tid(wave_s); if (rep == 0) peer_u_pass<0xFFFFu>(WSP(signed char, W2_HS), WSP(int, W2_IDX), WSP(unsigned char, W2_UB), WSP(int, W2_PART), rows, tid);
#if MK_DUP == 9
          else peer_u_pass<MK_EMASK>(WSP(signed char, W2_HS), WSP(int, W2_IDX), WSP(unsigned char, W2_UB), WSP(int, 847 * MiB), rows, tid);
#endif
        }
        }
        xcd_barrier(bar);
        for (int rep = 0; rep < ((MK_DUP == 10 && l == NL - 1) ? 2 : 1); ++rep) { if (rep) xcd_barrier(bar);
        { const int tid = make_tid(wave_s); peer_coef_pass(WSP(int, W2_PART), WSP(int, W2_IDX), WSP(float, W2_GWT), WSP(float, W2_SU), WSP(float, W2_SV), WSP(float, W2_SV + 512 * 1024), WSP(signed char, W2_COEF), WSP(float, W2_SV + 768 * 1024), rows, tid); }
        }
        xcd_barrier(bar);
        for (int rep = 0; rep < ((MK_DUP == 11 && l == NL - 1) ? 2 : 1); ++rep) { if (rep) xcd_barrier(bar);
        { const int tid = make_tid(wave_s); peer_v_pass(WSP(signed char, W2_COEF), WSP(float, W2_SV + 768 * 1024), WSP(int, W2_IDX), WSP(unsigned char, W2_VB), WSP(float, W2_HS)  , rows, tid); }
        }
        xcd_barrier(bar);
        for (int rep = 0; rep < ((MK_DUP == 12 && l == NL - 1) ? 2 : 1); ++rep) { if (rep) xcd_barrier(bar);
        { const int tid = make_tid(wave_s);
          if (l < NL - 1) peer_row_pass<false>(WSP(float, W2_X), WSP(float, W2_HS), WSP(float, W2_MOD) + (size_t)l * 2 * NMOD, AP::in(6) + (l + 1) * D, WSP(float, W2_MOD) + (size_t)(l + 1) * 2 * NMOD, WSP(bf16_t, W2_B1), nullptr, rows, tid);
          else peer_row_pass<true>(WSP(float, W2_X), WSP(float, W2_HS), WSP(float, W2_MOD) + (size_t)l * 2 * NMOD, AP::in(21), nullptr, nullptr, AP::out(), rows, tid); }
        }
        if (l < NL - 1) xcd_barrier(bar);
    }
#undef WSP
}

extern "C" void kernel_launch(void* const* d_in, const int* in_sizes, int n_in, void* d_out, int out_size, void* d_ws, size_t ws_size, hipStream_t stream) {
    static int grid = 0;
    if (grid == 0) {
        if (n_in != 22 || ws_size < W2_END) { fprintf(stderr, "kernel_launch: bad args n_in %d ws %zu\n", n_in, ws_size); grid = -1; return; }
        int dev = 0, cus = 0;
        if (hipGetDevice(&dev) != hipSuccess || hipDeviceGetAttribute(&cus, hipDeviceAttributeMultiprocessorCount, dev) != hipSuccess) { grid = -1; return; }
        if (hipFuncSetAttribute((const void*)mk_fwd, hipFuncAttributeMaxDynamicSharedMemorySize, LDS_BYTES) != hipSuccess) { grid = -1; return; }
        int per_cu = 0;
        if (hipOccupancyMaxActiveBlocksPerMultiprocessor(&per_cu, (const void*)mk_fwd, 512, LDS_BYTES) != hipSuccess || per_cu < 1) { fprintf(stderr, "kernel_launch: occupancy query says %d\n", per_cu); }
        (void)hipGetLastError();
        grid = cus;
    }
    if (grid < 0) return;
    (void)hipMemsetAsync((char*)d_ws, 0, 1 * MiB, stream);
    FArgs a{};
    for (int i = 0; i < 22; ++i) a.in[i] = (const float*)d_in[i];
    a.out = (float*)d_out; a.ws = (char*)d_ws;
    hipLaunchKernelGGL(mk_fwd, dim3(grid), dim3(512), LDS_BYTES, stream, a);
}
```
